# Optimizing an MI355X kernel written in HIP

```python
import math
import jax, jax.numpy as jnp
from jax import lax
import numpy as np

D_MODEL = 1024
BATCH = 8
SEQ = 8192
DEPTH = 2

CTX_LEN = 256
GRID_W = 64
ROPE_BASE = 10000.0
QBLOCK = 128

DEEPNORM_ALPHA = (2 * DEPTH) ** 0.25
DEEPNORM_BETA = (8 * DEPTH) ** -0.25

CHUNK = 128
GMLP_GROUPS = 4
GMLP_GROUP_CH = 128
GMLP_WIDTH = GMLP_GROUPS * GMLP_GROUP_CH

MLA_HEADS = 8
MLA_NOPE = 64
MLA_ROPE = 32
MLA_V = 64
MLA_Q_RANK = 256
MLA_KV_RANK = 128
MLA_WIDTH = MLA_HEADS * MLA_V
EVEN_SPLITS = [GMLP_WIDTH, 2 * GMLP_WIDTH, 2 * GMLP_WIDTH + MLA_Q_RANK,
               2 * GMLP_WIDTH + MLA_Q_RANK + MLA_KV_RANK]
EVEN_IN = 2 * GMLP_WIDTH + MLA_Q_RANK + MLA_KV_RANK + MLA_ROPE

DIFF_HEADS = 8
DIFF_HEAD_DIM = D_MODEL // DIFF_HEADS // 2
DIFF_WIDTH = DIFF_HEADS * 2 * DIFF_HEAD_DIM
ODD_IN = 3 * DIFF_WIDTH

N_EXPERTS = 16
EXPERT_FF = 1024
CAPACITY_FACTOR = 2

kernel_name = "hybrid_gmlp_mla_diffattn_ecmoe_dit"


def layer_norm(x, g, b, eps=1e-5):
    xf = x.astype(jnp.float32)
    mu = jnp.mean(xf, -1, keepdims=True)
    var = jnp.mean(jnp.square(xf - mu), -1, keepdims=True)
    return ((xf - mu) * lax.rsqrt(var + eps) * g + b).astype(x.dtype)


def rms_norm(x, g, eps=1e-6):
    xf = x.astype(jnp.float32)
    return (xf * lax.rsqrt(jnp.mean(jnp.square(xf), -1, keepdims=True) + eps) * g).astype(x.dtype)


def axial_rope_tables(n_tokens, dim, dtype):
    n_rows = n_tokens // GRID_W
    row = jnp.repeat(jnp.arange(n_rows, dtype=jnp.float32), GRID_W)
    col = jnp.tile(jnp.arange(GRID_W, dtype=jnp.float32), n_rows)
    n_freq = dim // 4
    inv_freq = ROPE_BASE ** (-jnp.arange(n_freq, dtype=jnp.float32) / n_freq)
    ang = jnp.concatenate([row[:, None] * inv_freq, col[:, None] * inv_freq], -1)
    return jnp.cos(ang).astype(dtype), jnp.sin(ang).astype(dtype)


def apply_rope(x, cos, sin):
    x1 = x[..., 0::2]
    x2 = x[..., 1::2]
    cc = cos[None, :, None, :]
    ss = sin[None, :, None, :]
    return jnp.stack([x1 * cc - x2 * ss, x1 * ss + x2 * cc], -1).reshape(x.shape)


def attention_blocked(qs, ks, v, coeffs):
    bn, n, h, d = qs[0].shape
    scale = d ** -0.5
    nblk = n // QBLOCK
    qb = tuple(q.reshape(bn, nblk, QBLOCK, h, d).swapaxes(0, 1) for q in qs)

    def block(qblk):
        p = 0.0
        for coef, q, k in zip(coeffs, qblk, ks):
            s = jnp.einsum('bqhd,bkhd->bhqk', q, k).astype(jnp.float32) * scale
            p = p + coef * jax.nn.softmax(s, axis=-1)
        return jnp.einsum('bhqk,bkhe->bqhe', p.astype(v.dtype), v)

    out = lax.map(block, qb)
    return out.swapaxes(0, 1).reshape(bn, n, h, v.shape[-1])


def modulation(cond, w_mod, b_mod):
    m = jax.nn.silu(cond) @ w_mod + b_mod
    return jnp.split(m[..., None, :], 6, axis=-1)


def chunk_gmlp(u, v, ln_g, ln_b, ws, bs):
    bn, n, w = v.shape
    vn = layer_norm(v, ln_g, ln_b).reshape(bn, n // CHUNK, CHUNK, GMLP_GROUPS, GMLP_GROUP_CH)
    mixed = jnp.einsum('gpq,bnqgc->bnpgc', ws, vn) + bs.T[None, None, :, :, None]
    return u * mixed.reshape(bn, n, w)


def even_project(h, p, rope):
    bn, n, _ = h.shape
    u, v, cq, ckv, kr = jnp.split(h @ p['w_in'], EVEN_SPLITS, axis=-1)
    a = chunk_gmlp(jax.nn.gelu(u, approximate=False), jax.nn.gelu(v, approximate=False),
                   p['gmlp_ln_g'], p['gmlp_ln_b'], p['gmlp_ws'], p['gmlp_bs'])
    q = (rms_norm(cq, p['mla_q_norm']) @ p['mla_w_uq']).reshape(bn, n, MLA_HEADS, MLA_NOPE + MLA_ROPE)
    kv = (rms_norm(ckv, p['mla_kv_norm']) @ p['mla_w_ukv']).reshape(bn, n, MLA_HEADS, MLA_NOPE + MLA_V)
    q_nope, q_rope = q[..., :MLA_NOPE], q[..., MLA_NOPE:]
    k_nope, val = kv[..., :MLA_NOPE], kv[..., MLA_NOPE:]
    kr = kr[:, :, None, :]
    if rope is not None:
        q_rope = apply_rope(q_rope, *rope)
        kr = apply_rope(kr, *rope)
    q = jnp.concatenate([q_nope, q_rope], -1)
    k = jnp.concatenate([k_nope, jnp.broadcast_to(kr, (bn, n, MLA_HEADS, MLA_ROPE))], -1)
    return a, q, k, val


def even_mixer(h_lat, h_ctx, p, need_ctx):
    bn, n, _ = h_lat.shape
    rope = axial_rope_tables(n, MLA_ROPE, h_lat.dtype)
    a_l, q_l, k_l, v_l = even_project(h_lat, p, rope)
    a_c, q_c, k_c, v_c = even_project(h_ctx, p, None)
    o_l = attention_blocked((q_l,), (jnp.concatenate([k_l, k_c], 1),),
                            jnp.concatenate([v_l, v_c], 1), (1.0,))
    out_l = jnp.concatenate([a_l, o_l.reshape(bn, n, MLA_WIDTH)], -1) @ p['w_out']
    out_c = None
    if need_ctx:
        o_c = attention_blocked((q_c,), (k_c,), v_c, (1.0,))
        out_c = jnp.concatenate([a_c, o_c.reshape(bn, h_ctx.shape[1], MLA_WIDTH)], -1) @ p['w_out']
    return out_l, out_c


def odd_mixer(h_lat, h_ctx, p, layer_idx, need_ctx):
    lam_init = 0.8 - 0.6 * math.exp(-0.3 * layer_idx)
    lam = (jnp.exp(jnp.sum(p['lambda_q1'].astype(jnp.float32) * p['lambda_k1']))
           - jnp.exp(jnp.sum(p['lambda_q2'].astype(jnp.float32) * p['lambda_k2'])) + lam_init)
    bn, n, _ = h_lat.shape
    m = h_ctx.shape[1]
    rope = axial_rope_tables(n, DIFF_HEAD_DIM, h_lat.dtype)
    q, k, v = jnp.split(h_lat @ p['w_in'], 3, axis=-1)
    q = apply_rope(q.reshape(bn, n, 2 * DIFF_HEADS, DIFF_HEAD_DIM), *rope).reshape(bn, n, DIFF_HEADS, 2, DIFF_HEAD_DIM)
    k = apply_rope(k.reshape(bn, n, 2 * DIFF_HEADS, DIFF_HEAD_DIM), *rope).reshape(bn, n, DIFF_HEADS, 2, DIFF_HEAD_DIM)
    v = v.reshape(bn, n, DIFF_HEADS, 2 * DIFF_HEAD_DIM)
    k_c, v_c = jnp.split(h_ctx @ p['w_in'][:, DIFF_WIDTH:], 2, axis=-1)
    k_c = k_c.reshape(bn, m, DIFF_HEADS, 2, DIFF_HEAD_DIM)
    v_c = v_c.reshape(bn, m, DIFF_HEADS, 2 * DIFF_HEAD_DIM)
    kk = jnp.concatenate([k, k_c], 1)
    vv = jnp.concatenate([v, v_c], 1)
    o = attention_blocked((q[..., 0, :], q[..., 1, :]), (kk[..., 0, :], kk[..., 1, :]), vv, (1.0, -lam))
    out_l = (rms_norm(o, p['subln_g']) * (1.0 - lam_init)).reshape(bn, n, DIFF_WIDTH) @ p['w_out']
    out_c = None
    if need_ctx:
        q_c = (h_ctx @ p['w_in'][:, :DIFF_WIDTH]).reshape(bn, m, DIFF_HEADS, 2, DIFF_HEAD_DIM)
        o_c = attention_blocked((q_c[..., 0, :], q_c[..., 1, :]), (k_c[..., 0, :], k_c[..., 1, :]), v_c, (1.0, -lam))
        out_c = (rms_norm(o_c, p['subln_g']) * (1.0 - lam_init)).reshape(bn, m, DIFF_WIDTH) @ p['w_out']
    return out_l, out_c


def expert_choice_ffn(h, router, w_gate, w_up, w_down):
    n, d = h.shape[1], h.shape[2]
    cap = CAPACITY_FACTOR * n // N_EXPERTS
    aff = jax.nn.softmax(jnp.einsum('bnd,de->bne', h, router).astype(jnp.float32), axis=-1)
    g, idx = lax.top_k(aff.transpose(0, 2, 1), cap)
    xs = jax.vmap(lambda hb, ib: hb[ib])(h, idx)
    hid = jax.nn.silu(jnp.einsum('becd,edf->becf', xs, w_gate)) * jnp.einsum('becd,edf->becf', xs, w_up)
    y = jnp.einsum('becf,efd->becd', hid, w_down) * g[..., None].astype(h.dtype)
    return jax.vmap(lambda yb, ib: jnp.zeros((n, d), yb.dtype).at[ib.reshape(-1)].add(yb.reshape(-1, d)))(y, idx)


def setup_inputs(seed: int = 0) -> dict:
    key = jax.random.key(seed)
    ks = iter(jax.random.split(key, 64))
    D = D_MODEL

    def nrm(shape, scale=1.0):
        return jax.random.normal(next(ks), shape, jnp.float32) * scale

    def gain(n):
        return 1.0 + nrm((n,), 0.02)

    inp = {}
    inp['x'] = nrm((BATCH, SEQ, D))
    inp['c'] = nrm((BATCH, D))
    inp['ctx'] = nrm((BATCH, CTX_LEN, D))
    inp['c_ctx'] = nrm((D,))
    inp['w_mod_0'] = nrm((D, 6 * D), 0.25 * D ** -0.5)
    inp['b_mod_0'] = nrm((6 * D,), 0.01)
    inp['w_in_0'] = nrm((D, EVEN_IN), D ** -0.5)
    inp['gmlp_ln_g_0'] = gain(GMLP_WIDTH)
    inp['gmlp_ln_b_0'] = nrm((GMLP_WIDTH,), 0.02)
    inp['gmlp_ws_0'] = nrm((GMLP_GROUPS, CHUNK, CHUNK), CHUNK ** -0.5)
    inp['gmlp_bs_0'] = 1.0 + nrm((GMLP_GROUPS, CHUNK), 0.02)
    inp['mla_q_norm_0'] = gain(MLA_Q_RANK)
    inp['mla_w_uq_0'] = nrm((MLA_Q_RANK, MLA_HEADS * (MLA_NOPE + MLA_ROPE)), MLA_Q_RANK ** -0.5)
    inp['mla_kv_norm_0'] = gain(MLA_KV_RANK)
    inp['mla_w_ukv_0'] = nrm((MLA_KV_RANK, MLA_HEADS * (MLA_NOPE + MLA_V)), MLA_KV_RANK ** -0.5)
    inp['w_out_0'] = nrm((GMLP_WIDTH + MLA_WIDTH, D), DEEPNORM_BETA * (GMLP_WIDTH + MLA_WIDTH) ** -0.5)
    inp['ln_mix_g_0'] = gain(D)
    inp['ln_mix_b_0'] = nrm((D,), 0.02)
    inp['router_0'] = nrm((D, N_EXPERTS), D ** -0.5)
    inp['w_gate_0'] = nrm((N_EXPERTS, D, EXPERT_FF), D ** -0.5)
    inp['w_up_0'] = nrm((N_EXPERTS, D, EXPERT_FF), D ** -0.5)
    inp['w_down_0'] = nrm((N_EXPERTS, EXPERT_FF, D), DEEPNORM_BETA * EXPERT_FF ** -0.5)
    inp['ln_ffn_g_0'] = gain(D)
    inp['ln_ffn_b_0'] = nrm((D,), 0.02)
    inp['w_mod_1'] = nrm((D, 6 * D), 0.25 * D ** -0.5)
    inp['b_mod_1'] = nrm((6 * D,), 0.01)
    inp['w_in_1'] = nrm((D, ODD_IN), D ** -0.5)
    inp['lambda_q1_1'] = nrm((DIFF_HEAD_DIM,), 0.1)
    inp['lambda_k1_1'] = nrm((DIFF_HEAD_DIM,), 0.1)
    inp['lambda_q2_1'] = nrm((DIFF_HEAD_DIM,), 0.1)
    inp['lambda_k2_1'] = nrm((DIFF_HEAD_DIM,), 0.1)
    inp['subln_g_1'] = gain(2 * DIFF_HEAD_DIM)
    inp['w_out_1'] = nrm((DIFF_WIDTH, D), DEEPNORM_BETA * DIFF_WIDTH ** -0.5)
    inp['ln_mix_g_1'] = gain(D)
    inp['ln_mix_b_1'] = nrm((D,), 0.02)
    inp['router_1'] = nrm((D, N_EXPERTS), D ** -0.5)
    inp['w_gate_1'] = nrm((N_EXPERTS, D, EXPERT_FF), D ** -0.5)
    inp['w_up_1'] = nrm((N_EXPERTS, D, EXPERT_FF), D ** -0.5)
    inp['w_down_1'] = nrm((N_EXPERTS, EXPERT_FF, D), DEEPNORM_BETA * EXPERT_FF ** -0.5)
    inp['ln_ffn_g_1'] = gain(D)
    inp['ln_ffn_b_1'] = nrm((D,), 0.02)
    return inp


def reference(x, c, ctx, c_ctx,
              w_mod_0, b_mod_0, w_in_0, gmlp_ln_g_0, gmlp_ln_b_0, gmlp_ws_0, gmlp_bs_0,
              mla_q_norm_0, mla_w_uq_0, mla_kv_norm_0, mla_w_ukv_0, w_out_0,
              ln_mix_g_0, ln_mix_b_0, router_0, w_gate_0, w_up_0, w_down_0, ln_ffn_g_0, ln_ffn_b_0,
              w_mod_1, b_mod_1, w_in_1, lambda_q1_1, lambda_k1_1, lambda_q2_1, lambda_k2_1, subln_g_1,
              w_out_1, ln_mix_g_1, ln_mix_b_1, router_1, w_gate_1, w_up_1, w_down_1, ln_ffn_g_1, ln_ffn_b_1):
    p0 = dict(w_mod=w_mod_0, b_mod=b_mod_0, w_in=w_in_0, gmlp_ln_g=gmlp_ln_g_0, gmlp_ln_b=gmlp_ln_b_0,
              gmlp_ws=gmlp_ws_0, gmlp_bs=gmlp_bs_0, mla_q_norm=mla_q_norm_0, mla_w_uq=mla_w_uq_0,
              mla_kv_norm=mla_kv_norm_0, mla_w_ukv=mla_w_ukv_0, w_out=w_out_0,
              ln_mix_g=ln_mix_g_0, ln_mix_b=ln_mix_b_0, router=router_0, w_gate=w_gate_0,
              w_up=w_up_0, w_down=w_down_0, ln_ffn_g=ln_ffn_g_0, ln_ffn_b=ln_ffn_b_0)
    p1 = dict(w_mod=w_mod_1, b_mod=b_mod_1, w_in=w_in_1, lambda_q1=lambda_q1_1, lambda_k1=lambda_k1_1,
              lambda_q2=lambda_q2_1, lambda_k2=lambda_k2_1, subln_g=subln_g_1, w_out=w_out_1,
              ln_mix_g=ln_mix_g_1, ln_mix_b=ln_mix_b_1, router=router_1, w_gate=w_gate_1,
              w_up=w_up_1, w_down=w_down_1, ln_ffn_g=ln_ffn_g_1, ln_ffn_b=ln_ffn_b_1)
    layers = (p0, p1)
    x_lat, x_ctx = x, ctx
    for l in range(DEPTH):
        p = layers[l]
        need_ctx = l < DEPTH - 1
        sh_a, sc_a, g_a, sh_f, sc_f, g_f = modulation(c, p['w_mod'], p['b_mod'])
        csh_a, csc_a, cg_a, csh_f, csc_f, cg_f = modulation(c_ctx, p['w_mod'], p['b_mod'])
        h_lat = x_lat * (1.0 + sc_a) + sh_a
        h_ctx = x_ctx * (1.0 + csc_a) + csh_a
        if l % 2 == 0:
            m_lat, m_ctx = even_mixer(h_lat, h_ctx, p, need_ctx)
        else:
            m_lat, m_ctx = odd_mixer(h_lat, h_ctx, p, l, need_ctx)
        x_lat = layer_norm(DEEPNORM_ALPHA * x_lat + (1.0 + g_a) * m_lat, p['ln_mix_g'], p['ln_mix_b'])
        f_lat = expert_choice_ffn(x_lat * (1.0 + sc_f) + sh_f, p['router'], p['w_gate'], p['w_up'], p['w_down'])
        x_lat = layer_norm(DEEPNORM_ALPHA * x_lat + (1.0 + g_f) * f_lat, p['ln_ffn_g'], p['ln_ffn_b'])
        if need_ctx:
            x_ctx = layer_norm(DEEPNORM_ALPHA * x_ctx + (1.0 + cg_a) * m_ctx, p['ln_mix_g'], p['ln_mix_b'])
            f_ctx = expert_choice_ffn(x_ctx * (1.0 + csc_f) + csh_f, p['router'], p['w_gate'], p['w_up'], p['w_down'])
            x_ctx = layer_norm(DEEPNORM_ALPHA * x_ctx + (1.0 + cg_f) * f_ctx, p['ln_ffn_g'], p['ln_ffn_b'])
    return x_lat
```

```cpp
#include <hip/hip_runtime.h>
#include <cstdio>
#include <cstdint>
namespace pg8 {
#define PG8_LAS __attribute__((address_space(3)))
typedef unsigned short bf16_t;
typedef short bf16x8 __attribute__((ext_vector_type(8)));
typedef float f32x4 __attribute__((ext_vector_type(4)));
typedef unsigned u32x4 __attribute__((ext_vector_type(4)));
constexpr int BM = 256, BK = 64, HALF = 128, HTB = HALF * BK * 2  , STAGE_BYTES = 8 * HTB, NXCD = 8, WGM = 8;

__host__ __device__ __forceinline__ int lds_byte(int r, int c) { const int st = (r >> 4) * 2 + (c >> 5), rr = r & 15, cc = c & 31, ob = rr * 64 + cc * 2; return st * 1024 + (ob ^ (((ob >> 9) & 1) << 5)); }
__host__ __device__ __forceinline__ void stage_rc(int b, int& R, int& C) { const int st = b / 1024, sb = b % 1024, swz = sb ^ (((sb >> 9) & 1) << 5); R = (st >> 1) * 16 + swz / 64; C = (st & 1) * 32 + (swz % 64) / 2; }
__host__ __device__ __forceinline__ int perm32(int rho) { const int n = rho >> 4, i = rho & 15; return 8 * (i >> 2) + 4 * n + (i & 3); }

struct Unit { int pm, pn; };
struct Gemm { const bf16_t* A; const bf16_t* Bt; int M, N, K; };

struct StaticOrder {
    int nM, nN, nwg, G, c;
    __host__ __device__ void init(int M, int N, int G_, int c_) { nM = M / BM; nN = N / BM; nwg = nM * nN; G = G_; c = c_; }
    __host__ __device__ bool next(int i, Unit& u) const {
        const long L = (long)i * G + c; if (L >= nwg) return false;
        int wgid = (int)L; { const int q = nwg / NXCD, r = nwg % NXCD, xcd = wgid % NXCD, off = wgid / NXCD; wgid = (xcd < r ? xcd * (q + 1) : r * (q + 1) + (xcd - r) * q) + off; }
        const int nig = WGM * nN, gid = wgid / nig, fm = gid * WGM, gsz = (nM - fm) < WGM ? (nM - fm) : WGM;
        u.pm = fm + ((wgid % nig) % gsz); u.pn = (wgid % nig) / gsz; return true;
    }
    __device__ __forceinline__ void a_ready(const Unit&) const {}
    __device__ __forceinline__ void done(const Unit&) const {}
};

__device__ __forceinline__ unsigned cvt_pk_bf16(float lo, float hi) { unsigned r; asm volatile("v_cvt_pk_bf16_f32 %0, %1, %2" : "=v"(r) : "v"(lo), "v"(hi)); return r; }
typedef float f32x2 __attribute__((ext_vector_type(2)));
__device__ __forceinline__ f32x2 gelu_pk(f32x2 v) {
    const f32x2 av = __builtin_elementwise_abs(v), d = av * 0.2316418882f + 1.0f;
    f32x2 t; t.x = __builtin_amdgcn_rcpf(d.x); t.y = __builtin_amdgcn_rcpf(d.y);
    f32x2 q = t * 0.5307027145f + (-0.7265760135f); q = q * t + 0.7107068705f; q = q * t + (-0.142248368f); q = q * t + 0.127414796f; q = q * t;
    const f32x2 s = (v * v) * (-0.72134752044f);
    f32x2 e; e.x = __builtin_amdgcn_exp2f(s.x); e.y = __builtin_amdgcn_exp2f(s.y);
    const f32x2 m = v * (q * e), r = v - m;
    f32x2 o; o.x = v.x < 0.f ? m.x : r.x; o.y = v.y < 0.f ? m.y : r.y; return o;
}
template <class Epi, class Sched, bool ALIGN_EPI = false, bool SP2 = false>
__device__ __forceinline__ void gemm_phase(PG8_LAS unsigned char* lds, const Gemm g, const Sched& S, const Epi& E, const int wid_in) {
    const int wid = wid_in, lane = (int)__builtin_amdgcn_mbcnt_hi(~0u, __builtin_amdgcn_mbcnt_lo(~0u, 0u)), tid = wid * 64 + lane, wr = wid >> 2, wc = wid & 3, fr = lane & 15, fq = lane >> 4;
    int K_ = g.K; asm volatile("" : "+s"(K_)); const int K = K_, nt = K / BK;
    unsigned voffA[2], voffB[2];
#pragma unroll
    for (int i = 0; i < 2; ++i) { int R, C; stage_rc(tid * 16 + i * 8192, R, C); const int Rb = Epi::PERM ? ((R & ~31) + perm32(R & 31)) : R;
        voffA[i] = (unsigned)(R * K + C) * 2u; voffB[i] = (unsigned)(Rb * K + C) * 2u; }
    const size_t kstep = (size_t)(BK * 2);
    const size_t hstep = (size_t)HALF * K * 2;
    const size_t tstep = 2 * hstep;
    const unsigned ldsw = (unsigned)wid * 1024u;
    const int aoff = lds_byte(wr * 64 + fr, fq * 8), boff = lds_byte(wc * 32 + fr, fq * 8);
#define PG8_SA(b, h) (((b) * 2 + (h)) * HTB)
#define PG8_SB(b, h) ((4 + (b) * 2 + (h)) * HTB)
#define PG8_STAGE(bufoff, gbase, voff) do { _Pragma("unroll") for (int _i = 0; _i < 2; ++_i) \
        __builtin_amdgcn_global_load_lds((const unsigned*)((const char*)(gbase) + (voff)[_i]), (PG8_LAS unsigned*)(lds + (bufoff) + ldsw + _i * 8192), 16, 0, 0); } while (0)
#define PG8_LDA(dst, b, h) do { _Pragma("unroll") for (int m = 0; m < 4; ++m) _Pragma("unroll") for (int k = 0; k < 2; ++k) dst[m][k] = *(const PG8_LAS bf16x8*)(lds + PG8_SA(b, h) + aoff + m * 2048 + k * 1024); } while (0)
#define PG8_LDB(dst, b, h) do { _Pragma("unroll") for (int n = 0; n < 2; ++n) _Pragma("unroll") for (int k = 0; k < 2; ++k) dst[n][k] = *(const PG8_LAS bf16x8*)(lds + PG8_SB(b, h) + boff + n * 2048 + k * 1024); } while (0)
#define PG8_MMA(ai, bj, At, Bt) do { __builtin_amdgcn_s_setprio(1); _Pragma("unroll") for (int m = 0; m < 4; ++m) _Pragma("unroll") for (int n = 0; n < 2; ++n) _Pragma("unroll") for (int k = 0; k < 2; ++k) \
        acc[ai][bj][m][n] = __builtin_amdgcn_mfma_f32_16x16x32_bf16(Bt[n][k], At[m][k], acc[ai][bj][m][n], 0, 0, 0); __builtin_amdgcn_s_setprio(0); } while (0)
#define PG8_WAIT_V(n) asm volatile("s_waitcnt vmcnt(" #n ")" ::: "memory")
#define PG8_WAIT_L(n) asm volatile("s_waitcnt lgkmcnt(" #n ")" ::: "memory")
#define PG8_BAR __builtin_amdgcn_s_barrier()
#define PG8_SCHED __builtin_amdgcn_sched_barrier(0)
    Unit cur, nxt; int ui = 0;
    if (!S.next(0, cur)) return;
    f32x4 acc[2][2][4][2];
#pragma unroll
    for (int a = 0; a < 2; ++a)
#pragma unroll
        for (int b = 0; b < 2; ++b)
#pragma unroll
            for (int m = 0; m < 4; ++m)
#pragma unroll
                for (int n = 0; n < 2; ++n) acc[a][b][m][n] = (f32x4){0.f, 0.f, 0.f, 0.f};
    bf16x8 At[4][2], B0[2][2], B1[2][2];
    const char* cA = (const char*)g.A + (size_t)cur.pm * tstep; const char* cB = (const char*)g.Bt + (size_t)cur.pn * tstep;
    S.a_ready(cur);
    if constexpr (SP2) {
        PG8_STAGE(PG8_SB(0, 0), cB, voffB); PG8_STAGE(PG8_SB(0, 1), cB + hstep, voffB); PG8_STAGE(PG8_SA(0, 0), cA, voffA); PG8_STAGE(PG8_SA(0, 1), cA + hstep, voffA);
        if (wr == 1) PG8_BAR;
        PG8_WAIT_V(2); PG8_BAR;
        PG8_STAGE(PG8_SB(1, 0), cB + kstep, voffB); PG8_STAGE(PG8_SA(1, 0), cA + kstep, voffA); PG8_STAGE(PG8_SB(1, 1), cB + hstep + kstep, voffB);
        PG8_WAIT_V(6); PG8_BAR;
    } else {
        PG8_STAGE(PG8_SB(0, 0), cB, voffB); PG8_STAGE(PG8_SA(0, 0), cA, voffA); PG8_STAGE(PG8_SB(0, 1), cB + hstep, voffB); PG8_STAGE(PG8_SA(0, 1), cA + hstep, voffA);
        if (wr == 1) PG8_BAR;
        PG8_WAIT_V(4); PG8_BAR;
        PG8_STAGE(PG8_SB(1, 0), cB + kstep, voffB); PG8_STAGE(PG8_SA(1, 0), cA + kstep, voffA); PG8_STAGE(PG8_SB(1, 1), cB + hstep + kstep, voffB);
        PG8_WAIT_V(6); PG8_BAR;
    }
    for (;;) {
        const bool has_next = S.next(ui + 1, nxt);
        const char* nA = has_next ? (const char*)g.A + (size_t)nxt.pm * tstep : cA; const char* nB = has_next ? (const char*)g.Bt + (size_t)nxt.pn * tstep : cB;
        for (int t = 0; t < nt; t += 2) {
            const bool last = (t == nt - 2);
            const char* a1 = cA + (size_t)(t + 1) * kstep;
            const char* a2 = last ? nA : cA + (size_t)(t + 2) * kstep; const char* b2 = last ? nB : cB + (size_t)(t + 2) * kstep;
            const char* a3 = a2 + kstep; const char* b3 = b2 + kstep;
            if (last && has_next) S.a_ready(nxt);
            if constexpr (SP2) {
            PG8_LDB(B0, 0, 0); PG8_LDB(B1, 0, 1); PG8_SCHED; PG8_LDA(At, 0, 0); PG8_STAGE(PG8_SA(1, 1), a1 + hstep, voffA);
            PG8_WAIT_V(8); PG8_WAIT_L(0); PG8_BAR; PG8_MMA(0, 0, At, B0); PG8_MMA(0, 1, At, B1); PG8_BAR; PG8_SCHED;
            PG8_LDA(At, 0, 1); PG8_STAGE(PG8_SB(0, 0), b2, voffB); PG8_STAGE(PG8_SB(0, 1), b2 + hstep, voffB); PG8_STAGE(PG8_SA(0, 0), a2, voffA);
            PG8_WAIT_V(8); PG8_WAIT_L(0); PG8_BAR; PG8_MMA(1, 0, At, B0); PG8_MMA(1, 1, At, B1); PG8_BAR; PG8_SCHED;
            PG8_LDB(B0, 1, 0); PG8_LDB(B1, 1, 1); PG8_SCHED; PG8_LDA(At, 1, 0); PG8_STAGE(PG8_SA(0, 1), a2 + hstep, voffA);
            PG8_WAIT_V(8); PG8_WAIT_L(0); PG8_BAR; PG8_MMA(0, 0, At, B0); PG8_MMA(0, 1, At, B1); PG8_BAR; PG8_SCHED;
            PG8_LDA(At, 1, 1); PG8_STAGE(PG8_SB(1, 0), b3, voffB); PG8_STAGE(PG8_SB(1, 1), b3 + hstep, voffB); PG8_STAGE(PG8_SA(1, 0), a3, voffA);
            PG8_WAIT_V(8); PG8_WAIT_L(0); PG8_BAR; PG8_MMA(1, 0, At, B0); PG8_MMA(1, 1, At, B1); PG8_BAR; PG8_SCHED;
            } else {
            PG8_LDB(B0, 0, 0); PG8_SCHED; PG8_LDA(At, 0, 0); PG8_STAGE(PG8_SA(1, 1), a1 + hstep, voffA);
            PG8_WAIT_L(8); PG8_BAR; PG8_WAIT_L(0); PG8_MMA(0, 0, At, B0); PG8_BAR; PG8_SCHED;
            PG8_LDB(B1, 0, 1); PG8_STAGE(PG8_SB(0, 0), b2, voffB);
            PG8_BAR; PG8_WAIT_L(0); PG8_MMA(0, 1, At, B1); PG8_BAR;
            PG8_LDA(At, 0, 1); PG8_STAGE(PG8_SA(0, 0), a2, voffA);
            PG8_BAR; PG8_WAIT_L(0); PG8_MMA(1, 0, At, B0); PG8_BAR; PG8_SCHED;
            PG8_STAGE(PG8_SB(0, 1), b2 + hstep, voffB);
            PG8_WAIT_V(6); PG8_BAR; PG8_MMA(1, 1, At, B1); PG8_BAR;
            PG8_LDB(B0, 1, 0); PG8_SCHED; PG8_LDA(At, 1, 0); PG8_STAGE(PG8_SA(0, 1), a2 + hstep, voffA);
            PG8_WAIT_L(8); PG8_BAR; PG8_WAIT_L(0); PG8_MMA(0, 0, At, B0); PG8_BAR; PG8_SCHED;
            PG8_LDB(B1, 1, 1); PG8_STAGE(PG8_SB(1, 0), b3, voffB);
            PG8_BAR; PG8_WAIT_L(0); PG8_MMA(0, 1, At, B1); PG8_BAR;
            PG8_LDA(At, 1, 1); PG8_STAGE(PG8_SA(1, 0), a3, voffA);
            PG8_BAR; PG8_WAIT_L(0); PG8_MMA(1, 0, At, B0); PG8_BAR; PG8_SCHED;
            PG8_STAGE(PG8_SB(1, 1), b3 + hstep, voffB);
            PG8_WAIT_V(6); PG8_BAR; PG8_MMA(1, 1, At, B1); PG8_BAR;
            }
        }
        if constexpr (ALIGN_EPI) { if (wr == 0) PG8_BAR; }
        if constexpr (!Epi::AFTER_DRAIN) { E(acc, cur, wr, wc, fr, fq); S.done(cur); }
        if (!has_next) break;
#pragma unroll
        for (int a = 0; a < 2; ++a)
#pragma unroll
            for (int b = 0; b < 2; ++b)
#pragma unroll
                for (int m = 0; m < 4; ++m)
#pragma unroll
                    for (int n = 0; n < 2; ++n) acc[a][b][m][n] = (f32x4){0.f, 0.f, 0.f, 0.f};
        cur = nxt; cA = nA; cB = nB; ++ui;
        if constexpr (ALIGN_EPI) { if (wr == 1) PG8_BAR; }
    }
    PG8_WAIT_V(0);
    if constexpr (!ALIGN_EPI) { if (wr == 0) PG8_BAR; }
    PG8_BAR;
    if constexpr (Epi::AFTER_DRAIN) { E.fused(acc, cur, wr, wc, fr, fq, lds, wid, lane); S.done(cur); }
#undef PG8_SA
#undef PG8_SB
#undef PG8_STAGE
#undef PG8_LDA
#undef PG8_LDB
#undef PG8_MMA
#undef PG8_WAIT_V
#undef PG8_WAIT_L
#undef PG8_BAR
#undef PG8_SCHED
}
}
namespace att {
typedef unsigned short bf16_t;
using bf16x8 = __attribute__((ext_vector_type(8))) short;
using s16x4  = __attribute__((ext_vector_type(4))) short;
using f32x16 = __attribute__((ext_vector_type(16))) float;
using u32x4  = __attribute__((ext_vector_type(4))) unsigned;
#define SBAR() __builtin_amdgcn_sched_barrier(0)
#define ADI __device__ __forceinline__
ADI int crow(int r, int hi) { return (r & 3) + 8 * (r >> 2) + 4 * hi; }
ADI unsigned cvtpk(float lo, float hi) { unsigned r; asm volatile("v_cvt_pk_bf16_f32 %0, %1, %2" : "=v"(r) : "v"(lo), "v"(hi)); return r; }
ADI bf16x8 ld8(const bf16_t* p) { return *reinterpret_cast<const bf16x8*>(p); }

ADI void partialSM(f32x16& p0, f32x16& p1, float& m_reg, float& mn, float& alpha, const float C, const float THRS) {
  float pmax = p0[0];
#pragma unroll
  for (int r = 1; r < 16; ++r) pmax = fmaxf(pmax, p0[r]);
#pragma unroll
  for (int r = 0; r < 16; ++r) pmax = fmaxf(pmax, p1[r]);
  { auto rr = __builtin_amdgcn_permlane32_swap(__float_as_uint(pmax), __float_as_uint(pmax), false, false);
    pmax = fmaxf(__uint_as_float(rr[0]), __uint_as_float(rr[1])); }
  if (__builtin_expect(__all(pmax - m_reg <= THRS), 1)) { mn = m_reg; alpha = 1.f; }
  else { mn = fmaxf(m_reg, pmax); alpha = __builtin_amdgcn_exp2f((m_reg - mn) * C); m_reg = mn; }
  float mnC = -mn * C;
#pragma unroll
  for (int r = 0; r < 16; ++r) p0[r] = fmaf(p0[r], C, mnC);
#pragma unroll
  for (int r = 0; r < 16; ++r) p1[r] = fmaf(p1[r], C, mnC);
#pragma unroll
  for (int r = 0; r < 16; ++r) p0[r] = __builtin_amdgcn_exp2f(p0[r]);
}
ADI void finishSM(f32x16& p0, f32x16& p1, float alpha, float& l_reg, bf16x8& pa0, bf16x8& pa1, bf16x8& pa2, bf16x8& pa3) {
#pragma unroll
  for (int r = 0; r < 16; ++r) p1[r] = __builtin_amdgcn_exp2f(p1[r]);
  float ps = 0;
#pragma unroll
  for (int r = 0; r < 16; ++r) ps += p0[r];
#pragma unroll
  for (int r = 0; r < 16; ++r) ps += p1[r];
  { auto rr = __builtin_amdgcn_permlane32_swap(__float_as_uint(ps), __float_as_uint(ps), false, false);
    ps = __uint_as_float(rr[0]) + __uint_as_float(rr[1]); }
  l_reg = l_reg * alpha + ps;
#define PK4(P, BASE, OUT) do { unsigned a0 = cvtpk(P[BASE + 0], P[BASE + 1]), a1 = cvtpk(P[BASE + 2], P[BASE + 3]);   \
    unsigned b0 = cvtpk(P[BASE + 4], P[BASE + 5]), b1 = cvtpk(P[BASE + 6], P[BASE + 7]);                              \
    auto r0 = __builtin_amdgcn_permlane32_swap(a0, b0, false, false); auto r1 = __builtin_amdgcn_permlane32_swap(a1, b1, false, false); \
    u32x4 w = {r0[0], r1[0], r0[1], r1[1]}; OUT = *reinterpret_cast<bf16x8*>(&w); } while (0)
  PK4(p0, 0, pa0); PK4(p0, 8, pa1); PK4(p1, 0, pa2); PK4(p1, 8, pa3);
#undef PK4
}
template <int NKS, int KPITCH>
ADI void qkt(f32x16& p0, f32x16& p1, const char* Ks, const bf16x8* qr, int r32, int hi) {
  p0 = f32x16{}; p1 = f32x16{};
  const int sw = (r32 & 7) << 4;
#pragma unroll
  for (int d0 = 0; d0 < NKS; ++d0) { const int cb = ((d0 * 16 + hi * 8) * 2) ^ sw;
    bf16x8 b0 = *reinterpret_cast<const bf16x8*>(Ks + r32 * KPITCH + cb);
    bf16x8 b1 = *reinterpret_cast<const bf16x8*>(Ks + (32 + r32) * KPITCH + cb);
    p0 = __builtin_amdgcn_mfma_f32_32x32x16_bf16(b0, qr[d0], p0, 0, 0, 0);
    p1 = __builtin_amdgcn_mfma_f32_32x32x16_bf16(b1, qr[d0], p1, 0, 0, 0); }
}
template <int NDB> ADI int v_st(int k, int c) { const int kk = (k & ~0xC) | ((k & 4) << 1) | ((k & 8) >> 1); return ((kk >> 3) * NDB + (c >> 5)) * 512 + ((kk & 7) * 32 + (c & 31)) * 2; }
ADI int v_rd_base(int lane) { return ((lane & 3) << 3) | (((lane >> 2) & 3) << 6) | (((lane >> 4) & 1) << 5) | (((lane >> 5) & 1) << 8); }
template <int OFF> ADI s16x4 tr_read(int vb) {
  s16x4 r; asm volatile("ds_read_b64_tr_b16 %0, %1 offset:%2" : "=&v"(r) : "v"(vb), "i"(OFF) : "memory"); return r;
}
template <int D0, int NDB> ADI void pv_one(f32x16& od, int vb, bf16x8 pa0, bf16x8 pa1, bf16x8 pa2, bf16x8 pa3) {
#define VRO(ks, half) (((2 * (ks) + (half)) * NDB + D0) * 512)
  const s16x4 l0 = tr_read<VRO(0, 0)>(vb), h0 = tr_read<VRO(0, 1)>(vb), l1 = tr_read<VRO(1, 0)>(vb), h1 = tr_read<VRO(1, 1)>(vb);
  const s16x4 l2 = tr_read<VRO(2, 0)>(vb), h2 = tr_read<VRO(2, 1)>(vb), l3 = tr_read<VRO(3, 0)>(vb), h3 = tr_read<VRO(3, 1)>(vb);
#undef VRO
  asm volatile("s_waitcnt lgkmcnt(0)" ::: "memory"); SBAR();
#define PK(L, H) (bf16x8){L[0], L[1], L[2], L[3], H[0], H[1], H[2], H[3]}
  od = __builtin_amdgcn_mfma_f32_32x32x16_bf16(pa0, PK(l0, h0), od, 0, 0, 0);
  od = __builtin_amdgcn_mfma_f32_32x32x16_bf16(pa1, PK(l1, h1), od, 0, 0, 0);
  od = __builtin_amdgcn_mfma_f32_32x32x16_bf16(pa2, PK(l2, h2), od, 0, 0, 0);
  od = __builtin_amdgcn_mfma_f32_32x32x16_bf16(pa3, PK(l3, h3), od, 0, 0, 0);
#undef PK
}
template <int NDB> ADI void pv_all(f32x16* o, int vb, bf16x8 pa0, bf16x8 pa1, bf16x8 pa2, bf16x8 pa3) {
  pv_one<0, NDB>(o[0], vb, pa0, pa1, pa2, pa3); pv_one<1, NDB>(o[1], vb, pa0, pa1, pa2, pa3);
  if constexpr (NDB == 4) { pv_one<2, NDB>(o[2], vb, pa0, pa1, pa2, pa3); pv_one<3, NDB>(o[3], vb, pa0, pa1, pa2, pa3); }
}

template <int DQK, int DV> struct Cfg {
  static constexpr int KPITCH = (DQK <= 64) ? 128 : 256, SHM_K = 64 * KPITCH, SHM_V = 64 * DV * 2, NDB = DV / 32, NKS = DQK / 16;
  static constexpr int WS_OFF = 2 * SHM_V + 2 * SHM_K;
  static constexpr int STASH_OFF = WS_OFF + 8 * 64 * 4;
};

template <int DQK, int DV>
ADI void attn_core(const bf16_t* __restrict__ Qb, const bf16_t* __restrict__ Kh, const bf16_t* __restrict__ Vh, int seq, char* lds,
                   const float SCALE, f32x16 (&o)[DV / 32], float& l_reg, const int wid) {
  using CF = Cfg<DQK, DV>;
  constexpr int KPITCH = CF::KPITCH, SHM_K = CF::SHM_K, SHM_V = CF::SHM_V, NDB = CF::NDB, NKS = CF::NKS;
  const float C = SCALE * 1.4426950408889634f, THRS = 8.f / SCALE;
  const int lane = (int)__builtin_amdgcn_mbcnt_hi(~0u, __builtin_amdgcn_mbcnt_lo(~0u, 0u)), tid = wid * 64 + lane, r32 = lane & 31, hi = lane >> 5;
  char* V_lds = lds; char* K_lds = lds + 2 * SHM_V;
  float* ws = (float*)(lds + CF::WS_OFF) + wid * 64; float* al_l = ws + 32;
  float m_reg = -1e30f; l_reg = 0.f;
#pragma unroll
  for (int d = 0; d < NDB; ++d) o[d] = f32x16{};
  bf16x8 qr[NKS];
  const bf16_t* Qw = Qb + (long)(wid * 32 + r32) * DQK + hi * 8;
#pragma unroll
  for (int d0 = 0; d0 < NKS; ++d0) qr[d0] = ld8(Qw + d0 * 16);
  constexpr int KCH = DQK / 8, TPRK = (KCH <= 8) ? 8 : 16, NKL = (TPRK == 8) ? 1 : 2, KRPP = 512 / TPRK;
  constexpr int VCH = DV / 8, NVL = (VCH == 8) ? 1 : 2, VRPP = 512 / VCH;
  static_assert(VCH == 8 || VCH == 16, "DV is 64 or 128");
  const int krow = tid / TPRK, kch = tid % TPRK; const bool kvalid = kch < KCH;
  const int vrow = tid / VCH, vch = tid % VCH;
  struct { bf16x8 k0, k1, v0, v1; } sr_[2];
  const unsigned koff = (unsigned)(krow * DQK + kch * 8) * 2u, voff = (unsigned)(vrow * DV + vch * 8) * 2u;
#define LD8B(base, off) (*reinterpret_cast<const bf16x8*>((const char*)(base) + (off)))
#define SLOAD(i, kk0) do { const char* kp_ = (const char*)Kh + (size_t)(kk0) * (DQK * 2); const char* vp_ = (const char*)Vh + (size_t)(kk0) * (DV * 2); \
    if (kvalid) { sr_[i].k0 = LD8B(kp_, koff); if constexpr (NKL == 2) sr_[i].k1 = LD8B(kp_ + KRPP * DQK * 2, koff); } \
    sr_[i].v0 = LD8B(vp_, voff); if constexpr (NVL == 2) sr_[i].v1 = LD8B(vp_ + VRPP * DV * 2, voff); } while (0)
#define SWRITE(b, i) do { \
    if (kvalid) { *(bf16x8*)(K_lds + (b) * SHM_K + krow * KPITCH + ((kch * 16) ^ ((krow & 7) << 4))) = sr_[i].k0; \
      if constexpr (NKL == 2) *(bf16x8*)(K_lds + (b) * SHM_K + (krow + KRPP) * KPITCH + ((kch * 16) ^ (((krow + KRPP) & 7) << 4))) = sr_[i].k1; } \
    *(bf16x8*)(V_lds + (b) * SHM_V + v_st<NDB>(vrow, vch * 8)) = sr_[i].v0; \
    if constexpr (NVL == 2) *(bf16x8*)(V_lds + (b) * SHM_V + v_st<NDB>(vrow + VRPP, vch * 8)) = sr_[i].v1; } while (0)
#define SWAIT() do { if constexpr (NKL + NVL == 3) asm volatile("s_waitcnt vmcnt(3)" ::: "memory"); else asm volatile("s_waitcnt vmcnt(4)" ::: "memory"); } while (0)
#define RESC(a) do { if (__any((a) < 1.f)) { if (hi == 0) al_l[r32] = (a); asm volatile("s_waitcnt lgkmcnt(0)" ::: "memory"); \
    _Pragma("unroll") for (int d = 0; d < NDB; ++d) _Pragma("unroll") for (int r = 0; r < 16; ++r) o[d][r] *= al_l[crow(r, hi)]; } } while (0)
  const int vb0 = (int)(uintptr_t)(__attribute__((address_space(3))) char*)V_lds + v_rd_base(lane);
  f32x16 pA0, pA1, pB0, pB1; float mnA, mnB, alA, alB; bf16x8 pa0, pa1, pa2, pa3; const int NT = seq / 64;
  constexpr int SE = 0, SO = 1;
  SLOAD(SE, 0); asm volatile("s_waitcnt vmcnt(0)" ::: "memory"); SWRITE(0, SE); __syncthreads();
  qkt<NKS, KPITCH>(pA0, pA1, K_lds, qr, r32, hi); partialSM(pA0, pA1, m_reg, mnA, alA, C, THRS);
  SLOAD(SO, 64); if (2 < NT) SLOAD(SE, 128);
  SWAIT(); SWRITE(1, SO); __syncthreads();
  for (int j = 1; j + 1 < NT; j += 2) {
    SBAR(); qkt<NKS, KPITCH>(pB0, pB1, K_lds + SHM_K, qr, r32, hi);
    finishSM(pA0, pA1, alA, l_reg, pa0, pa1, pa2, pa3); SBAR();
    SLOAD(SO, (j + 2) * 64); SBAR();
    pv_all<NDB>(o, vb0, pa0, pa1, pa2, pa3); partialSM(pB0, pB1, m_reg, mnB, alB, C, THRS);
    __syncthreads(); SWAIT(); SWRITE(0, SE);
    RESC(alB); __syncthreads();
    SBAR(); qkt<NKS, KPITCH>(pA0, pA1, K_lds, qr, r32, hi);
    finishSM(pB0, pB1, alB, l_reg, pa0, pa1, pa2, pa3); SBAR();
    if (j + 3 < NT) SLOAD(SE, (j + 3) * 64); SBAR();
    pv_all<NDB>(o, vb0 + SHM_V, pa0, pa1, pa2, pa3); partialSM(pA0, pA1, m_reg, mnA, alA, C, THRS);
    __syncthreads(); SWAIT(); SWRITE(1, SO);
    RESC(alA); __syncthreads();
  }
  SBAR(); qkt<NKS, KPITCH>(pB0, pB1, K_lds + SHM_K, qr, r32, hi);
  finishSM(pA0, pA1, alA, l_reg, pa0, pa1, pa2, pa3); SBAR();
  pv_all<NDB>(o, vb0, pa0, pa1, pa2, pa3); partialSM(pB0, pB1, m_reg, mnB, alB, C, THRS);
  __syncthreads(); RESC(alB);
  finishSM(pB0, pB1, alB, l_reg, pa0, pa1, pa2, pa3); SBAR();
  pv_all<NDB>(o, vb0 + SHM_V, pa0, pa1, pa2, pa3);
#undef SLOAD
#undef LD8B
#undef SWRITE
#undef SWAIT
#undef RESC
}
ADI void row_inv(float l_reg, char* lds, int ws_off, float (&rli)[16], const int wid) {
  const int lane = (int)__builtin_amdgcn_mbcnt_hi(~0u, __builtin_amdgcn_mbcnt_lo(~0u, 0u)), r32 = lane & 31, hi = lane >> 5;
  float* li_l = (float*)(lds + ws_off) + wid * 64;
  if (hi == 0) li_l[r32] = l_reg;
  asm volatile("s_waitcnt lgkmcnt(0)" ::: "memory");
#pragma unroll
  for (int r = 0; r < 16; ++r) rli[r] = 1.f / li_l[crow(r, hi)];
  asm volatile("s_waitcnt lgkmcnt(0)" ::: "memory");
}
}
typedef unsigned short bf16_fwd_decl_unused;
#define GAS __attribute__((address_space(1)))
#define LAS __attribute__((address_space(3)))
#define DI __device__ __forceinline__
typedef unsigned short bf16;
typedef float f32x4 __attribute__((ext_vector_type(4)));
typedef float f32x2 __attribute__((ext_vector_type(2)));
typedef unsigned u32x4 __attribute__((ext_vector_type(4)));
typedef unsigned u32x2 __attribute__((ext_vector_type(2)));
typedef short bf16x8 __attribute__((ext_vector_type(8)));

constexpr int DM = 1024, NB = 8, SEQ = 8192, CTX = 256;
constexpr int NL = NB * SEQ, NC = NB * CTX, NR = NL + NC;
constexpr int TKV = SEQ + CTX;
constexpr int NE = 16, FFE = 1024, CAPL = 1024, CAPC = 32;
constexpr int ROWS_E = NB * CAPL + NB * CAPC;
constexpr int MT_E = ROWS_E / 256;
constexpr float DN_ALPHA = 1.4142135623730951f;
constexpr float LAM_INIT = 0.35550906759f;
constexpr int NWAVES = 8, NTHR = 512;

constexpr size_t MiB = 1u << 20;
constexpr size_t WS_CTL = 0, CTL_ZERO_BYTES = 1 * MiB;
constexpr size_t WS_MOD = 1 * MiB;
constexpr size_t WS_ROPE16 = 2 * MiB;
constexpr size_t WS_ROPE32 = 3 * MiB;
constexpr size_t WS_RQ = 5 * MiB;
constexpr size_t WS_RKV = 5 * MiB + 512 * 1024;
constexpr size_t WS_AFF = 6 * MiB;
constexpr size_t WS_AFFC = 10 * MiB;
constexpr size_t WS_ROWIDX = 11 * MiB;
constexpr size_t WS_ROWGATE = 12 * MiB;
constexpr size_t WS_SLOTROW = 13 * MiB;
constexpr size_t WS_XC = 18 * MiB;
constexpr size_t WS_GWS = 26 * MiB;
constexpr size_t WS_WIN0 = 32 * MiB;
constexpr size_t WS_WUQ = 35 * MiB;
constexpr size_t WS_WUKV = 35 * MiB + 512 * 1024;
constexpr size_t WS_WOUT0 = 36 * MiB;
constexpr size_t WS_WGU0 = 38 * MiB;
constexpr size_t WS_WDN0 = 102 * MiB;
constexpr size_t WS_WIN1 = 134 * MiB;
constexpr size_t WS_WOUT1 = 140 * MiB;
constexpr size_t WS_WGU1 = 142 * MiB;
constexpr size_t WS_WDN1 = 206 * MiB;
constexpr size_t WS_R1 = 240 * MiB, WS_R2 = 520 * MiB, WS_R3 = 800 * MiB;
constexpr size_t WS_H = WS_R3;
constexpr size_t WS_CQ = WS_R3 + 132 * MiB;
constexpr size_t WS_CKV = WS_R3 + 165 * MiB;
constexpr size_t WS_UV = WS_R1;
constexpr size_t WS_QL = WS_R2;
constexpr size_t WS_QC = WS_R2 + 96 * MiB;
constexpr size_t WS_K0 = WS_R2 + 99 * MiB;
constexpr size_t WS_V0 = WS_R2 + 198 * MiB;
constexpr size_t WS_HID = WS_R1;
constexpr size_t WS_XS = WS_R2;
constexpr size_t WS_Y = WS_R2;
constexpr size_t WS_Q1 = WS_R1;
constexpr size_t WS_K1 = WS_R1 + 128 * MiB;
constexpr size_t WS_V1 = WS_R1 + 260 * MiB;
constexpr size_t WS_O1 = WS_R1 + 392 * MiB;
constexpr size_t WS_END = 1024 * MiB;
static_assert(WS_CKV + (size_t)NR * 128 * 2 <= WS_END, "ws map");
static_assert(WS_V0 + (size_t)NB * 8 * TKV * 64 * 2 <= WS_R3, "ws map");
static_assert(WS_O1 + (size_t)NL * 1024 * 2 <= WS_R3, "ws map");
static_assert(WS_XS + (size_t)NE * ROWS_E * 1024 * 2 <= WS_R3 && WS_HID + (size_t)NE * ROWS_E * 1024 * 2 <= WS_R2, "ws map");
static_assert(WS_WDN1 + 32 * MiB <= WS_R1 && WS_SLOTROW + (size_t)NR * 16 * 4 <= WS_XC && WS_XC + (size_t)NC * 1024 * 4 <= WS_GWS, "ws map");

constexpr int CW_BAR = 4096;
constexpr int RING_BYTES = 131072, LDSCTL_OFF = RING_BYTES, MISC_OFF = LDSCTL_OFF + 320, LDS_BYTES = 147456;

struct Params {
    const float* in[41];
    float* out; unsigned char* ws;
    int ph_lo, ph_hi;
};
enum { I_X = 0, I_C, I_CTX, I_CCTX, I_WMOD0, I_BMOD0, I_WIN0, I_GLNG, I_GLNB, I_GWS, I_GBS, I_QNORM, I_WUQ, I_KVNORM, I_WUKV, I_WOUT0,
       I_LNMG0, I_LNMB0, I_ROUTER0, I_WGATE0, I_WUP0, I_WDOWN0, I_LNFG0, I_LNFB0,
       I_WMOD1, I_BMOD1, I_WIN1, I_LQ1, I_LK1, I_LQ2, I_LK2, I_SUBLN, I_WOUT1, I_LNMG1, I_LNMB1, I_ROUTER1, I_WGATE1, I_WUP1, I_WDOWN1, I_LNFG1, I_LNFB1 };

DI unsigned cvt_pk(float lo, float hi) { unsigned r; asm volatile("v_cvt_pk_bf16_f32 %0, %1, %2" : "=v"(r) : "v"(lo), "v"(hi)); return r; }
DI float bf_lo(unsigned u) { return __uint_as_float(u << 16); }
DI float bf_hi(unsigned u) { return __uint_as_float(u & 0xffff0000u); }
DI u32x4 pack8(f32x4 a, f32x4 b) { u32x4 w; w.x = cvt_pk(a[0], a[1]); w.y = cvt_pk(a[2], a[3]); w.z = cvt_pk(b[0], b[1]); w.w = cvt_pk(b[2], b[3]); return w; }
DI float wave_sum(float v) {
#pragma unroll
    for (int o = 1; o < 64; o <<= 1) v += __shfl_xor(v, o);
    return v;
}
DI float wave_max(float v) {
#pragma unroll
    for (int o = 1; o < 64; o <<= 1) v = fmaxf(v, __shfl_xor(v, o));
    return v;
}
#define LDS_WAIT() asm volatile("s_waitcnt lgkmcnt(0)" ::: "memory")
#define VM_WAIT() asm volatile("s_waitcnt vmcnt(0)" ::: "memory")

DI void row_info(int row, int& b, int& tpos, int& t_rope) {
    if (row < NL) { b = row >> 13; tpos = row & (SEQ - 1); t_rope = tpos; }
    else { const int j = row - NL; b = j >> 8; tpos = SEQ + (j & (CTX - 1)); t_rope = -1; }
}
DI void rope8(f32x4& v0, f32x4& v1, const f32x2* cs) {
    const f32x2 c0 = cs[0], c1 = cs[1], c2 = cs[2], c3 = cs[3];
    float a, b;
    a = v0[0]; b = v0[1]; v0[0] = a * c0.x - b * c0.y; v0[1] = a * c0.y + b * c0.x;
    a = v0[2]; b = v0[3]; v0[2] = a * c1.x - b * c1.y; v0[3] = a * c1.y + b * c1.x;
    a = v1[0]; b = v1[1]; v1[0] = a * c2.x - b * c2.y; v1[1] = a * c2.y + b * c2.x;
    a = v1[2]; b = v1[3]; v1[2] = a * c3.x - b * c3.y; v1[3] = a * c3.y + b * c3.x;
}

using pg8::Unit;
#define EPI_ARGS const f32x4 (&acc)[2][2][4][2], const Unit& u, int wr, int wc, int fr, int fq
#define EPI_FOR_ROWS _Pragma("unroll") for (int ai = 0; ai < 2; ++ai) _Pragma("unroll") for (int m = 0; m < 4; ++m)
#define EPI_ROW (u.pm * 256 + ai * 128 + wr * 64 + m * 16 + fr)
#define EPI_FOR_COLS _Pragma("unroll") for (int bj = 0; bj < 2; ++bj)
#define EPI_LCOL (bj * 128 + wc * 32 + 8 * fq)

DI f32x4 gelu4(f32x4 v) { f32x2 a = pg8::gelu_pk((f32x2){v[0], v[1]}), b = pg8::gelu_pk((f32x2){v[2], v[3]}); return (f32x4){a.x, a.y, b.x, b.y}; }

#define ST16(base, off, val) (*(u32x4*)((char*)(base) + (unsigned)(off)) = (val))
#define EPI_ROW_END __builtin_amdgcn_sched_barrier(0)
struct EpiA0 {
    static constexpr bool PERM = true, AFTER_DRAIN = false;
    unsigned char* ws; const f32x2* rope16;
    DI void operator()(EPI_ARGS) const {
        const int pn = u.pn;
        EPI_FOR_ROWS { const unsigned row = (unsigned)EPI_ROW;
            EPI_FOR_COLS { const unsigned lcol = (unsigned)EPI_LCOL; f32x4 v0 = acc[ai][bj][m][0], v1 = acc[ai][bj][m][1];
                if (pn < 4) { v0 = gelu4(v0); v1 = gelu4(v1); ST16(ws, (unsigned)WS_UV + (row * 1024u + (unsigned)pn * 256u + lcol) * 2u, pack8(v0, v1)); }
                else if (pn == 4) { ST16(ws, (unsigned)WS_CQ + (row * 256u + lcol) * 2u, pack8(v0, v1)); }
                else if (lcol < 128u) { ST16(ws, (unsigned)WS_CKV + (row * 128u + lcol) * 2u, pack8(v0, v1)); }
                else if (lcol < 160u) {
                    int b, tpos, tr; row_info((int)row, b, tpos, tr);
                    if (tr >= 0) rope8(v0, v1, (const f32x2*)((const char*)rope16 + (unsigned)(tr * 16 + (int)((lcol - 128u) >> 1)) * 8u));
                    const u32x4 w = pack8(v0, v1);
                    const unsigned o0 = (unsigned)WS_K0 + ((unsigned)(b * 8 * TKV + tpos) * 96u + 64u + (lcol - 128u)) * 2u;
#pragma unroll
                    for (int h = 0; h < 8; ++h) ST16(ws, o0 + (unsigned)h * (unsigned)(TKV * 96 * 2), w);
                }
            } EPI_ROW_END; }
    }
};
struct EpiQ {
    static constexpr bool PERM = true, AFTER_DRAIN = false;
    unsigned char* ws; const float* rq; const f32x2* rope16;
    DI void operator()(EPI_ARGS) const {
        EPI_FOR_ROWS { const int row = EPI_ROW; const float r = rq[row]; int b, tpos, tr; row_info(row, b, tpos, tr);
            const bool lat = tr >= 0; unsigned char* base = ws;
            const unsigned rowoff = lat ? (unsigned)WS_QL + (unsigned)(b * 8 * SEQ + tpos) * 192u : (unsigned)WS_QC + (unsigned)(b * 8 * CTX + (tpos - SEQ)) * 192u;
            const unsigned hstride = lat ? (unsigned)(SEQ * 192) : (unsigned)(CTX * 192);
            EPI_FOR_COLS { const unsigned col = (unsigned)(u.pn * 256 + EPI_LCOL); f32x4 v0 = acc[ai][bj][m][0] * r, v1 = acc[ai][bj][m][1] * r;
                const unsigned h = (col * 683u) >> 16;
                const unsigned d = col - h * 96u;
                if (d >= 64u && lat) rope8(v0, v1, (const f32x2*)((const char*)rope16 + (unsigned)(tr * 16 + (int)((d - 64u) >> 1)) * 8u));
                ST16(base, rowoff + h * hstride + d * 2u, pack8(v0, v1));
            } EPI_ROW_END; }
    }
};
struct EpiKV {
    static constexpr bool PERM = true, AFTER_DRAIN = false;
    unsigned char* ws; const float* rkv;
    DI void operator()(EPI_ARGS) const {
        EPI_FOR_ROWS { const int row = EPI_ROW; const float r = rkv[row]; int b, tpos, tr; row_info(row, b, tpos, tr);
            const unsigned tok = (unsigned)(b * 8 * TKV + tpos);
            EPI_FOR_COLS { const unsigned col = (unsigned)(u.pn * 256 + EPI_LCOL); const f32x4 v0 = acc[ai][bj][m][0] * r, v1 = acc[ai][bj][m][1] * r;
                const unsigned h = col >> 7, d = col & 127u; const unsigned th = tok + h * (unsigned)TKV;
                const unsigned off = (d < 64u) ? (unsigned)WS_K0 + (th * 96u + d) * 2u : (unsigned)WS_V0 + (th * 64u + (d - 64u)) * 2u;
                ST16(ws, off, pack8(v0, v1));
            } EPI_ROW_END; }
    }
};
struct EpiOut {
    static constexpr bool PERM = true, AFTER_DRAIN = false;
    const float* xl; const float* xc; float* tl; float* tc; const float* gmod;
    DI void operator()(EPI_ARGS) const {
        EPI_FOR_ROWS { const int row = EPI_ROW; const bool lat = row < NL; const int b = lat ? (row >> 13) : 8;
            const char* xs = (const char*)(lat ? xl : xc); char* ts = (char*)(lat ? tl : tc); const unsigned roff = (unsigned)(lat ? row : row - NL) * 4096u;
            EPI_FOR_COLS { const unsigned col = (unsigned)(u.pn * 256 + EPI_LCOL); const f32x4 v0 = acc[ai][bj][m][0], v1 = acc[ai][bj][m][1];
                const f32x4 x0 = *(const f32x4*)(xs + (roff + col * 4u)), x1 = *(const f32x4*)(xs + (roff + col * 4u + 16u));
                const f32x4 g0 = *(const f32x4*)((const char*)gmod + ((unsigned)b * 6144u + col) * 4u), g1 = *(const f32x4*)((const char*)gmod + ((unsigned)b * 6144u + col) * 4u + 16u);
                *(f32x4*)(ts + (roff + col * 4u)) = x0 * DN_ALPHA + (g0 + 1.f) * v0; *(f32x4*)(ts + (roff + col * 4u + 16u)) = x1 * DN_ALPHA + (g1 + 1.f) * v1;
            } EPI_ROW_END; }
    }
};
struct EpiMoe1 {
    static constexpr bool PERM = true, AFTER_DRAIN = false;
    bf16* HID; int nN;
    DI void operator()(EPI_ARGS) const {
        const int e = u.pm / MT_E, pnl = u.pn - e * nN;
        EPI_FOR_ROWS { const unsigned row = (unsigned)EPI_ROW;
            EPI_FOR_COLS { const unsigned col = (unsigned)(pnl * 256 + EPI_LCOL); const f32x4 g = acc[ai][bj][m][0], up = acc[ai][bj][m][1];
                f32x4 h;
#pragma unroll
                for (int i = 0; i < 4; ++i) h[i] = g[i] / (1.f + __expf(-g[i])) * up[i];
                u32x2 w; w.x = cvt_pk(h[0], h[1]); w.y = cvt_pk(h[2], h[3]);
                *(u32x2*)((char*)HID + (row * 2048u + col)) = w;
            } EPI_ROW_END; }
    }
};
struct EpiMoe2 {
    static constexpr bool PERM = true, AFTER_DRAIN = false;
    bf16* Y; const float* gate; int nN;
    DI void operator()(EPI_ARGS) const {
        const int e = u.pm / MT_E, pnl = u.pn - e * nN;
        EPI_FOR_ROWS { const unsigned row = (unsigned)EPI_ROW; const float g = gate[row];
            EPI_FOR_COLS { const unsigned col = (unsigned)(pnl * 256 + EPI_LCOL);
                ST16(Y, (row * 1024u + col) * 2u, pack8(acc[ai][bj][m][0] * g, acc[ai][bj][m][1] * g));
            } EPI_ROW_END; }
    }
};
struct EpiA1 {
    static constexpr bool PERM = true, AFTER_DRAIN = false;
    unsigned char* ws; const f32x2* rope32; int row_off, col_off;
    DI void operator()(EPI_ARGS) const {
        const unsigned colt = (unsigned)(col_off + u.pn * 256); const unsigned s = colt >> 10;
        unsigned char* base = ws;
        EPI_FOR_ROWS { const int row = row_off + EPI_ROW; int b, tpos, tr; row_info(row, b, tpos, tr);
            const unsigned tq = (unsigned)(b * 16 * SEQ + tpos), tk = (unsigned)(b * 16 * TKV + tpos), tv = (unsigned)(b * 8 * TKV + tpos);
            EPI_FOR_COLS { const unsigned sc = (colt & 1023u) + (unsigned)EPI_LCOL; f32x4 v0 = acc[ai][bj][m][0], v1 = acc[ai][bj][m][1];
                unsigned off;
                if (s == 2) off = (unsigned)WS_V1 + ((tv + (sc >> 7) * (unsigned)TKV) * 128u + (sc & 127u)) * 2u;
                else { const unsigned hh = sc >> 6, d = sc & 63u;
                    if (tr >= 0) rope8(v0, v1, (const f32x2*)((const char*)rope32 + (unsigned)(tr * 32 + (int)(d >> 1)) * 8u));
                    off = (s == 0) ? (unsigned)WS_Q1 + ((tq + hh * (unsigned)SEQ) * 64u + d) * 2u : (unsigned)WS_K1 + ((tk + hh * (unsigned)TKV) * 64u + d) * 2u; }
                ST16(base, off, pack8(v0, v1));
            } EPI_ROW_END; }
    }
};

struct GroupedOrder {
    int MT, nN, c, G;
    DI bool next(int i, Unit& u) const {
        const int x = c & 7, j = c >> 3, per = G >> 3, q = i * per + j, per_e = MT * nN;
        if (q >= 2 * per_e) return false;
        const int el = q / per_e, rem = q - el * per_e, e = 2 * x + el;
        const int nig = 8 * nN, gid = rem / nig, fm = gid * 8, gsz = (MT - fm) < 8 ? (MT - fm) : 8, w = rem - gid * nig;
        u.pm = e * MT_E + fm + (w % gsz); u.pn = e * nN + (w / gsz); return true;
    }
    DI void a_ready(const Unit&) const {}
    DI void done(const Unit&) const {}
};
#define XB_TMO      128
#define XB_XCNT(j)  (256  + 64 * (j))
#define XB_XSUB(j)  (1280 + 64 * (j))
#define XB_XGEN(j)  (2304 + 64 * (j))
#define XB_TOP      3328
#define XB_TOPGEN   3392
#define XCD_BAR_WORDS 3456
#define XB_SPIN_CAP (1u << 18)

__device__ __forceinline__ unsigned xb_ld(unsigned* p)              { return __hip_atomic_load(p, __ATOMIC_RELAXED, __HIP_MEMORY_SCOPE_AGENT); }
__device__ __forceinline__ unsigned xb_add(unsigned* p, unsigned v) { return __hip_atomic_fetch_add(p, v, __ATOMIC_RELAXED, __HIP_MEMORY_SCOPE_AGENT); }
__device__ __forceinline__ unsigned xb_xcc_id() { return (unsigned)__builtin_amdgcn_s_getreg((3 << 11) | 20) & 0xFu; }
#define XB_SPIN(cond, bar) do { unsigned _sp = 0; while (cond) { __builtin_amdgcn_s_sleep(1); \
    if ((++_sp & 255u) == 0u) { if (xb_ld(&(bar)[XB_TMO])) break; if (_sp > XB_SPIN_CAP) { atomicAdd(&(bar)[XB_TMO], 1u); break; } } } } while (0)

struct XcdBarrier {
    unsigned* bar; unsigned x;
    volatile LAS unsigned* st;
};

__device__ __forceinline__ bool xb_thread0(const int wid) { return wid == 0 && __builtin_amdgcn_mbcnt_hi(~0u, __builtin_amdgcn_mbcnt_lo(~0u, 0u)) == 0u; }
__device__ __forceinline__ XcdBarrier xcd_barrier_post(unsigned* bar, volatile LAS unsigned* st, const int wid) {
    XcdBarrier b; b.bar = bar; b.x = xb_xcc_id(); b.st = st;
    if (xb_thread0(wid)) (void)xb_add(&bar[XB_XCNT(b.x)], 1u);
    return b;
}
__device__ __forceinline__ void xcd_barrier_complete(unsigned* bar, unsigned x, unsigned& nloc, unsigned& nx) {
    const unsigned G = gridDim.x * gridDim.y * gridDim.z;
    unsigned sum, cnt, mine, sp = 0u;
    for (;;) {
        sum = 0u; cnt = 0u; mine = 0u;
#pragma unroll
        for (unsigned j = 0; j < 16; ++j) { const unsigned c = xb_ld(&bar[XB_XCNT(j)]); sum += c; cnt += (c > 0u) ? 1u : 0u; mine = (j == x) ? c : mine; }
        if (sum == G) break;
        __builtin_amdgcn_s_sleep(1);
        if ((++sp & 255u) == 0u) { if (xb_ld(&bar[XB_TMO])) break; if (sp > XB_SPIN_CAP) { atomicAdd(&bar[XB_TMO], 1u); break; } }
    }
    nloc = mine > 0u ? mine : 1u; nx = cnt > 0u ? cnt : 1u;
}

__device__ __forceinline__ void xcd_barrier(const XcdBarrier& b, const int wid) {
    asm volatile("s_waitcnt vmcnt(0)" ::: "memory");
    __syncthreads();
    if (xb_thread0(wid)) {
        unsigned* bar = b.bar;
        __builtin_amdgcn_s_waitcnt(0);
        unsigned nloc = b.st[0], nx = b.st[1];
        if (nloc == 0u) { xcd_barrier_complete(bar, b.x, nloc, nx); b.st[0] = nloc; b.st[1] = nx; }
        const unsigned old = xb_add(&bar[XB_XSUB(b.x)], 1u);
        const unsigned gen = old / nloc;
        if (old + 1u == (gen + 1u) * nloc) {
            __builtin_amdgcn_fence(__ATOMIC_RELEASE, "agent");
            asm volatile("s_waitcnt vmcnt(0)" ::: "memory");
            const unsigned og = xb_add(&bar[XB_TOP], 1u);
            const unsigned tg = og / nx;
            if (og + 1u == (tg + 1u) * nx) xb_add(&bar[XB_TOPGEN], 1u);
            else XB_SPIN(xb_ld(&bar[XB_TOPGEN]) == tg, bar);
            __builtin_amdgcn_fence(__ATOMIC_ACQUIRE, "agent");
            xb_add(&bar[XB_XGEN(b.x)], 1u);
            asm volatile("s_waitcnt vmcnt(0)" ::: "memory");
        } else {
            XB_SPIN(xb_ld(&bar[XB_XGEN(b.x)]) == gen, bar);
            __builtin_amdgcn_fence(__ATOMIC_ACQUIRE, "agent");
            asm volatile("s_waitcnt vmcnt(0)" ::: "memory");
        }
    }
    __syncthreads();
}
__device__ const float INVF8[8] = {1.000000000e+00f, 3.162277639e-01f, 1.000000015e-01f, 3.162277490e-02f, 9.999999776e-03f, 3.162277630e-03f, 1.000000047e-03f, 3.162277571e-04f};
__device__ const float INVF16[16] = {1.000000000e+00f, 5.623413324e-01f, 3.162277639e-01f, 1.778279394e-01f, 1.000000015e-01f, 5.623413250e-02f, 3.162277490e-02f, 1.778279431e-02f,
                                     9.999999776e-03f, 5.623413250e-03f, 3.162277630e-03f, 1.778279431e-03f, 1.000000047e-03f, 5.623413017e-04f, 3.162277571e-04f, 1.778279402e-04f};
struct Ctx {
    unsigned char* lds; int tid, lane, wave, bid, G, gw, NGW;
};
DI Ctx make_ctx(unsigned char* lds, const int wid) {
    Ctx c; c.lds = lds; c.lane = (int)__builtin_amdgcn_mbcnt_hi(~0u, __builtin_amdgcn_mbcnt_lo(~0u, 0u)); c.wave = wid; c.tid = wid * 64 + c.lane;
    c.bid = blockIdx.x; c.G = gridDim.x; c.gw = c.bid * NWAVES + c.wave; c.NGW = c.G * NWAVES; return c;
}

template <int MODE>
DI void transpose_item(const float* W, int K, int N, bf16* WT, LAS float* scr, int item, int lane, const float* kgain, int which) {
    const int nblk = N / 32, kb = item / nblk, nb = item - kb * nblk, k0 = 64 * kb, n0 = 32 * nb;
#pragma unroll 8
    for (int i = 0; i < 32; ++i) { const int kk = 2 * i + (lane >> 5); const float g = kgain ? kgain[k0 + kk] : 1.f; scr[kk * 33 + (lane & 31)] = W[(size_t)(k0 + kk) * N + n0 + (lane & 31)] * g; }
    LDS_WAIT(); asm volatile("" ::: "memory");
    const int c = lane & 7;
#pragma unroll
    for (int j = 0; j < 4; ++j) { const int n = (lane >> 3) + 8 * j; const LAS float* s = scr + (8 * c) * 33 + n;
        u32x4 o; o.x = cvt_pk(s[0 * 33], s[1 * 33]); o.y = cvt_pk(s[2 * 33], s[3 * 33]); o.z = cvt_pk(s[4 * 33], s[5 * 33]); o.w = cvt_pk(s[6 * 33], s[7 * 33]);
        const int nn = n0 + n; const int drow = MODE ? (((nn >> 2) << 3) + which * 4 + (nn & 3)) : nn;
        *(u32x4*)(WT + (size_t)drow * K + k0 + 8 * c) = o; }
    LDS_WAIT(); asm volatile("" ::: "memory");
}

DI void phase_prologue(const Params& p, const Ctx& c) {
    unsigned char* ws = p.ws;
    float* MOD = (float*)(ws + WS_MOD);
    for (int unit = c.bid; unit < 192; unit += c.G) {
        const int l = unit / 96, c0 = (unit % 96) * 64;
        float* sl = (float*)c.lds;
        for (int i = c.tid; i < 9 * 1024; i += NTHR) { const int bb = i >> 10, k = i & 1023; const float cv = bb < 8 ? p.in[I_C][bb * 1024 + k] : p.in[I_CCTX][k]; sl[i] = cv / (1.f + expf(-cv)); }
        __syncthreads();
        const float* W = p.in[l ? I_WMOD1 : I_WMOD0]; const float* bm = p.in[l ? I_BMOD1 : I_BMOD0];
        float a0 = 0, a1 = 0, a2 = 0, a3 = 0, a4 = 0, a5 = 0, a6 = 0, a7 = 0, a8 = 0;
        const int col = c0 + c.lane, ks = c.wave * 128;
        for (int k = ks; k < ks + 128; ++k) { const float w = W[(size_t)k * 6144 + col];
            a0 += sl[k] * w; a1 += sl[1024 + k] * w; a2 += sl[2048 + k] * w; a3 += sl[3072 + k] * w; a4 += sl[4096 + k] * w;
            a5 += sl[5120 + k] * w; a6 += sl[6144 + k] * w; a7 += sl[7168 + k] * w; a8 += sl[8192 + k] * w; }
        float* red = sl + 9 * 1024;
        float* rw = red + (c.wave * 9) * 64 + c.lane;
        rw[0] = a0; rw[64] = a1; rw[128] = a2; rw[192] = a3; rw[256] = a4; rw[320] = a5; rw[384] = a6; rw[448] = a7; rw[512] = a8;
        __syncthreads();
        for (int i = c.tid; i < 9 * 64; i += NTHR) { const int bb = i >> 6, cc = i & 63; float s = 0.f;
#pragma unroll
            for (int w = 0; w < 8; ++w) s += red[(w * 9 + bb) * 64 + cc];
            MOD[(size_t)(l * 9 + bb) * 6144 + c0 + cc] = s + bm[c0 + cc]; }
        __syncthreads();
    }
    LAS float* scr = (LAS float*)((LAS unsigned char*)c.lds + c.wave * 16384);
    constexpr int IT_IN0 = 16 * 45, IT_UQ = 4 * 24, IT_UKV = 2 * 32, IT_SQ = 16 * 32, IT_IN1 = 16 * 96, IT_MOE = 2 * 3 * 16 * 512;
    constexpr int NITEMS = IT_IN0 + IT_UQ + IT_UKV + IT_SQ + IT_IN1 + IT_SQ + IT_MOE;
    for (int it = c.gw; it < NITEMS; it += c.NGW) {
        int r = it;
        if (r < IT_IN0) { transpose_item<0>(p.in[I_WIN0], 1024, 1440, (bf16*)(ws + WS_WIN0), scr, r, c.lane, nullptr, 0); continue; } r -= IT_IN0;
        if (r < IT_UQ) { transpose_item<0>(p.in[I_WUQ], 256, 768, (bf16*)(ws + WS_WUQ), scr, r, c.lane, p.in[I_QNORM], 0); continue; } r -= IT_UQ;
        if (r < IT_UKV) { transpose_item<0>(p.in[I_WUKV], 128, 1024, (bf16*)(ws + WS_WUKV), scr, r, c.lane, p.in[I_KVNORM], 0); continue; } r -= IT_UKV;
        if (r < IT_SQ) { transpose_item<0>(p.in[I_WOUT0], 1024, 1024, (bf16*)(ws + WS_WOUT0), scr, r, c.lane, nullptr, 0); continue; } r -= IT_SQ;
        if (r < IT_IN1) { transpose_item<0>(p.in[I_WIN1], 1024, 3072, (bf16*)(ws + WS_WIN1), scr, r, c.lane, nullptr, 0); continue; } r -= IT_IN1;
        if (r < IT_SQ) { transpose_item<0>(p.in[I_WOUT1], 1024, 1024, (bf16*)(ws + WS_WOUT1), scr, r, c.lane, nullptr, 0); continue; } r -= IT_SQ;
        const int l = r / (3 * 16 * 512), kind = (r / (16 * 512)) % 3, e = (r / 512) & 15, item = r & 511;
        if (kind < 2) { const float* W = p.in[l ? (kind ? I_WUP1 : I_WGATE1) : (kind ? I_WUP0 : I_WGATE0)] + (size_t)e * 1024 * 1024;
            transpose_item<1>(W, 1024, 1024, (bf16*)(ws + (l ? WS_WGU1 : WS_WGU0)) + (size_t)e * 2048 * 1024, scr, item, c.lane, nullptr, kind); }
        else { const float* W = p.in[l ? I_WDOWN1 : I_WDOWN0] + (size_t)e * 1024 * 1024;
            transpose_item<0>(W, 1024, 1024, (bf16*)(ws + (l ? WS_WDN1 : WS_WDN0)) + (size_t)e * 1024 * 1024, scr, item, c.lane, nullptr, 0); }
    }
    const int gt = c.bid * NTHR + c.tid, NGT = c.G * NTHR;
    f32x2* R16 = (f32x2*)(ws + WS_ROPE16); f32x2* R32 = (f32x2*)(ws + WS_ROPE32);
    for (int i = gt; i < SEQ * 48; i += NGT) { const int t = i / 48, jj = i - t * 48;
        int nf, j; if (jj < 16) { nf = 8; j = jj; } else { nf = 16; j = jj - 16; }
        const int f = j < nf ? j : j - nf; const float pos = (float)(j < nf ? (t >> 6) : (t & 63));
        const float invf = (nf == 8) ? INVF8[f] : INVF16[f];
        const float ang = pos * invf; const double da = (double)ang;
        const double qd = rint(da * 0.6366197723675814); const double y = fma(-qd, 1.5707963267948966, da) - qd * 6.123233995736766e-17; const double y2 = y * y;
        const double sy = y * (1.0 + y2 * (-1.0 / 6 + y2 * (1.0 / 120 + y2 * (-1.0 / 5040 + y2 * (1.0 / 362880 + y2 * (-1.0 / 39916800))))));
        const double cy = 1.0 + y2 * (-0.5 + y2 * (1.0 / 24 + y2 * (-1.0 / 720 + y2 * (1.0 / 40320 + y2 * (-1.0 / 3628800 + y2 * (1.0 / 479001600))))));
        const int qi = ((int)qd) & 3;
        const double cr = (qi == 0) ? cy : (qi == 1) ? -sy : (qi == 2) ? -cy : sy, sr = (qi == 0) ? sy : (qi == 1) ? cy : (qi == 2) ? -sy : -cy;
        const f32x2 cs = {(float)cr, (float)sr};
        if (jj < 16) R16[t * 16 + j] = cs; else R32[t * 32 + j] = cs; }
    bf16* GW = (bf16*)(ws + WS_GWS);
    for (int i = gt; i < 4 * 128 * 128 / 2; i += NGT) { const f32x2 v = *(const f32x2*)(p.in[I_GWS] + 2 * i); ((unsigned*)GW)[i] = cvt_pk(v.x, v.y); }
    unsigned* padz = (unsigned*)((bf16*)(ws + WS_WIN0) + (size_t)1440 * 1024);
    for (int i = gt; i < 96 * 1024 / 2; i += NGT) padz[i] = 0u;
}

DI void phase_mod_rows(const Ctx& c, const float* xl, const float* xc, const float* mod  , int sh_off, int sc_off, bf16* H) {
    for (int row = c.gw; row < NR; row += c.NGW) {
        const bool lat = row < NL; const int b = lat ? (row >> 13) : 8;
        const float* xs = lat ? xl + (size_t)row * 1024 : xc + (size_t)(row - NL) * 1024;
#pragma unroll
        for (int j = 0; j < 4; ++j) { const int col = 4 * c.lane + 256 * j;
            const f32x4 x = *(const f32x4*)(xs + col), sc = *(const f32x4*)(mod + b * 6144 + sc_off + col), sh = *(const f32x4*)(mod + b * 6144 + sh_off + col);
            const f32x4 h = x * (sc + 1.f) + sh;
            u32x2 w; w.x = cvt_pk(h[0], h[1]); w.y = cvt_pk(h[2], h[3]);
            *(u32x2*)(H + (size_t)row * 1024 + col) = w; }
    }
}

DI void phase_gmlp(const Params& p, const Ctx& c) {
    unsigned char* ws = p.ws;
    bf16* UV = (bf16*)(ws + WS_UV); const bf16* CQ = (const bf16*)(ws + WS_CQ); const bf16* CKV = (const bf16*)(ws + WS_CKV);
    float* RQ = (float*)(ws + WS_RQ); float* RKV = (float*)(ws + WS_RKV); const bf16* GW = (const bf16*)(ws + WS_GWS);
    const float* lng = p.in[I_GLNG]; const float* lnb = p.in[I_GLNB]; const float* bs = p.in[I_GBS];
    constexpr int PITCH = 136;
    bf16* WsL = (bf16*)c.lds;
    bf16* VT = WsL + 128 * PITCH;
    f32x2* st = (f32x2*)(VT + 128 * PITCH);
    const int tk = c.tid >> 2, part = c.tid & 3;
    for (int unit = c.bid; unit < (NR / 128) * 4; unit += c.G) {
        const int ch = unit >> 2, g = unit & 3, row0 = ch * 128;
        {
            const bf16* vrow = UV + (size_t)(row0 + tk) * 1024 + 512 + part * 128; float s = 0.f, s2 = 0.f;
#pragma unroll
            for (int i = 0; i < 16; ++i) { const u32x4 w = *(const u32x4*)(vrow + 8 * i);
#pragma unroll
                for (int k = 0; k < 4; ++k) { const float a = bf_lo(w[k]), b = bf_hi(w[k]); s += a + b; s2 += a * a + b * b; } }
            s += __shfl_xor(s, 1); s += __shfl_xor(s, 2); s2 += __shfl_xor(s2, 1); s2 += __shfl_xor(s2, 2);
            const float mean = s * (1.f / 512.f), var = fmaxf(s2 * (1.f / 512.f) - mean * mean, 0.f);
            if (part == 0) st[tk] = (f32x2){mean, 1.f / sqrtf(var + 1e-5f)};
            if (g == 0) {
                const bf16* q = CQ + (size_t)(row0 + tk) * 256 + part * 64; float ss = 0.f;
#pragma unroll
                for (int i = 0; i < 8; ++i) { const u32x4 w = *(const u32x4*)(q + 8 * i);
#pragma unroll
                    for (int k = 0; k < 4; ++k) { const float a = bf_lo(w[k]), b = bf_hi(w[k]); ss += a * a + b * b; } }
                ss += __shfl_xor(ss, 1); ss += __shfl_xor(ss, 2);
                const bf16* kv = CKV + (size_t)(row0 + tk) * 128 + part * 32; float sk = 0.f;
#pragma unroll
                for (int i = 0; i < 4; ++i) { const u32x4 w = *(const u32x4*)(kv + 8 * i);
#pragma unroll
                    for (int k = 0; k < 4; ++k) { const float a = bf_lo(w[k]), b = bf_hi(w[k]); sk += a * a + b * b; } }
                sk += __shfl_xor(sk, 1); sk += __shfl_xor(sk, 2);
                if (part == 0) { RQ[row0 + tk] = 1.f / sqrtf(ss * (1.f / 256.f) + 1e-6f); RKV[row0 + tk] = 1.f / sqrtf(sk * (1.f / 128.f) + 1e-6f); }
            }
        }
        for (int i = c.tid; i < 2048; i += NTHR) { const int pr = i >> 4, qc = (i & 15) * 8; *(u32x4*)(WsL + pr * PITCH + qc) = *(const u32x4*)(GW + (size_t)g * 16384 + pr * 128 + qc); }
        __syncthreads();
        {
            const f32x2 ms = st[tk]; const bf16* vrow = UV + (size_t)(row0 + tk) * 1024 + 512 + g * 128 + part * 32;
#pragma unroll
            for (int i = 0; i < 4; ++i) { const u32x4 w = *(const u32x4*)(vrow + 8 * i);
#pragma unroll
                for (int k = 0; k < 4; ++k) { const int cc = part * 32 + 8 * i + 2 * k; const int cg = g * 128 + cc;
                    const float a = (bf_lo(w[k]) - ms.x) * ms.y * lng[cg] + lnb[cg], b = (bf_hi(w[k]) - ms.x) * ms.y * lng[cg + 1] + lnb[cg + 1];
                    const unsigned pk = cvt_pk(a, b);
                    VT[cc * PITCH + tk] = (bf16)(pk & 0xffffu); VT[(cc + 1) * PITCH + tk] = (bf16)(pk >> 16); } }
        }
        __syncthreads();
        f32x4 acc[8];
#pragma unroll
        for (int pt = 0; pt < 8; ++pt) acc[pt] = (f32x4){0.f, 0.f, 0.f, 0.f};
        const int fr = c.lane & 15, fq = c.lane >> 4;
#pragma unroll
        for (int ks = 0; ks < 4; ++ks) {
            const bf16x8 a = *(const bf16x8*)(VT + (16 * c.wave + fr) * PITCH + 32 * ks + 8 * fq);
#pragma unroll
            for (int pt = 0; pt < 8; ++pt) { const bf16x8 b = *(const bf16x8*)(WsL + (16 * pt + fr) * PITCH + 32 * ks + 8 * fq);
                acc[pt] = __builtin_amdgcn_mfma_f32_16x16x32_bf16(a, b, acc[pt], 0, 0, 0); }
        }
#pragma unroll
        for (int pt = 0; pt < 8; ++pt) { const int pp = 16 * pt + fr; const float bias = bs[g * 128 + pp];
            bf16* up = UV + (size_t)(row0 + pp) * 1024 + g * 128 + 16 * c.wave + 4 * fq;
            const u32x2 uu = *(const u32x2*)up;
            u32x2 w; w.x = cvt_pk(bf_lo(uu.x) * (acc[pt][0] + bias), bf_hi(uu.x) * (acc[pt][1] + bias)); w.y = cvt_pk(bf_lo(uu.y) * (acc[pt][2] + bias), bf_hi(uu.y) * (acc[pt][3] + bias));
            *(u32x2*)up = w; }
        __syncthreads();
    }
}

DI void phase_ln_router(const Ctx& c, float* TL, float* TC, const float* lng, const float* lnb, const float* mod  , const float* router  ,
                        bf16* H, float* AFF, float* AFFC, int nrows) {
    float* rt = (float*)c.lds;
    for (int i = c.tid; i < 16384; i += NTHR) { const int k = i >> 4, e = i & 15; rt[e * 1024 + k] = router[i]; }
    __syncthreads();
    for (int row = c.gw; row < nrows; row += c.NGW) {
        const bool lat = row < NL; const int b = lat ? (row >> 13) : 8;
        float* ts = lat ? TL + (size_t)row * 1024 : TC + (size_t)(row - NL) * 1024;
        float s = 0.f, s2 = 0.f;
#pragma unroll 4
        for (int k = 0; k < 16; ++k) { const float x = ts[c.lane + 64 * k]; s += x; s2 += x * x; }
        const float mean = wave_sum(s) * (1.f / 1024.f);
        const float rstd = 1.f / sqrtf(fmaxf(wave_sum(s2) * (1.f / 1024.f) - mean * mean, 0.f) + 1e-5f);
        float lg[16];
#pragma unroll
        for (int e = 0; e < 16; ++e) lg[e] = 0.f;
        const float* mrow = mod + b * 6144;
#pragma unroll 2
        for (int k = 0; k < 16; ++k) { const int col = c.lane + 64 * k;
            const float x1 = (ts[col] - mean) * rstd * lng[col] + lnb[col]; ts[col] = x1;
            const float hf = x1 * (1.f + mrow[4 * 1024 + col]) + mrow[3 * 1024 + col];
            H[(size_t)row * 1024 + col] = (bf16)(cvt_pk(hf, hf) & 0xffffu);
            const float* rc = rt + col;
#pragma unroll
            for (int e = 0; e < 16; ++e) lg[e] += hf * rc[e * 1024]; }
        { const bool b5 = (c.lane & 32) != 0, b4 = (c.lane & 16) != 0, b3 = (c.lane & 8) != 0, b2 = (c.lane & 4) != 0;
#pragma unroll
          for (int e = 0; e < 8; ++e) { const float send = b5 ? lg[e] : lg[e + 8], keep = b5 ? lg[e + 8] : lg[e]; lg[e] = keep + __shfl_xor(send, 32); }
#pragma unroll
          for (int e = 0; e < 4; ++e) { const float send = b4 ? lg[e] : lg[e + 4], keep = b4 ? lg[e + 4] : lg[e]; lg[e] = keep + __shfl_xor(send, 16); }
#pragma unroll
          for (int e = 0; e < 2; ++e) { const float send = b3 ? lg[e] : lg[e + 2], keep = b3 ? lg[e + 2] : lg[e]; lg[e] = keep + __shfl_xor(send, 8); }
          { const float send = b2 ? lg[0] : lg[1], keep = b2 ? lg[1] : lg[0]; lg[0] = keep + __shfl_xor(send, 4); }
          lg[0] += __shfl_xor(lg[0], 2); lg[0] += __shfl_xor(lg[0], 1); }
        const int eidx = ((c.lane >> 2) & 1) | (((c.lane >> 3) & 1) << 1) | (((c.lane >> 4) & 1) << 2) | (((c.lane >> 5) & 1) << 3);
        const float mx = wave_max(lg[0]); const float ex = expf(lg[0] - mx); const float se = wave_sum(ex) * 0.25f;
        float* dst = lat ? AFF + (size_t)(b * 16) * SEQ + (row & (SEQ - 1)) : AFFC + (size_t)(((row - NL) >> 8) * 16) * CTX + ((row - NL) & (CTX - 1));
        const int estride = lat ? SEQ : CTX;
        if ((c.lane & 3) == 0) dst[(size_t)eidx * estride] = ex / se;
    }
    __syncthreads();
}

DI void topk_unit(const Ctx& c, const float* aff, int n, int k, int* rowidx_out, float* gate_out, int* slotrow, int e, int tokrow0, int yrow0) {
    unsigned* vals = (unsigned*)c.lds;
    unsigned* hist = vals + 8192;
    unsigned* misc = hist + 256;
    unsigned* wtot = misc + 16;
    for (int i = c.tid; i < n; i += NTHR) vals[i] = __float_as_uint(aff[i]);
    unsigned prefix = 0u, kk = (unsigned)k;
    for (int pass = 3; pass >= 0; --pass) {
        if (c.tid < 256) hist[c.tid] = 0u;
        __syncthreads();
        for (int i = c.tid; i < n; i += NTHR) { const unsigned v = vals[i];
            const bool match = (pass == 3) ? true : ((v >> (8 * (pass + 1))) == prefix);
            if (match) atomicAdd(&hist[(v >> (8 * pass)) & 255u], 1u); }
        __syncthreads();
        if (c.wave == 0) {
            const unsigned h0 = hist[4 * c.lane], h1 = hist[4 * c.lane + 1], h2 = hist[4 * c.lane + 2], h3 = hist[4 * c.lane + 3];
            const unsigned sl = h0 + h1 + h2 + h3; unsigned S = sl;
#pragma unroll
            for (int o = 1; o < 64; o <<= 1) { const unsigned t = __shfl_down(S, o); if (c.lane + o < 64) S += t; }
            const unsigned above = S - sl;
            if (S >= kk && above < kk) { unsigned cum = above; unsigned bin;
                if (cum + h3 >= kk) bin = 4 * c.lane + 3;
                else { cum += h3; if (cum + h2 >= kk) bin = 4 * c.lane + 2;
                    else { cum += h2; if (cum + h1 >= kk) bin = 4 * c.lane + 1; else { cum += h1; bin = 4 * c.lane; } } }
                misc[0] = bin; misc[1] = kk - cum; }
        }
        __syncthreads();
        prefix = (prefix << 8) | misc[0]; kk = misc[1];
        __syncthreads();
    }
    const unsigned T = prefix, need_eq = kk, cnt_gt = (unsigned)k - kk;
    const int per = n >= NTHR ? n / NTHR : 1; const int i0 = c.tid * per; const bool active = i0 < n;
    unsigned cg = 0, ce = 0;
    if (active) for (int j = 0; j < per; ++j) { const unsigned v = vals[i0 + j]; cg += (v > T) ? 1u : 0u; ce += (v == T) ? 1u : 0u; }
    const unsigned packed = cg | (ce << 16); unsigned incl = packed;
#pragma unroll
    for (int o = 1; o < 64; o <<= 1) { const unsigned t = __shfl_up(incl, o); if (c.lane >= o) incl += t; }
    if (c.lane == 63) wtot[c.wave] = incl;
    __syncthreads();
    unsigned off = 0u;
    for (int w = 0; w < c.wave; ++w) off += wtot[w];
    const unsigned excl = incl - packed + off; unsigned g_off = excl & 0xffffu, e_off = excl >> 16;
    if (active) for (int j = 0; j < per; ++j) { const int i = i0 + j; const unsigned v = vals[i]; int slot = -1;
        if (v > T) slot = (int)(g_off++);
        else if (v == T) { if (e_off < need_eq) slot = (int)(cnt_gt + e_off); ++e_off; }
        if (slot >= 0) { rowidx_out[slot] = tokrow0 + i; gate_out[slot] = __uint_as_float(v); slotrow[(size_t)(tokrow0 + i) * 16 + e] = yrow0 + slot; }
        else slotrow[(size_t)(tokrow0 + i) * 16 + e] = -1; }
    __syncthreads();
}
DI void phase_topk(const Params& p, const Ctx& c, bool with_ctx) {
    unsigned char* ws = p.ws;
    const float* AFF = (const float*)(ws + WS_AFF); const float* AFFC = (const float*)(ws + WS_AFFC);
    int* ROWIDX = (int*)(ws + WS_ROWIDX); float* ROWGATE = (float*)(ws + WS_ROWGATE); int* SLOTROW = (int*)(ws + WS_SLOTROW);
    const int nunits = with_ctx ? 256 : 128;
    for (int unit = c.bid; unit < nunits; unit += c.G) {
        if (unit < 128) { const int b = unit >> 4, e = unit & 15;
            topk_unit(c, AFF + (size_t)(b * 16 + e) * SEQ, SEQ, CAPL, ROWIDX + e * ROWS_E + b * CAPL, ROWGATE + e * ROWS_E + b * CAPL, SLOTROW, e, b * SEQ, e * ROWS_E + b * CAPL); }
        else { const int uu = unit - 128, b = uu >> 4, e = uu & 15;
            topk_unit(c, AFFC + (size_t)(b * 16 + e) * CTX, CTX, CAPC, ROWIDX + e * ROWS_E + NB * CAPL + b * CAPC, ROWGATE + e * ROWS_E + NB * CAPL + b * CAPC, SLOTROW, e, NL + b * CTX, e * ROWS_E + NB * CAPL + b * CAPC); }
    }
}

DI void phase_gather(const Params& p, const Ctx& c, bool with_ctx) {
    unsigned char* ws = p.ws; const int* ROWIDX = (const int*)(ws + WS_ROWIDX); const bf16* H = (const bf16*)(ws + WS_H); bf16* XS = (bf16*)(ws + WS_XS);
    const int per_e = with_ctx ? ROWS_E : NB * CAPL;
    for (int i = c.gw; i < NE * per_e; i += c.NGW) { const int e = i / per_e, r = i - e * per_e; const int rr = e * ROWS_E + r;
        const int src = ROWIDX[rr];
        const u32x4* s = (const u32x4*)(H + (size_t)src * 1024) + c.lane; u32x4* d = (u32x4*)(XS + (size_t)rr * 1024) + c.lane;
        const u32x4 a = s[0], b = s[64]; d[0] = a; d[64] = b; }
}

DI void phase_combine_ln(const Ctx& c, const float* X1L, const float* X1C, float* OUTL, float* OUTC, const bf16* Y, const int* SLOTROW, const float* lng, const float* lnb,
                         const float* mod  , const float* modn  , bf16* H, int nrows) {
    for (int row = c.gw; row < nrows; row += c.NGW) {
        const bool lat = row < NL; const int b = lat ? (row >> 13) : 8;
        const float* xs = lat ? X1L + (size_t)row * 1024 : X1C + (size_t)(row - NL) * 1024; float* os = lat ? OUTL + (size_t)row * 1024 : OUTC + (size_t)(row - NL) * 1024;
        f32x4 f[4];
#pragma unroll
        for (int j = 0; j < 4; ++j) f[j] = (f32x4){0.f, 0.f, 0.f, 0.f};
        const int myslot = (c.lane < 16) ? SLOTROW[(size_t)row * 16 + c.lane] : -1;
#pragma unroll
        for (int e = 0; e < 16; ++e) { const int s = __builtin_amdgcn_readlane(myslot, e);
            if (s >= 0) { const bf16* yr = Y + (size_t)s * 1024 + 4 * c.lane;
#pragma unroll
                for (int j = 0; j < 4; ++j) { const u32x2 w = *(const u32x2*)(yr + 256 * j); f[j][0] += bf_lo(w.x); f[j][1] += bf_hi(w.x); f[j][2] += bf_lo(w.y); f[j][3] += bf_hi(w.y); } } }
        f32x4 t[4]; float s = 0.f;
#pragma unroll
        for (int j = 0; j < 4; ++j) { const int col = 4 * c.lane + 256 * j; const f32x4 x = *(const f32x4*)(xs + col), g = *(const f32x4*)(mod + b * 6144 + 5 * 1024 + col);
            t[j] = x * DN_ALPHA + (g + 1.f) * f[j]; s += (t[j][0] + t[j][1]) + (t[j][2] + t[j][3]); }
        const float mean = wave_sum(s) * (1.f / 1024.f); float s2 = 0.f;
#pragma unroll
        for (int j = 0; j < 4; ++j) { t[j] = t[j] - mean; s2 += (t[j][0] * t[j][0] + t[j][1] * t[j][1]) + (t[j][2] * t[j][2] + t[j][3] * t[j][3]); }
        const float rstd = 1.f / sqrtf(wave_sum(s2) * (1.f / 1024.f) + 1e-5f);
#pragma unroll
        for (int j = 0; j < 4; ++j) { const int col = 4 * c.lane + 256 * j; const f32x4 g = *(const f32x4*)(lng + col), bb = *(const f32x4*)(lnb + col);
            const f32x4 x2 = t[j] * rstd * g + bb; *(f32x4*)(os + col) = x2;
            if (modn) { const f32x4 sc = *(const f32x4*)(modn + b * 6144 + 1024 + col), sh = *(const f32x4*)(modn + b * 6144 + col); const f32x4 h = x2 * (sc + 1.f) + sh;
                u32x2 w; w.x = cvt_pk(h[0], h[1]); w.y = cvt_pk(h[2], h[3]); *(u32x2*)(H + (size_t)row * 1024 + col) = w; } }
    }
}
DI void phase_attn_mla(const Params& p, const Ctx& c) {
    unsigned char* ws = p.ws;
    const bf16* QL = (const bf16*)(ws + WS_QL); const bf16* QC = (const bf16*)(ws + WS_QC); const bf16* K0 = (const bf16*)(ws + WS_K0); const bf16* V0 = (const bf16*)(ws + WS_V0);
    bf16* CAT = (bf16*)(ws + WS_UV);
    using CF = att::Cfg<96, 64>;
    const int r32 = c.lane & 31, hi = c.lane >> 5;
    for (int i = 0;; ++i) {
        const int L = i * c.G + c.bid;
        if (L >= 2048 + 64) break;
        const bf16 *Qb, *Kh, *Vh; int seq, orow0, h;
        if (L < 2048) { const int bh = (L >> 8) * 8 + (L & 7), qb = (L & 255) >> 3; const int b = bh >> 3; h = bh & 7;
            Qb = QL + ((size_t)bh * SEQ + qb * 256) * 96; Kh = K0 + (size_t)bh * TKV * 96; Vh = V0 + (size_t)bh * TKV * 64; seq = TKV; orow0 = b * SEQ + qb * 256; }
        else { const int bh = L - 2048; const int b = bh >> 3; h = bh & 7;
            Qb = QC + (size_t)bh * CTX * 96; Kh = K0 + ((size_t)bh * TKV + SEQ) * 96; Vh = V0 + ((size_t)bh * TKV + SEQ) * 64; seq = CTX; orow0 = NL + b * CTX; }
        att::f32x16 o[2]; float l_reg;
        att::attn_core<96, 64>(Qb, Kh, Vh, seq, (char*)c.lds, 0.10206207261596575f, o, l_reg, c.wave);
        float rli[16]; att::row_inv(l_reg, (char*)c.lds, CF::WS_OFF, rli, c.wave);
#pragma unroll
        for (int r = 0; r < 16; ++r) { const int orow = orow0 + c.wave * 32 + att::crow(r, hi);
#pragma unroll
            for (int d0 = 0; d0 < 2; ++d0) { const float v = o[d0][r] * rli[r]; CAT[(size_t)orow * 1024 + 512 + h * 64 + d0 * 32 + r32] = (bf16)(cvt_pk(v, v) & 0xffffu); } }
    }
    __syncthreads();
}
DI void phase_attn_diff(const Params& p, const Ctx& c) {
    unsigned char* ws = p.ws;
    const bf16* Q1 = (const bf16*)(ws + WS_Q1); const bf16* K1 = (const bf16*)(ws + WS_K1); const bf16* V1 = (const bf16*)(ws + WS_V1); bf16* O1 = (bf16*)(ws + WS_O1);
    using CF = att::Cfg<64, 128>;
    const int r32 = c.lane & 31, hi = c.lane >> 5;
    float lam;
    { const float a = p.in[I_LQ1][c.lane] * p.in[I_LK1][c.lane], b = p.in[I_LQ2][c.lane] * p.in[I_LK2][c.lane];
      lam = expf(wave_sum(a)) - expf(wave_sum(b)) + LAM_INIT; }
    const float* sg = p.in[I_SUBLN];
    unsigned* stash = (unsigned*)(c.lds + CF::STASH_OFF) + c.wave * 2048;
    for (int i = 0;; ++i) {
        const int L = i * c.G + c.bid;
        if (L >= 2048) break;
        const int bh = (L >> 8) * 8 + (L & 7), qb = (L & 255) >> 3, b = bh >> 3, h = bh & 7;
        const bf16* Vh = V1 + (size_t)bh * TKV * 128;
        att::f32x16 o[4]; float l_reg; float rli[16];
        {
            const int hh = 2 * h; const bf16* Qb = Q1 + ((size_t)(b * 16 + hh) * SEQ + qb * 256) * 64; const bf16* Kh = K1 + (size_t)(b * 16 + hh) * TKV * 64;
            att::attn_core<64, 128>(Qb, Kh, Vh, TKV, (char*)c.lds, 0.125f, o, l_reg, c.wave);
            att::row_inv(l_reg, (char*)c.lds, CF::WS_OFF, rli, c.wave);
#pragma unroll
            for (int d0 = 0; d0 < 4; ++d0)
#pragma unroll
                for (int r = 0; r < 16; r += 2) stash[(d0 * 8 + (r >> 1)) * 64 + c.lane] = cvt_pk(o[d0][r] * rli[r], o[d0][r + 1] * rli[r + 1]);
        }
        {
            const int hh = 2 * h + 1; const bf16* Qb = Q1 + ((size_t)(b * 16 + hh) * SEQ + qb * 256) * 64; const bf16* Kh = K1 + (size_t)(b * 16 + hh) * TKV * 64;
            att::attn_core<64, 128>(Qb, Kh, Vh, TKV, (char*)c.lds, 0.125f, o, l_reg, c.wave);
            att::row_inv(l_reg, (char*)c.lds, CF::WS_OFF, rli, c.wave);
        }
        float ss[16];
#pragma unroll
        for (int r = 0; r < 16; ++r) ss[r] = 0.f;
#pragma unroll
        for (int d0 = 0; d0 < 4; ++d0)
#pragma unroll
            for (int r = 0; r < 16; r += 2) { const unsigned w = stash[(d0 * 8 + (r >> 1)) * 64 + c.lane];
                const float f0 = bf_lo(w) - lam * o[d0][r] * rli[r], f1 = bf_hi(w) - lam * o[d0][r + 1] * rli[r + 1];
                o[d0][r] = f0; o[d0][r + 1] = f1; ss[r] += f0 * f0; ss[r + 1] += f1 * f1; }
#pragma unroll
        for (int r = 0; r < 16; ++r) {
#pragma unroll
            for (int off = 1; off < 32; off <<= 1) ss[r] += __shfl_xor(ss[r], off);
            ss[r] = (1.f - LAM_INIT) / sqrtf(ss[r] * (1.f / 128.f) + 1e-6f); }
        const int orow0 = b * SEQ + qb * 256 + c.wave * 32;
#pragma unroll
        for (int d0 = 0; d0 < 4; ++d0) { const float g = sg[d0 * 32 + r32];
#pragma unroll
            for (int r = 0; r < 16; ++r) { const float v = o[d0][r] * ss[r] * g;
                O1[(size_t)(orow0 + att::crow(r, hi)) * 1024 + h * 128 + d0 * 32 + r32] = (bf16)(cvt_pk(v, v) & 0xffffu); } }
    }
    __syncthreads();
}

constexpr int NPHASE = 22;
__global__ void __launch_bounds__(NTHR, 2) trunk_fwd(Params p) {
    extern __shared__ __attribute__((aligned(16))) unsigned char lds[];
    const int BID = blockIdx.x, GRD = gridDim.x, WID = __builtin_amdgcn_readfirstlane((int)threadIdx.x >> 6);
    unsigned char* ws = p.ws;
    LAS unsigned char* ldsl = (LAS unsigned char*)lds;
    for (int u = WID * 64 + (int)__builtin_amdgcn_mbcnt_hi(~0u, __builtin_amdgcn_mbcnt_lo(~0u, 0u)); u < (LDS_BYTES - LDSCTL_OFF) / 4; u += NTHR) ((LAS unsigned*)(ldsl + LDSCTL_OFF))[u] = 0u;
    __syncthreads();
    unsigned* ctl = (unsigned*)(ws + WS_CTL);
    const bool multi = (p.ph_hi - p.ph_lo) > 1;
    XcdBarrier bar; bar.bar = ctl + CW_BAR; bar.x = 0; bar.st = nullptr;
    if (multi) bar = xcd_barrier_post(ctl + CW_BAR, (volatile LAS unsigned*)(ldsl + MISC_OFF) + 8, WID);
    const int lo = __builtin_amdgcn_readfirstlane(p.ph_lo), hi = __builtin_amdgcn_readfirstlane(p.ph_hi);
#ifdef ONLY_PHASE
#define IN(k) ((k) == ONLY_PHASE && lo <= (k))
#else
#define IN(k) (lo <= (k) && (k) < hi)
#endif
#define SEAM(k) do { if (IN(k) && IN((k) + 1)) xcd_barrier(bar, WID); } while (0)
    float* MOD = (float*)(ws + WS_MOD);
    bf16* H = (bf16*)(ws + WS_H);
    float* XC = (float*)(ws + WS_XC);
    const f32x2* R16 = (const f32x2*)(ws + WS_ROPE16); const f32x2* R32 = (const f32x2*)(ws + WS_ROPE32);

    if (IN(0)) { const Ctx c = make_ctx(lds, WID); phase_prologue(p, c); } SEAM(0);
    if (IN(1)) { const Ctx c = make_ctx(lds, WID); phase_mod_rows(c, p.in[I_X], p.in[I_CTX], MOD, 0, 1024, H); } SEAM(1);
    if (IN(2)) {
        pg8::Gemm g{H, (const bf16*)(ws + WS_WIN0), NR, 1536, 1024}; pg8::StaticOrder S; S.init(NR, 1536, GRD, BID);
        EpiA0 E{ws, R16};
        pg8::gemm_phase<EpiA0, pg8::StaticOrder, true, true>(ldsl, g, S, E, WID);
    } SEAM(2);
    if (IN(3)) { const Ctx c = make_ctx(lds, WID); phase_gmlp(p, c); } SEAM(3);
    if (IN(4)) {
#ifndef P4_SKIP_Q
        { pg8::Gemm g{(const bf16*)(ws + WS_CQ), (const bf16*)(ws + WS_WUQ), NR, 768, 256}; pg8::StaticOrder S; S.init(NR, 768, GRD, BID);
          EpiQ E{ws, (const float*)(ws + WS_RQ), R16};
          pg8::gemm_phase<EpiQ, pg8::StaticOrder, true, true>(ldsl, g, S, E, WID); }
#endif
        __syncthreads();
#ifndef P4_SKIP_KV
        { pg8::Gemm g{(const bf16*)(ws + WS_CKV), (const bf16*)(ws + WS_WUKV), NR, 1024, 128}; pg8::StaticOrder S; S.init(NR, 1024, GRD, BID);
          EpiKV E{ws, (const float*)(ws + WS_RKV)};
          pg8::gemm_phase<EpiKV, pg8::StaticOrder, true, true>(ldsl, g, S, E, WID); }
#endif
    } SEAM(4);
    if (IN(5)) { const Ctx c = make_ctx(lds, WID); phase_attn_mla(p, c); } SEAM(5);
    if (IN(6)) {
        pg8::Gemm g{(const bf16*)(ws + WS_UV), (const bf16*)(ws + WS_WOUT0), NR, 1024, 1024}; pg8::StaticOrder S; S.init(NR, 1024, GRD, BID);
        EpiOut E{p.in[I_X], p.in[I_CTX], p.out, XC, MOD + 2 * 1024};
        pg8::gemm_phase<EpiOut, pg8::StaticOrder, true, true>(ldsl, g, S, E, WID);
    } SEAM(6);
    if (IN(7)) { const Ctx c = make_ctx(lds, WID); phase_ln_router(c, p.out, XC, p.in[I_LNMG0], p.in[I_LNMB0], MOD, p.in[I_ROUTER0], H, (float*)(ws + WS_AFF), (float*)(ws + WS_AFFC), NR); } SEAM(7);
    if (IN(8)) { const Ctx c = make_ctx(lds, WID); phase_topk(p, c, true); } SEAM(8);
    if (IN(9)) { const Ctx c = make_ctx(lds, WID); phase_gather(p, c, true); } SEAM(9);
    if (IN(10)) {
        pg8::Gemm g{(const bf16*)(ws + WS_XS), (const bf16*)(ws + WS_WGU0), NE * ROWS_E, NE * 2048, 1024}; GroupedOrder S{MT_E, 8, BID, GRD};
        EpiMoe1 E{(bf16*)(ws + WS_HID), 8};
        pg8::gemm_phase<EpiMoe1, GroupedOrder, true, true>(ldsl, g, S, E, WID);
    } SEAM(10);
    if (IN(11)) {
        pg8::Gemm g{(const bf16*)(ws + WS_HID), (const bf16*)(ws + WS_WDN0), NE * ROWS_E, NE * 1024, 1024}; GroupedOrder S{MT_E, 4, BID, GRD};
        EpiMoe2 E{(bf16*)(ws + WS_Y), (const float*)(ws + WS_ROWGATE), 4};
        pg8::gemm_phase<EpiMoe2, GroupedOrder, true, true>(ldsl, g, S, E, WID);
    } SEAM(11);
    if (IN(12)) { const Ctx c = make_ctx(lds, WID); phase_combine_ln(c, p.out, XC, p.out, XC, (const bf16*)(ws + WS_Y), (const int*)(ws + WS_SLOTROW), p.in[I_LNFG0], p.in[I_LNFB0], MOD, MOD + 9 * 6144, H, NR); } SEAM(12);
    if (IN(13)) {
        { pg8::Gemm g{H, (const bf16*)(ws + WS_WIN1), NL, 3072, 1024}; pg8::StaticOrder S; S.init(NL, 3072, GRD, BID);
          EpiA1 E{ws, R32, 0, 0};
          pg8::gemm_phase<EpiA1, pg8::StaticOrder, true, true>(ldsl, g, S, E, WID); }
        __syncthreads();
        { pg8::Gemm g{H + (size_t)NL * 1024, (const bf16*)(ws + WS_WIN1) + (size_t)1024 * 1024, NC, 2048, 1024}; pg8::StaticOrder S; S.init(NC, 2048, GRD, BID);
          EpiA1 E{ws, R32, NL, 1024};
          pg8::gemm_phase<EpiA1, pg8::StaticOrder, true, true>(ldsl, g, S, E, WID); }
    } SEAM(13);
    if (IN(14)) { const Ctx c = make_ctx(lds, WID); phase_attn_diff(p, c); } SEAM(14);
    if (IN(15)) {
        pg8::Gemm g{(const bf16*)(ws + WS_O1), (const bf16*)(ws + WS_WOUT1), NL, 1024, 1024}; pg8::StaticOrder S; S.init(NL, 1024, GRD, BID);
        EpiOut E{p.out, XC, p.out, XC, MOD + 9 * 6144 + 2 * 1024};
        pg8::gemm_phase<EpiOut, pg8::StaticOrder, true, true>(ldsl, g, S, E, WID);
    } SEAM(15);
    if (IN(16)) { const Ctx c = make_ctx(lds, WID); phase_ln_router(c, p.out, XC, p.in[I_LNMG1], p.in[I_LNMB1], MOD + 9 * 6144, p.in[I_ROUTER1], H, (float*)(ws + WS_AFF), (float*)(ws + WS_AFFC), NL); } SEAM(16);
    if (IN(17)) { const Ctx c = make_ctx(lds, WID); phase_topk(p, c, false); } SEAM(17);
    if (IN(18)) { const Ctx c = make_ctx(lds, WID); phase_gather(p, c, false); } SEAM(18);
    if (IN(19)) {
        pg8::Gemm g{(const bf16*)(ws + WS_XS), (const bf16*)(ws + WS_WGU1), NE * ROWS_E, NE * 2048, 1024}; GroupedOrder S{32, 8, BID, GRD};
        EpiMoe1 E{(bf16*)(ws + WS_HID), 8};
        pg8::gemm_phase<EpiMoe1, GroupedOrder, true, true>(ldsl, g, S, E, WID);
    } SEAM(19);
    if (IN(20)) {
        pg8::Gemm g{(const bf16*)(ws + WS_HID), (const bf16*)(ws + WS_WDN1), NE * ROWS_E, NE * 1024, 1024}; GroupedOrder S{32, 4, BID, GRD};
        EpiMoe2 E{(bf16*)(ws + WS_Y), (const float*)(ws + WS_ROWGATE), 4};
        pg8::gemm_phase<EpiMoe2, GroupedOrder, true, true>(ldsl, g, S, E, WID);
    } SEAM(20);
    if (IN(21)) { const Ctx c = make_ctx(lds, WID); phase_combine_ln(c, p.out, XC, p.out, XC, (const bf16*)(ws + WS_Y), (const int*)(ws + WS_SLOTROW), p.in[I_LNFG1], p.in[I_LNFB1], MOD + 9 * 6144, nullptr, H, NL); }
#undef IN
#undef SEAM
}

#ifndef N_LAUNCH_MODE
#define N_LAUNCH_MODE 0
#endif
extern "C" void kernel_launch(void* const* d_in, const int* in_sizes, int n_in, void* d_out, int out_size, void* d_ws, size_t ws_size, hipStream_t stream) {
    static int ok = 0;
    if (ok == 0) {
        if (n_in != 41 || in_sizes[0] != NL * DM || out_size != NL * DM || ws_size < WS_END) { fprintf(stderr, "kernel_launch: unexpected shapes: n_in %d in0 %d out %d ws %zu (need %zu)\n", n_in, n_in > 0 ? in_sizes[0] : -1, out_size, ws_size, (size_t)WS_END); ok = -1; return; }
        if (hipFuncSetAttribute((const void*)trunk_fwd, hipFuncAttributeMaxDynamicSharedMemorySize, LDS_BYTES) != hipSuccess) { fprintf(stderr, "kernel_launch: hipFuncSetAttribute failed\n"); ok = -1; return; }
        int per_cu = 0;
        if (hipOccupancyMaxActiveBlocksPerMultiprocessor(&per_cu, (const void*)trunk_fwd, NTHR, LDS_BYTES) != hipSuccess || per_cu < 1) fprintf(stderr, "kernel_launch: note: occupancy query reports %d\n", per_cu);
        (void)hipGetLastError();
        ok = 1;
    }
    if (ok < 0) return;
    (void)hipMemsetAsync((char*)d_ws + WS_CTL, 0, CTL_ZERO_BYTES, stream);
    Params p{};
    for (int i = 0; i < 41; ++i) p.in[i] = (const float*)d_in[i];
    p.out = (float*)d_out; p.ws = (unsigned char*)d_ws;
    const int grid = 256;
#if N_LAUNCH_MODE == 0
    p.ph_lo = 0; p.ph_hi = NPHASE;
    hipLaunchKernelGGL(trunk_fwd, dim3(grid), dim3(NTHR), LDS_BYTES, stream, p);
#else
    for (int k = 0; k < NPHASE; ++k) { p.ph_lo = k; p.ph_hi = k + 1; hipLaunchKernelGGL(trunk_fwd, dim3(grid), dim3(NTHR), LDS_BYTES, stream, p); }
#endif
    const hipError_t le = hipPeekAtLastError();
    if (le != hipSuccess) fprintf(stderr, "kernel_launch: launch failed: %s\n", hipGetErrorName(le));
}
```

```cpp
#include <hip/hip_runtime.h>
#include <cstdio>
#include <cstdint>

namespace pg8 {
#define PG8_LAS __attribute__((address_space(3)))
typedef unsigned short bf16_t;
typedef short bf16x8 __attribute__((ext_vector_type(8)));
typedef float f32x4 __attribute__((ext_vector_type(4)));
typedef unsigned u32x4 __attribute__((ext_vector_type(4)));
constexpr int BM = 256, BK = 64, HALF = 128, HTB = HALF * BK * 2  , STAGE_BYTES = 8 * HTB, NXCD = 8, WGM = 8;

__host__ __device__ __forceinline__ int lds_byte(int r, int c) { const int st = (r >> 4) * 2 + (c >> 5), rr = r & 15, cc = c & 31, ob = rr * 64 + cc * 2; return st * 1024 + (ob ^ (((ob >> 9) & 1) << 5)); }
__host__ __device__ __forceinline__ void stage_rc(int b, int& R, int& C) { const int st = b / 1024, sb = b % 1024, swz = sb ^ (((sb >> 9) & 1) << 5); R = (st >> 1) * 16 + swz / 64; C = (st & 1) * 32 + (swz % 64) / 2; }
__host__ __device__ __forceinline__ int perm32(int rho) { const int n = rho >> 4, i = rho & 15; return 8 * (i >> 2) + 4 * n + (i & 3); }

struct Unit { int pm, pn; };
struct Gemm { const bf16_t* A; const bf16_t* Bt; int M, N, K; };

struct StaticOrder {
    int nM, nN, nwg, G, c;
    __host__ __device__ void init(int M, int N, int G_, int c_) { nM = M / BM; nN = N / BM; nwg = nM * nN; G = G_; c = c_; }
    __host__ __device__ bool next(int i, Unit& u) const {
        const long L = (long)i * G + c; if (L >= nwg) return false;
        int wgid = (int)L; { const int q = nwg / NXCD, r = nwg % NXCD, xcd = wgid % NXCD, off = wgid / NXCD; wgid = (xcd < r ? xcd * (q + 1) : r * (q + 1) + (xcd - r) * q) + off; }
        const int nig = WGM * nN, gid = wgid / nig, fm = gid * WGM, gsz = (nM - fm) < WGM ? (nM - fm) : WGM;
        u.pm = fm + ((wgid % nig) % gsz); u.pn = (wgid % nig) / gsz; return true;
    }
    __device__ __forceinline__ void a_ready(const Unit&) const {}
    __device__ __forceinline__ void done(const Unit&) const {}
};

__device__ __forceinline__ unsigned cvt_pk_bf16(float lo, float hi) { unsigned r; asm volatile("v_cvt_pk_bf16_f32 %0, %1, %2" : "=v"(r) : "v"(lo), "v"(hi)); return r; }
typedef float f32x2 __attribute__((ext_vector_type(2)));
__device__ __forceinline__ f32x2 gelu_pk(f32x2 v) {
    const f32x2 av = __builtin_elementwise_abs(v), d = av * 0.2316418882f + 1.0f;
    f32x2 t; t.x = __builtin_amdgcn_rcpf(d.x); t.y = __builtin_amdgcn_rcpf(d.y);
    f32x2 q = t * 0.5307027145f + (-0.7265760135f); q = q * t + 0.7107068705f; q = q * t + (-0.142248368f); q = q * t + 0.127414796f; q = q * t;
    const f32x2 s = (v * v) * (-0.72134752044f);
    f32x2 e; e.x = __builtin_amdgcn_exp2f(s.x); e.y = __builtin_amdgcn_exp2f(s.y);
    const f32x2 m = v * (q * e), r = v - m;
    f32x2 o; o.x = v.x < 0.f ? m.x : r.x; o.y = v.y < 0.f ? m.y : r.y; return o;
}
typedef int v8i32 __attribute__((ext_vector_type(8)));
template <class Epi, class Sched, bool ALIGN_EPI = false, bool SP2 = false, bool FP8 = false, bool GATHER = false>
__device__ __forceinline__ void gemm_phase(PG8_LAS unsigned char* lds, const Gemm g, const Sched& S, const Epi& E, const int wid_in, const int* rowidx = nullptr, const int tbl_off = 0) {
    int lane_ = (int)__builtin_amdgcn_mbcnt_hi(~0u, __builtin_amdgcn_mbcnt_lo(~0u, 0u)); asm volatile("" : "+v"(lane_));
    const int wid = wid_in, lane = lane_, tid = wid * 64 + lane, wr = wid >> 2, wc = wid & 3, fr = lane & 15, fq = lane >> 4;
    int K_ = g.K; asm volatile("" : "+s"(K_)); const int K = K_, nt = K / BK;
    unsigned voffA[2], voffB[2];
#pragma unroll
    for (int i = 0; i < 2; ++i) { int R, C; stage_rc(tid * 16 + i * 8192, R, C); const int Rb = Epi::PERM ? ((R & ~31) + perm32(R & 31)) : R;
        voffA[i] = (unsigned)(R * K + C) * 2u; voffB[i] = (unsigned)(Rb * K + C) * 2u; }
    int gR[2], gC[2];
#pragma unroll
    for (int i = 0; i < 2; ++i) { int R, C; stage_rc(tid * 16 + i * 8192, R, C); gR[i] = R; gC[i] = C * 2; }
    const PG8_LAS int* gtbl = (const PG8_LAS int*)(lds + tbl_off);
    unsigned offC[2][2], offN[2][2];
#define PG8_GOFF(dst, ui_) do { _Pragma("unroll") for (int h_ = 0; h_ < 2; ++h_) _Pragma("unroll") for (int i_ = 0; i_ < 2; ++i_) \
        dst[h_][i_] = (unsigned)gtbl[(ui_) * 256 + h_ * 128 + gR[i_]] * (unsigned)(K * 2) + (unsigned)gC[i_]; } while (0)
    const size_t kstep = (size_t)(BK * 2);
    const size_t hstep = (size_t)HALF * K * 2;
    const size_t tstep = 2 * hstep;
    const unsigned ldsw = (unsigned)wid * 1024u;
    const int aoff = lds_byte(wr * 64 + fr, fq * 8), boff = lds_byte(wc * 32 + fr, fq * 8);
#define PG8_SA(b, h) (((b) * 2 + (h)) * HTB)
#define PG8_SB(b, h) ((4 + (b) * 2 + (h)) * HTB)
#define PG8_STAGE(bufoff, gbase, voff) do { _Pragma("unroll") for (int _i = 0; _i < 2; ++_i) \
        __builtin_amdgcn_global_load_lds((const unsigned*)((const char*)(gbase) + (voff)[_i]), (PG8_LAS unsigned*)(lds + (bufoff) + ldsw + _i * 8192), 16, 0, 0); } while (0)
#define PG8_STAGE_A(bufoff, kk, h, nx) do { if constexpr (GATHER) { const unsigned sel_[2] = {(nx) ? offN[h][0] : offC[h][0], (nx) ? offN[h][1] : offC[h][1]}; PG8_STAGE(bufoff, (const char*)g.A + (size_t)(kk) * kstep, sel_); } \
        else { PG8_STAGE(bufoff, ((nx) ? nA : cA) + (size_t)(kk) * kstep + (size_t)(h) * hstep, voffA); } } while (0)
#define PG8_LD16(off) (*(const PG8_LAS u32x4*)(lds + (off)))
#define PG8_V8(l0, l1) ((v8i32){(int)(l0).x, (int)(l0).y, (int)(l0).z, (int)(l0).w, (int)(l1).x, (int)(l1).y, (int)(l1).z, (int)(l1).w})
#define PG8_LDA(dst, b, h) do { _Pragma("unroll") for (int m = 0; m < 4; ++m) { const u32x4 l0_ = PG8_LD16(PG8_SA(b, h) + aoff + m * 2048), l1_ = PG8_LD16(PG8_SA(b, h) + aoff + m * 2048 + 1024); \
        if constexpr (FP8) dst##8[m] = PG8_V8(l0_, l1_); else { dst[m][0] = __builtin_bit_cast(bf16x8, l0_); dst[m][1] = __builtin_bit_cast(bf16x8, l1_); } } } while (0)
#define PG8_LDB(dst, b, h) do { _Pragma("unroll") for (int n = 0; n < 2; ++n) { const u32x4 l0_ = PG8_LD16(PG8_SB(b, h) + boff + n * 2048), l1_ = PG8_LD16(PG8_SB(b, h) + boff + n * 2048 + 1024); \
        if constexpr (FP8) dst##8[n] = PG8_V8(l0_, l1_); else { dst[n][0] = __builtin_bit_cast(bf16x8, l0_); dst[n][1] = __builtin_bit_cast(bf16x8, l1_); } } } while (0)
#define PG8_MMA(ai, bj, At, Bt) do { __builtin_amdgcn_s_setprio(1); _Pragma("unroll") for (int m = 0; m < 4; ++m) _Pragma("unroll") for (int n = 0; n < 2; ++n) { \
        if constexpr (FP8) asm volatile("v_mfma_scale_f32_16x16x128_f8f6f4 %0, %1, %2, %0, %3, %3 op_sel_hi:[0,0,0]" : "+v"(acc[ai][bj][m][n]) : "v"(Bt##8[n]), "v"(At##8[m]), "v"(one_scale));   \
        else { _Pragma("unroll") for (int k = 0; k < 2; ++k) acc[ai][bj][m][n] = __builtin_amdgcn_mfma_f32_16x16x32_bf16(Bt[n][k], At[m][k], acc[ai][bj][m][n], 0, 0, 0); } } \
        __builtin_amdgcn_s_setprio(0); } while (0)
#define PG8_WAIT_V(n) asm volatile("s_waitcnt vmcnt(" #n ")" ::: "memory")
#define PG8_WAIT_L(n) asm volatile("s_waitcnt lgkmcnt(" #n ")" ::: "memory")
#define PG8_BAR __builtin_amdgcn_s_barrier()
#define PG8_SCHED __builtin_amdgcn_sched_barrier(0)
    Unit cur, nxt; int ui = 0;
    if (!S.next(0, cur)) return;
    f32x4 acc[2][2][4][2];
#pragma unroll
    for (int a = 0; a < 2; ++a)
#pragma unroll
        for (int b = 0; b < 2; ++b)
#pragma unroll
            for (int m = 0; m < 4; ++m)
#pragma unroll
                for (int n = 0; n < 2; ++n) acc[a][b][m][n] = (f32x4){0.f, 0.f, 0.f, 0.f};
    const int one_scale = 0x7f7f7f7f;
    bf16x8 At[4][2], B0[2][2], B1[2][2]; v8i32 At8[4], B08[2], B18[2];
    const char* cA = (const char*)g.A + (size_t)cur.pm * tstep; const char* cB = (const char*)g.Bt + (size_t)cur.pn * tstep;
    const char* nA = cA;
    if constexpr (GATHER) { Unit tu; for (int i = 0; S.next(i, tu); ++i) if (tid < 256) ((PG8_LAS int*)(lds + tbl_off))[i * 256 + tid] = rowidx[tu.pm * 256 + tid];
        asm volatile("s_waitcnt vmcnt(0) lgkmcnt(0)" ::: "memory"); PG8_BAR; PG8_GOFF(offC, 0); PG8_GOFF(offN, 0); }
    S.a_ready(cur);
    if constexpr (SP2) {
        PG8_STAGE(PG8_SB(0, 0), cB, voffB); PG8_STAGE(PG8_SB(0, 1), cB + hstep, voffB); PG8_STAGE_A(PG8_SA(0, 0), 0, 0, false); PG8_STAGE_A(PG8_SA(0, 1), 0, 1, false);
        if (wr == 1) PG8_BAR;
        PG8_WAIT_V(2); PG8_BAR;
        PG8_STAGE(PG8_SB(1, 0), cB + kstep, voffB); PG8_STAGE_A(PG8_SA(1, 0), 1, 0, false); PG8_STAGE(PG8_SB(1, 1), cB + hstep + kstep, voffB);
        PG8_WAIT_V(6); PG8_BAR;
    } else {
        PG8_STAGE(PG8_SB(0, 0), cB, voffB); PG8_STAGE_A(PG8_SA(0, 0), 0, 0, false); PG8_STAGE(PG8_SB(0, 1), cB + hstep, voffB); PG8_STAGE_A(PG8_SA(0, 1), 0, 1, false);
        if (wr == 1) PG8_BAR;
        PG8_WAIT_V(4); PG8_BAR;
        PG8_STAGE(PG8_SB(1, 0), cB + kstep, voffB); PG8_STAGE_A(PG8_SA(1, 0), 1, 0, false); PG8_STAGE(PG8_SB(1, 1), cB + hstep + kstep, voffB);
        PG8_WAIT_V(6); PG8_BAR;
    }
    for (;;) {
        const bool has_next = S.next(ui + 1, nxt);
        nA = has_next ? (const char*)g.A + (size_t)nxt.pm * tstep : cA; const char* nB = has_next ? (const char*)g.Bt + (size_t)nxt.pn * tstep : cB;
        if constexpr (GATHER) { if (has_next) PG8_GOFF(offN, ui + 1); }
        for (int t = 0; t < nt; t += 2) {
            const bool last = (t == nt - 2);
            const char* b2 = last ? nB : cB + (size_t)(t + 2) * kstep; const char* b3 = b2 + kstep;
            const int k2 = last ? 0 : t + 2, k3 = k2 + 1;
            if (last && has_next) S.a_ready(nxt);
            if constexpr (SP2) {
            PG8_LDB(B0, 0, 0); PG8_LDB(B1, 0, 1); PG8_SCHED; PG8_LDA(At, 0, 0); PG8_STAGE_A(PG8_SA(1, 1), t + 1, 1, false);
            PG8_WAIT_V(8); PG8_WAIT_L(0); PG8_BAR; PG8_MMA(0, 0, At, B0); PG8_MMA(0, 1, At, B1); PG8_BAR; PG8_SCHED;
            PG8_LDA(At, 0, 1); PG8_STAGE(PG8_SB(0, 0), b2, voffB); PG8_STAGE(PG8_SB(0, 1), b2 + hstep, voffB); PG8_STAGE_A(PG8_SA(0, 0), k2, 0, last);
            PG8_WAIT_V(8); PG8_WAIT_L(0); PG8_BAR; PG8_MMA(1, 0, At, B0); PG8_MMA(1, 1, At, B1); PG8_BAR; PG8_SCHED;
            PG8_LDB(B0, 1, 0); PG8_LDB(B1, 1, 1); PG8_SCHED; PG8_LDA(At, 1, 0); PG8_STAGE_A(PG8_SA(0, 1), k2, 1, last);
            PG8_WAIT_V(8); PG8_WAIT_L(0); PG8_BAR; PG8_MMA(0, 0, At, B0); PG8_MMA(0, 1, At, B1); PG8_BAR; PG8_SCHED;
            PG8_LDA(At, 1, 1); PG8_STAGE(PG8_SB(1, 0), b3, voffB); PG8_STAGE(PG8_SB(1, 1), b3 + hstep, voffB); PG8_STAGE_A(PG8_SA(1, 0), k3, 0, last);
            PG8_WAIT_V(8); PG8_WAIT_L(0); PG8_BAR; PG8_MMA(1, 0, At, B0); PG8_MMA(1, 1, At, B1); PG8_BAR; PG8_SCHED;
            } else {
            PG8_LDB(B0, 0, 0); PG8_SCHED; PG8_LDA(At, 0, 0); PG8_STAGE_A(PG8_SA(1, 1), t + 1, 1, false);
            PG8_WAIT_L(8); PG8_BAR; PG8_WAIT_L(0); PG8_MMA(0, 0, At, B0); PG8_BAR; PG8_SCHED;
            PG8_LDB(B1, 0, 1); PG8_STAGE(PG8_SB(0, 0), b2, voffB);
            PG8_BAR; PG8_WAIT_L(0); PG8_MMA(0, 1, At, B1); PG8_BAR;
            PG8_LDA(At, 0, 1); PG8_STAGE_A(PG8_SA(0, 0), k2, 0, last);
            PG8_BAR; PG8_WAIT_L(0); PG8_MMA(1, 0, At, B0); PG8_BAR; PG8_SCHED;
            PG8_STAGE(PG8_SB(0, 1), b2 + hstep, voffB);
            PG8_WAIT_V(6); PG8_BAR; PG8_MMA(1, 1, At, B1); PG8_BAR;
            PG8_LDB(B0, 1, 0); PG8_SCHED; PG8_LDA(At, 1, 0); PG8_STAGE_A(PG8_SA(0, 1), k2, 1, last);
            PG8_WAIT_L(8); PG8_BAR; PG8_WAIT_L(0); PG8_MMA(0, 0, At, B0); PG8_BAR; PG8_SCHED;
            PG8_LDB(B1, 1, 1); PG8_STAGE(PG8_SB(1, 0), b3, voffB);
            PG8_BAR; PG8_WAIT_L(0); PG8_MMA(0, 1, At, B1); PG8_BAR;
            PG8_LDA(At, 1, 1); PG8_STAGE_A(PG8_SA(1, 0), k3, 0, last);
            PG8_BAR; PG8_WAIT_L(0); PG8_MMA(1, 0, At, B0); PG8_BAR; PG8_SCHED;
            PG8_STAGE(PG8_SB(1, 1), b3 + hstep, voffB);
            PG8_WAIT_V(6); PG8_BAR; PG8_MMA(1, 1, At, B1); PG8_BAR;
            }
        }
        if constexpr (ALIGN_EPI) { if (wr == 0) PG8_BAR; }
        if constexpr (!Epi::AFTER_DRAIN) { E(acc, cur, wr, wc, fr, fq); S.done(cur); }
        if (!has_next) break;
#pragma unroll
        for (int a = 0; a < 2; ++a)
#pragma unroll
            for (int b = 0; b < 2; ++b)
#pragma unroll
                for (int m = 0; m < 4; ++m)
#pragma unroll
                    for (int n = 0; n < 2; ++n) acc[a][b][m][n] = (f32x4){0.f, 0.f, 0.f, 0.f};
        cur = nxt; cA = nA; cB = nB; ++ui;
        if constexpr (GATHER) { _Pragma("unroll") for (int h_ = 0; h_ < 2; ++h_) _Pragma("unroll") for (int i_ = 0; i_ < 2; ++i_) offC[h_][i_] = offN[h_][i_]; }
        if constexpr (ALIGN_EPI) { if (wr == 1) PG8_BAR; }
    }
    PG8_WAIT_V(0);
    if constexpr (!ALIGN_EPI) { if (wr == 0) PG8_BAR; }
    PG8_BAR;
    if constexpr (Epi::AFTER_DRAIN) { E.fused(acc, cur, wr, wc, fr, fq, lds, wid, lane); S.done(cur); }
#undef PG8_SA
#undef PG8_SB
#undef PG8_STAGE
#undef PG8_LDA
#undef PG8_LDB
#undef PG8_MMA
#undef PG8_STAGE_A
#undef PG8_GOFF
#undef PG8_LD16
#undef PG8_V8
#undef PG8_WAIT_V
#undef PG8_WAIT_L
#undef PG8_BAR
#undef PG8_SCHED
}
}
namespace att {
typedef unsigned short bf16_t;
using bf16x8 = __attribute__((ext_vector_type(8))) short;
using s16x4  = __attribute__((ext_vector_type(4))) short;
using f32x16 = __attribute__((ext_vector_type(16))) float;
using u32x4  = __attribute__((ext_vector_type(4))) unsigned;
#define SBAR() __builtin_amdgcn_sched_barrier(0)
#ifndef ATT_MPRIO
#define ATT_MPRIO 0
#define ATT_VPRIO 0
#endif
#define ADI __device__ __forceinline__
ADI int crow(int r, int hi) { return (r & 3) + 8 * (r >> 2) + 4 * hi; }
ADI unsigned cvtpk(float lo, float hi) { unsigned r; asm volatile("v_cvt_pk_bf16_f32 %0, %1, %2" : "=v"(r) : "v"(lo), "v"(hi)); return r; }
ADI bf16x8 ld8(const bf16_t* p) { return *reinterpret_cast<const bf16x8*>(p); }

constexpr float THRL = 60.f;
template <bool FIRST, int MODE = 1>
ADI void softmax_tile(f32x16& p0, f32x16& p1, float& mhat, f32x16& negm, float& l_reg, float& alpha, bf16x8& pa0, bf16x8& pa1, bf16x8& pa2, bf16x8& pa3, const bool chk = true) {
  alpha = 1.f;
  if ((FIRST || MODE != 0) && (FIRST || MODE == 1 || chk)) {
    float pmax = p0[0];
#pragma unroll
    for (int r = 1; r < 16; ++r) pmax = fmaxf(pmax, p0[r]);
#pragma unroll
    for (int r = 0; r < 16; ++r) pmax = fmaxf(pmax, p1[r]);
    { auto rr = __builtin_amdgcn_permlane32_swap(__float_as_uint(pmax), __float_as_uint(pmax), false, false);
      pmax = fmaxf(__uint_as_float(rr[0]), __uint_as_float(rr[1])); }
    if (FIRST || __builtin_expect(__any(pmax > THRL), 0)) {
      const float dl = FIRST ? pmax : fmaxf(pmax, 0.f);
      mhat += dl; alpha = FIRST ? 1.f : __builtin_amdgcn_exp2f(-dl);
#pragma unroll
      for (int r = 0; r < 16; ++r) { p0[r] -= dl; p1[r] -= dl; }
#pragma unroll
      for (int r = 0; r < 16; ++r) negm[r] = -mhat;
    }
  }
#pragma unroll
  for (int r = 0; r < 16; ++r) p0[r] = __builtin_amdgcn_exp2f(p0[r]);
#pragma unroll
  for (int r = 0; r < 16; ++r) p1[r] = __builtin_amdgcn_exp2f(p1[r]);
  float ps = 0;
#pragma unroll
  for (int r = 0; r < 16; ++r) ps += p0[r];
#pragma unroll
  for (int r = 0; r < 16; ++r) ps += p1[r];
  { auto rr = __builtin_amdgcn_permlane32_swap(__float_as_uint(ps), __float_as_uint(ps), false, false);
    ps = __uint_as_float(rr[0]) + __uint_as_float(rr[1]); }
  if constexpr (FIRST || MODE != 0) l_reg = l_reg * alpha + ps; else l_reg += ps;
#define PK8(P, BASE, OUT) do { u32x4 w = {cvtpk(P[BASE + 0], P[BASE + 1]), cvtpk(P[BASE + 2], P[BASE + 3]), cvtpk(P[BASE + 4], P[BASE + 5]), cvtpk(P[BASE + 6], P[BASE + 7])}; OUT = *reinterpret_cast<bf16x8*>(&w); } while (0)
  PK8(p0, 0, pa0); PK8(p0, 8, pa1); PK8(p1, 0, pa2); PK8(p1, 8, pa3);
#undef PK8
}
template <int KPITCH> ADI int kswz(int r) { return KPITCH == 256 ? (((r & 7) | (((r >> 4) & 1) << 3)) << 4) : (((r >> 1) & 7) << 4); }
template <int NKS, int KPITCH>
ADI void qkt(f32x16& p0, f32x16& p1, const char* Ks, const bf16x8* qr, const f32x16& negm, int r32, int hi) {
  const int sw = kswz<KPITCH>(r32);
#pragma unroll
  for (int d0 = 0; d0 < NKS; d0 += 2) {
    const int cb0 = ((d0 * 16 + hi * 8) * 2) ^ sw, cb1 = (((d0 + 1) * 16 + hi * 8) * 2) ^ sw;
    const bf16x8 a0 = *reinterpret_cast<const bf16x8*>(Ks + r32 * KPITCH + cb0), a1 = *reinterpret_cast<const bf16x8*>(Ks + (32 + r32) * KPITCH + cb0);
    const bf16x8 c0 = *reinterpret_cast<const bf16x8*>(Ks + r32 * KPITCH + cb1), c1 = *reinterpret_cast<const bf16x8*>(Ks + (32 + r32) * KPITCH + cb1);
    if (d0 == 0) { p0 = __builtin_amdgcn_mfma_f32_32x32x16_bf16(a0, qr[0], negm, 0, 0, 0); p1 = __builtin_amdgcn_mfma_f32_32x32x16_bf16(a1, qr[0], negm, 0, 0, 0); }
    else { p0 = __builtin_amdgcn_mfma_f32_32x32x16_bf16(a0, qr[d0], p0, 0, 0, 0); p1 = __builtin_amdgcn_mfma_f32_32x32x16_bf16(a1, qr[d0], p1, 0, 0, 0); }
    p0 = __builtin_amdgcn_mfma_f32_32x32x16_bf16(c0, qr[d0 + 1], p0, 0, 0, 0); p1 = __builtin_amdgcn_mfma_f32_32x32x16_bf16(c1, qr[d0 + 1], p1, 0, 0, 0);
    SBAR();
  }
}
template <int NDB> struct VTF { bf16x8 a[NDB]; };
template <int S, int NDB> ADI void vt_load(VTF<NDB>& f, const char* Vb, int r32, int hi) {
  const int off = r32 * 128 + (((2 * S + hi) * 16) ^ kswz<128>(r32));
#pragma unroll
  for (int d = 0; d < NDB; ++d) f.a[d] = *reinterpret_cast<const bf16x8*>(Vb + d * 4096 + off);
}
template <int NDB> ADI void vt_mma(f32x16* o, const VTF<NDB>& f, bf16x8 pb) {
#pragma unroll
  for (int d = 0; d < NDB; ++d) o[d] = __builtin_amdgcn_mfma_f32_32x32x16_bf16(f.a[d], pb, o[d], 0, 0, 0);
}
template <int NDB> ADI void pvT(f32x16* o, const char* Vb, bf16x8 pb0, bf16x8 pb1, bf16x8 pb2, bf16x8 pb3, int r32, int hi) {
  VTF<NDB> fA, fB;
  SBAR(); vt_load<0, NDB>(fA, Vb, r32, hi); vt_load<1, NDB>(fB, Vb, r32, hi); SBAR();
  vt_mma<NDB>(o, fA, pb0); SBAR(); vt_load<2, NDB>(fA, Vb, r32, hi); SBAR();
  vt_mma<NDB>(o, fB, pb1); SBAR(); vt_load<3, NDB>(fB, Vb, r32, hi); SBAR();
  vt_mma<NDB>(o, fA, pb2); SBAR(); vt_mma<NDB>(o, fB, pb3); SBAR();
}

using i32x8 = __attribute__((ext_vector_type(8))) int;
constexpr float VSC8 = 16.f;
constexpr float OFF8 = 4.f;
constexpr float THR8 = 8.f, SUM8 = 448.f;
ADI void mfma8(f32x16& acc, const i32x8& a, const i32x8& b) {
  asm volatile("v_mfma_f32_32x32x64_f8f6f4 %0, %1, %2, %0" : "+v"(acc) : "v"(a), "v"(b));
}
constexpr float QS8 = 4.f, KS8 = 0.25f;
ADI void mfma8_c(f32x16& dst, const i32x8& a, const i32x8& b, const f32x16& c) {
  asm volatile("v_mfma_f32_32x32x64_f8f6f4 %0, %1, %2, %3" : "=&v"(dst) : "v"(a), "v"(b), "v"(c));
}
template <int RB> ADI int kswz8(int r) { return RB == 64 ? (((r >> 2) & 3) << 4) : (((r >> 1) & 7) << 4); }
template <int KB8>
ADI void qkt8(f32x16& p0, f32x16& p1, const char* Ks, const i32x8* q8, const f32x16& negm, int r32, int hi) {
  constexpr int RB = 64 * KB8;
  const int sw = kswz8<RB>(r32);
  u32x4 lo[2][KB8], hh[2][KB8];
  SBAR();
#pragma unroll
  for (int ks = 0; ks < KB8; ++ks)
#pragma unroll
    for (int t = 0; t < 2; ++t) { const char* rowp = Ks + (32 * t + r32) * RB;
      lo[t][ks] = *reinterpret_cast<const u32x4*>(rowp + ((ks * 64 + hi * 32) ^ sw)); hh[t][ks] = *reinterpret_cast<const u32x4*>(rowp + ((ks * 64 + hi * 32 + 16) ^ sw)); }
  SBAR();
#pragma unroll
  for (int ks = 0; ks < KB8; ++ks) {
    const i32x8 a0 = {(int)lo[0][ks][0], (int)lo[0][ks][1], (int)lo[0][ks][2], (int)lo[0][ks][3], (int)hh[0][ks][0], (int)hh[0][ks][1], (int)hh[0][ks][2], (int)hh[0][ks][3]};
    const i32x8 a1 = {(int)lo[1][ks][0], (int)lo[1][ks][1], (int)lo[1][ks][2], (int)lo[1][ks][3], (int)hh[1][ks][0], (int)hh[1][ks][1], (int)hh[1][ks][2], (int)hh[1][ks][3]};
    if (ks == 0) { mfma8_c(p0, a0, q8[0], negm); mfma8_c(p1, a1, q8[0], negm); }
    else { mfma8(p0, a0, q8[ks]); mfma8(p1, a1, q8[ks]); }
  }
  SBAR();
}
template <int NDB> ADI void pvT8(f32x16* o, const char* Vb, const i32x8& pb, int r32, int hi) {
  const int g = (r32 >> 2) & 3;
  const int off0 = r32 * 64 + (((2 * hi) ^ g) << 4), off1 = r32 * 64 + (((2 * hi + 1) ^ g) << 4);
  u32x4 lo[NDB], hh[NDB];
  SBAR();
#pragma unroll
  for (int d = 0; d < NDB; ++d) { lo[d] = *reinterpret_cast<const u32x4*>(Vb + d * 2048 + off0); hh[d] = *reinterpret_cast<const u32x4*>(Vb + d * 2048 + off1); }
  SBAR();
#pragma unroll
  for (int d = 0; d < NDB; ++d) { const i32x8 a = {(int)lo[d][0], (int)lo[d][1], (int)lo[d][2], (int)lo[d][3], (int)hh[d][0], (int)hh[d][1], (int)hh[d][2], (int)hh[d][3]}; mfma8(o[d], a, pb); }
  SBAR();
}
template <bool FIRST>
ADI void softmax_tile8(f32x16& p0, f32x16& p1, float& mhat, f32x16& negm, float& l_reg, float& alpha, i32x8& pb, const bool chk) {
  alpha = 1.f;
  if (FIRST || chk) {
    float pmax = p0[0];
#pragma unroll
    for (int r = 1; r < 16; ++r) pmax = fmaxf(pmax, p0[r]);
#pragma unroll
    for (int r = 0; r < 16; ++r) pmax = fmaxf(pmax, p1[r]);
    { auto rr = __builtin_amdgcn_permlane32_swap(__float_as_uint(pmax), __float_as_uint(pmax), false, false);
      pmax = fmaxf(__uint_as_float(rr[0]), __uint_as_float(rr[1])); }
    if (FIRST || __builtin_expect(__any(pmax > THR8), 0)) {
      const float dl = FIRST ? pmax - OFF8 : (pmax > THR8 ? pmax - OFF8 : 0.f);
      mhat += dl; alpha = FIRST ? 1.f : __builtin_amdgcn_exp2f(-dl);
#pragma unroll
      for (int r = 0; r < 16; ++r) { p0[r] -= dl; p1[r] -= dl; }
#pragma unroll
      for (int r = 0; r < 16; ++r) negm[r] = -mhat;
    }
  }
#pragma unroll
  for (int r = 0; r < 16; ++r) p0[r] = __builtin_amdgcn_exp2f(p0[r]);
#pragma unroll
  for (int r = 0; r < 16; ++r) p1[r] = __builtin_amdgcn_exp2f(p1[r]);
  float ps = 0;
#pragma unroll
  for (int r = 0; r < 16; ++r) ps += p0[r];
#pragma unroll
  for (int r = 0; r < 16; ++r) ps += p1[r];
  float hmax;
  { auto rr = __builtin_amdgcn_permlane32_swap(__float_as_uint(ps), __float_as_uint(ps), false, false);
    const float h0 = __uint_as_float(rr[0]), h1 = __uint_as_float(rr[1]); ps = h0 + h1; hmax = fmaxf(h0, h1); }
  if (!FIRST && !chk) {
    if (__builtin_expect(__any(hmax > SUM8), 0)) {
      const float dl = hmax > SUM8 ? ceilf(__builtin_amdgcn_logf(hmax)) - 6.f : 0.f;
      const float f = __builtin_amdgcn_exp2f(-dl);
      mhat += dl; alpha = f; ps *= f;
#pragma unroll
      for (int r = 0; r < 16; ++r) { p0[r] *= f; p1[r] *= f; }
#pragma unroll
      for (int r = 0; r < 16; ++r) negm[r] = -mhat;
    }
  }
  l_reg = l_reg * alpha + ps;
#pragma unroll
  for (int i = 0; i < 4; ++i) { int w = __builtin_amdgcn_cvt_pk_fp8_f32(p0[4 * i], p0[4 * i + 1], 0, false); pb[i] = __builtin_amdgcn_cvt_pk_fp8_f32(p0[4 * i + 2], p0[4 * i + 3], w, true); }
#pragma unroll
  for (int i = 0; i < 4; ++i) { int w = __builtin_amdgcn_cvt_pk_fp8_f32(p1[4 * i], p1[4 * i + 1], 0, false); pb[4 + i] = __builtin_amdgcn_cvt_pk_fp8_f32(p1[4 * i + 2], p1[4 * i + 3], w, true); }
}

template <int DQK, int DV, int RING = 3, bool PV8 = false, bool QK8 = false> struct Cfg {
  static constexpr int KB8 = (DQK + 63) / 64, KPITCH = QK8 ? 64 * KB8 : (DQK <= 64) ? 128 : 256, SHM_K = 64 * KPITCH, SHM_V = PV8 ? 64 * DV : 64 * DV * 2, NDB = DV / 32, NKS = DQK / 16;
  static constexpr int NBUF = RING;
  static constexpr int WS_OFF = NBUF * (SHM_V + SHM_K);
  static constexpr int STASH_OFF = WS_OFF + 8 * 64 * 4;
};

template <int DQK, int DV, int RING = 3, bool SPEC = false, bool PV8 = false, bool QK8 = false>
ADI void attn_core(const bf16_t* __restrict__ Qb, const bf16_t* __restrict__ Kh, const bf16_t* __restrict__ Vt, const int vpitch, int seq, char* lds,
                   f32x16 (&o)[DV / 32], float& l_reg, const int wid, const float kmax2, unsigned long long* prof = nullptr) {
  using CF = Cfg<DQK, DV, RING, PV8, QK8>;
  constexpr int KB8 = CF::KB8;
  constexpr int KPITCH = CF::KPITCH, SHM_K = CF::SHM_K, SHM_V = CF::SHM_V, NDB = CF::NDB, NKS = CF::NKS;
  int lane_ = (int)__builtin_amdgcn_mbcnt_hi(~0u, __builtin_amdgcn_mbcnt_lo(~0u, 0u)); asm volatile("" : "+v"(lane_));
  const int lane = lane_, tid = wid * 64 + lane, r32 = lane & 31, hi = lane >> 5;
  const int grp = wid >> 2;
  char* K_lds = lds; char* V_lds = lds + RING * SHM_K;
  float mhat = 0.f; l_reg = 0.f; f32x16 negm = f32x16{};
#pragma unroll
  for (int d = 0; d < NDB; ++d) o[d] = f32x16{};
  bf16x8 qr[NKS]; i32x8 q8[KB8];
  float bnd;
  if constexpr (QK8) {
    const char* Qw8 = (const char*)Qb + (size_t)(wid * 32 + r32) * (64 * KB8) + hi * 32;
    float qn2 = 0.f;
#pragma unroll
    for (int ks = 0; ks < KB8; ++ks) { const u32x4 a = *reinterpret_cast<const u32x4*>(Qw8 + ks * 64), b = *reinterpret_cast<const u32x4*>(Qw8 + ks * 64 + 16);
      q8[ks] = i32x8{(int)a[0], (int)a[1], (int)a[2], (int)a[3], (int)b[0], (int)b[1], (int)b[2], (int)b[3]};
#pragma unroll
      for (int j = 0; j < 8; ++j) { const auto x = __builtin_amdgcn_cvt_pk_f32_fp8(q8[ks][j], false), y = __builtin_amdgcn_cvt_pk_f32_fp8(q8[ks][j], true); qn2 += (x[0] * x[0] + x[1] * x[1]) + (y[0] * y[0] + y[1] * y[1]); } }
    auto rr = __builtin_amdgcn_permlane32_swap(__float_as_uint(qn2), __float_as_uint(qn2), false, false);
    qn2 = __uint_as_float(rr[0]) + __uint_as_float(rr[1]);
    bnd = sqrtf(qn2 * kmax2) * (1.07f / QS8);
  } else {
  const bf16_t* Qw = Qb + (long)(wid * 32 + r32) * DQK + hi * 8;
#pragma unroll
  for (int d0 = 0; d0 < NKS; ++d0) qr[d0] = ld8(Qw + d0 * 16);
  { float qn2 = 0.f;
#pragma unroll
    for (int d0 = 0; d0 < NKS; ++d0) {
#pragma unroll
      for (int j = 0; j < 8; ++j) { const float x = __uint_as_float(((unsigned)(unsigned short)qr[d0][j]) << 16); qn2 += x * x; } }
    auto rr = __builtin_amdgcn_permlane32_swap(__float_as_uint(qn2), __float_as_uint(qn2), false, false);
    qn2 = __uint_as_float(rr[0]) + __uint_as_float(rr[1]);
    bnd = sqrtf(qn2 * kmax2) * 1.02f; }
  }
  constexpr int KCH = DQK / 8, TPRK = (KCH <= 8) ? 8 : 16, NKL = (TPRK == 8) ? 1 : 2, KRPP = 512 / TPRK;
  constexpr int NVL = DV / 64;
  static_assert(DV == 64 || DV == 128, "DV is 64 or 128");
  constexpr int CPR8 = 4 * KB8;
  const int krow = QK8 ? tid / CPR8 : tid / TPRK, kch = QK8 ? tid % CPR8 : tid % TPRK; const bool kvalid = QK8 ? (krow < 64) : (kch < KCH);
  const int vrow = PV8 ? (tid >> 2) : (tid >> 3), vch = PV8 ? (tid & 3) : (tid & 7);
  const bool vvalid = !PV8 || DV == 128 || tid < 256;
  struct { bf16x8 k0, k1, v0, v1; } sr_[2];
  const unsigned koff = QK8 ? (unsigned)(krow * (64 * KB8) + kch * 16) : (unsigned)(krow * DQK + kch * 8) * 2u, voff = PV8 ? (unsigned)(vrow * vpitch + vch * 16) : (unsigned)(vrow * vpitch + vch * 8) * 2u;
  const int kst0 = QK8 ? (krow * KPITCH + ((kch * 16) ^ kswz8<64 * KB8>(krow))) : (krow * KPITCH + ((kch * 16) ^ kswz<KPITCH>(krow))), kst1 = (krow + KRPP) * KPITCH + ((kch * 16) ^ kswz<KPITCH>(krow + KRPP));
  const int vst0 = PV8 ? (vrow * 64 + ((vch ^ ((vrow >> 2) & 3)) << 4)) : (vrow * 128 + ((vch * 16) ^ kswz<128>(vrow))), vst1 = vst0 + 64 * 128;
#define LD8B(base, off) (*reinterpret_cast<const bf16x8*>((const char*)(base) + (off)))
#define SLOAD(i, kk0) do { const char* kp_ = (const char*)Kh + (size_t)(kk0) * (QK8 ? 64 * KB8 : DQK * 2); const char* vp_ = (const char*)Vt + (size_t)(kk0) * (PV8 ? 1 : 2); \
    if (kvalid) { sr_[i].k0 = LD8B(kp_, koff); if constexpr (NKL == 2 && !QK8) sr_[i].k1 = LD8B(kp_ + KRPP * DQK * 2, koff); } \
    if constexpr (PV8) { if (vvalid) sr_[i].v0 = LD8B(vp_, voff); } else { sr_[i].v0 = LD8B(vp_, voff); if constexpr (NVL == 2) sr_[i].v1 = LD8B(vp_ + (size_t)64 * vpitch * 2, voff); } } while (0)
#define SWRITE(b, i) do { \
    if (kvalid) { *(bf16x8*)(K_lds + (b) * SHM_K + kst0) = sr_[i].k0; if constexpr (NKL == 2 && !QK8) *(bf16x8*)(K_lds + (b) * SHM_K + kst1) = sr_[i].k1; } \
    if constexpr (PV8) { if (vvalid) *(bf16x8*)(V_lds + (b) * SHM_V + vst0) = sr_[i].v0; } else { *(bf16x8*)(V_lds + (b) * SHM_V + vst0) = sr_[i].v0; if constexpr (NVL == 2) *(bf16x8*)(V_lds + (b) * SHM_V + vst1) = sr_[i].v1; } } while (0)
#define LBAR() asm volatile("s_waitcnt lgkmcnt(0)\n\ts_barrier" ::: "memory")
#define RESC(a) do { if (__any((a) < 1.f)) { _Pragma("unroll") for (int d = 0; d < NDB; ++d) _Pragma("unroll") for (int r = 0; r < 16; ++r) o[d][r] *= (a); } } while (0)
  f32x16 p0, p1; float alpha; bf16x8 pa0, pa1, pa2, pa3; i32x8 pb; const int NT = seq / 64;
#define QKCALL(Ks_) do { if constexpr (QK8) qkt8<KB8>(p0, p1, Ks_, q8, negm, r32, hi); else qkt<NKS, KPITCH>(p0, p1, Ks_, qr, negm, r32, hi); } while (0)
#define PVCALL(Vb_) do { if constexpr (PV8) pvT8<NDB>(o, Vb_, pb, r32, hi); else pvT<NDB>(o, Vb_, pa0, pa1, pa2, pa3, r32, hi); } while (0)
#define SMX(FIRST_, CHK_, chk_) do { if constexpr (PV8) softmax_tile8<FIRST_>(p0, p1, mhat, negm, l_reg, alpha, pb, (FIRST_) || (CHK_) == 1 || ((CHK_) == 2 && (chk_))); \
    else softmax_tile<FIRST_, CHK_>(p0, p1, mhat, negm, l_reg, alpha, pa0, pa1, pa2, pa3, chk_); } while (0)
#ifdef ATT_PROF
#define TS(x) do { x = __builtin_amdgcn_s_memtime(); asm volatile("s_waitcnt lgkmcnt(0)" ::: "memory"); } while (0)
#define PROF_DECL unsigned long long t0_, t1_, t2_, t3_, t4_
#define PROF_ACC() do { if (prof) { prof[0] += t1_ - t0_; prof[1] += t2_ - t1_; prof[2] += t3_ - t2_; prof[3] += t4_ - t3_; prof[4] += 1; } } while (0)
#else
#define TS(x) do { } while (0)
#define PROF_DECL
#define PROF_ACC() do { } while (0)
#endif
#define STEP(n_, SL, CHK_) do { PROF_DECL; TS(t0_); __builtin_amdgcn_s_setprio(ATT_MPRIO);     \
    QKCALL(K_lds + kb * SHM_K); SBAR(); \
    PVCALL(V_lds + vbi * SHM_V); \
    __builtin_amdgcn_s_setprio(ATT_VPRIO); \
    if ((n_) + 1 < NT) SWRITE(wb, SL); \
    TS(t1_); if (grp == 1) LBAR(); TS(t2_); \
    if ((n_) + 3 < NT) SLOAD(SL, ((n_) + 3) * 64); \
    SBAR(); \
    SMX(false, CHK_, chk); SBAR(); \
    if constexpr ((CHK_) != 0 || PV8) RESC(alpha); \
    TS(t3_); if (grp == 0) LBAR(); TS(t4_); PROF_ACC(); \
    vbi = kb; kb = wb; wb = (wb == 2) ? 0 : wb + 1; } while (0)
  if constexpr (RING == 3) {
  LBAR();
    SLOAD(0, 0); SLOAD(1, 64); SWRITE(0, 0); if (2 < NT) SLOAD(0, 128);
    LBAR();
    QKCALL(K_lds); if constexpr (QK8) { asm volatile("s_nop 15\n\ts_nop 15\n\ts_nop 15\n\ts_nop 15\n\ts_nop 15" : "+v"(p0), "+v"(p1)); }
    SWRITE(1, 1);
    if (grp == 1) LBAR();
    if (3 < NT) SLOAD(1, 192);
    SBAR();
    SMX(true, 1, true); SBAR();
    const bool chk = !__all(bnd - mhat <= THRL);
    if (grp == 0) LBAR();
    int kb = 1, vbi = 0, wb = 2;
    if constexpr (SPEC) {
    if (!chk) { for (int n = 1; n + 1 < NT; n += 2) { STEP(n, 0, 0); STEP(n + 1, 1, 0); } STEP(NT - 1, 0, 0); }
    else { for (int n = 1; n + 1 < NT; n += 2) { STEP(n, 0, 1); STEP(n + 1, 1, 1); } STEP(NT - 1, 0, 1); }
    } else { for (int n = 1; n + 1 < NT; n += 2) { STEP(n, 0, 2); STEP(n + 1, 1, 2); } STEP(NT - 1, 0, 2); }
    { __builtin_amdgcn_s_setprio(1); PVCALL(V_lds + vbi * SHM_V); __builtin_amdgcn_s_setprio(0); }
    __builtin_amdgcn_s_setprio(0);
  } else {
#define STEP5(n_, SL, BAR_, CHK_) do { __builtin_amdgcn_s_setprio(ATT_MPRIO); \
    QKCALL(K_lds + kb * SHM_K); SBAR(); \
    PVCALL(V_lds + vbi * SHM_V); \
    __builtin_amdgcn_s_setprio(ATT_VPRIO); \
    if ((n_) + 2 < NT) SWRITE(wb, SL); \
    if ((BAR_) && grp == 1) LBAR(); \
    if ((n_) + 4 < NT) SLOAD(SL, ((n_) + 4) * 64); \
    SBAR(); \
    SMX(false, CHK_, chk); SBAR(); \
    if constexpr ((CHK_) != 0 || PV8) RESC(alpha); \
    if ((BAR_) && grp == 0) LBAR(); \
    vbi = kb; kb = (kb == 4) ? 0 : kb + 1; wb = (wb == 4) ? 0 : wb + 1; } while (0)
  LBAR();
  SLOAD(0, 0); SLOAD(1, 64); SWRITE(0, 0); SLOAD(0, 128); SWRITE(1, 1); SLOAD(1, 192);
  LBAR();
  QKCALL(K_lds); if constexpr (QK8) { asm volatile("s_nop 15\n\ts_nop 15\n\ts_nop 15\n\ts_nop 15\n\ts_nop 15" : "+v"(p0), "+v"(p1)); }
  SWRITE(2, 0);
  if (4 < NT) SLOAD(0, 256);
  SBAR();
  SMX(true, 1, true); SBAR();
  const bool chk = !__all(bnd - mhat <= THRL);
  int kb = 1, vbi = 0, wb = 3;
  if constexpr (SPEC) {
  if (!chk) { for (int n = 1; n + 1 < NT; n += 2) { STEP5(n, 1, true, 0); STEP5(n + 1, 0, false, 0); } STEP5(NT - 1, 1, true, 0); }
  else { for (int n = 1; n + 1 < NT; n += 2) { STEP5(n, 1, true, 1); STEP5(n + 1, 0, false, 1); } STEP5(NT - 1, 1, true, 1); }
  } else { for (int n = 1; n + 1 < NT; n += 2) { STEP5(n, 1, true, 2); STEP5(n + 1, 0, false, 2); } STEP5(NT - 1, 1, true, 2); }
  { __builtin_amdgcn_s_setprio(1); PVCALL(V_lds + vbi * SHM_V); __builtin_amdgcn_s_setprio(0); }
#undef STEP5
  }
  if constexpr (PV8) { asm volatile("s_nop 15\n\ts_nop 15\n\ts_nop 15\n\ts_nop 15\n\ts_nop 15" : "+v"(o[0]), "+v"(o[NDB - 1])); }
#undef PVCALL
#undef QKCALL
#undef SMX
#undef STEP
#undef SLOAD
#undef LD8B
#undef SWRITE
#undef LBAR
#undef RESC
}

template <int DQK, int DV> struct Cfg2 {
  static constexpr int KB8 = (DQK + 63) / 64, RB = 64 * KB8, SHM_K = 64 * RB, NDB = DV / 32, SHM_V = DV * 64, NBUF = 4;
  static constexpr int WS_OFF = NBUF * (SHM_K + SHM_V), STASH_OFF = WS_OFF + 2048;
};
#define NOP80 "s_nop 15\n\ts_nop 15\n\ts_nop 15\n\ts_nop 15\n\ts_nop 15"
#define NOP256 NOP80 "\n\t" NOP80 "\n\t" NOP80 "\n\ts_nop 15"
template <int A, int B> ADI void exps2(f32x16& x0, f32x16& x1) {
#pragma unroll
  for (int e = A; e < B; ++e) { if (e < 16) x0[e] = __builtin_amdgcn_exp2f(x0[e]); else x1[e - 16] = __builtin_amdgcn_exp2f(x1[e - 16]); }
}
template <int A, int B, bool INIT = false> ADI void adds2(float (&s4)[4], const f32x16& x0, const f32x16& x1) {
#pragma unroll
  for (int e = A; e < B; ++e) { const float x = (e < 16) ? x0[e] : x1[e - 16]; if (INIT && e < 2) s4[e & 1] = x; else s4[e & 1] += x; }
}
ADI __amdgpu_buffer_rsrc_t mk_rsrc(const char* p) {
  const unsigned long long a = (unsigned long long)p;
  const unsigned lo = __builtin_amdgcn_readfirstlane((unsigned)a), hi = __builtin_amdgcn_readfirstlane((unsigned)(a >> 32));
  return __builtin_amdgcn_make_buffer_rsrc((void*)(((unsigned long long)hi << 32) | lo), 0, 0x7ffffff0, 0x00020000);
}
template <int DQK, int DV, bool CHKC>
ADI bool attn_core2(const char* __restrict__ Qb, const char* __restrict__ Kh, const char* __restrict__ Vt, const int vpitch, const int seq, char* lds,
                    f32x16 (&o)[DV / 32], float& l_out, const int wid, const float kmax2) {
  using CF = Cfg2<DQK, DV>;
  constexpr int KB8 = CF::KB8, RB = CF::RB, SHM_K = CF::SHM_K, NDB = CF::NDB, SHM_V = CF::SHM_V;
  static_assert((KB8 == 1 && NDB == 4) || (KB8 == 2 && NDB == 2), "six MFMAs per tile: (64,128) or (96,64)");
  int lane_ = (int)__builtin_amdgcn_mbcnt_hi(~0u, __builtin_amdgcn_mbcnt_lo(~0u, 0u)); asm volatile("" : "+v"(lane_));
  const int lane = lane_, tid = wid * 64 + lane, r32 = lane & 31, hi = lane >> 5;
  char* K_lds = lds; char* V_lds = lds + CF::NBUF * SHM_K;
  float mhat = 0.f, l_reg = 0.f; f32x16 negm = f32x16{};
#pragma unroll
  for (int d = 0; d < NDB; ++d) o[d] = f32x16{};
  i32x8 q8[KB8]; float bnd;
  { const char* Qw8 = Qb + (size_t)(wid * 32 + r32) * RB + hi * 32; float qn2 = 0.f;
#pragma unroll
    for (int ks = 0; ks < KB8; ++ks) { const u32x4 a = *reinterpret_cast<const u32x4*>(Qw8 + ks * 64), b = *reinterpret_cast<const u32x4*>(Qw8 + ks * 64 + 16);
      q8[ks] = i32x8{(int)a[0], (int)a[1], (int)a[2], (int)a[3], (int)b[0], (int)b[1], (int)b[2], (int)b[3]};
#pragma unroll
      for (int j = 0; j < 8; ++j) { const auto x = __builtin_amdgcn_cvt_pk_f32_fp8(q8[ks][j], false), y = __builtin_amdgcn_cvt_pk_f32_fp8(q8[ks][j], true); qn2 += (x[0] * x[0] + x[1] * x[1]) + (y[0] * y[0] + y[1] * y[1]); } }
    auto rr = __builtin_amdgcn_permlane32_swap(__float_as_uint(qn2), __float_as_uint(qn2), false, false);
    qn2 = __uint_as_float(rr[0]) + __uint_as_float(rr[1]);
    bnd = sqrtf(qn2 * kmax2) * (1.07f / QS8); }
  constexpr int CPR8 = 4 * KB8;
  using sv2 = __attribute__((ext_vector_type(2))) unsigned;
  constexpr bool KS = false, VS = (DV == 64);
  const bool kvalid = (KB8 == 2) || wid < 4;
  constexpr int KCB = KS ? 8 : 16, VCB = VS ? 8 : 16;
  const int krow = KS ? (tid >> 3) : (tid / CPR8), kch = KS ? (tid & 7) : (tid % CPR8);
  const int vrow = VS ? (tid >> 3) : (tid >> 2), vch = VS ? (tid & 7) : (tid & 3);
  struct { bf16x8 k0, v0; sv2 k2, v2; } sr_[2];
  const unsigned koff = (unsigned)(krow * RB + kch * KCB), voff = (unsigned)(vrow * vpitch + vch * VCB);
  const int kst0 = krow * RB + ((kch * KCB) ^ kswz8<RB>(krow)), vst0 = VS ? (vrow * 64 + ((((vch >> 1) ^ ((vrow >> 2) & 3)) << 4) | ((vch & 1) << 3))) : (vrow * 64 + ((vch ^ ((vrow >> 2) & 3)) << 4));
#define LD8B(base, off) (*reinterpret_cast<const bf16x8*>((const char*)(base) + (off)))
  const __amdgpu_buffer_rsrc_t krs = mk_rsrc(Kh), vrs = mk_rsrc(Vt);
#define SLOAD(i, kk0) do { \
    if constexpr (KS) sr_[i].k2 = __builtin_bit_cast(sv2, __builtin_amdgcn_raw_buffer_load_b64(krs, (int)koff, (int)((kk0) * RB), 0)); else if (kvalid) sr_[i].k0 = __builtin_bit_cast(bf16x8, __builtin_amdgcn_raw_buffer_load_b128(krs, (int)koff, (int)((kk0) * RB), 0)); \
    if constexpr (VS) sr_[i].v2 = __builtin_bit_cast(sv2, __builtin_amdgcn_raw_buffer_load_b64(vrs, (int)voff, (int)(kk0), 0)); else sr_[i].v0 = __builtin_bit_cast(bf16x8, __builtin_amdgcn_raw_buffer_load_b128(vrs, (int)voff, (int)(kk0), 0)); } while (0)
#define SWRITE(b, i) do { \
    if constexpr (KS) *(sv2*)(K_lds + (b) * SHM_K + kst0) = sr_[i].k2; else if (kvalid) *(bf16x8*)(K_lds + (b) * SHM_K + kst0) = sr_[i].k0; \
    if constexpr (VS) *(sv2*)(V_lds + (b) * SHM_V + vst0) = sr_[i].v2; else *(bf16x8*)(V_lds + (b) * SHM_V + vst0) = sr_[i].v0; } while (0)
#define LBAR() asm volatile("s_waitcnt lgkmcnt(0)\n\ts_barrier" ::: "memory")
#define PIN(a_, b_) asm volatile("" : "+v"(a_), "+v"(b_), "+v"(ps4[0]), "+v"(ps4[1]))
  const int swk = kswz8<RB>(r32), gv = (r32 >> 2) & 3;
  const int kfo = r32 * RB, vfo0 = r32 * 64 + (((2 * hi) ^ gv) << 4), vfo1 = r32 * 64 + (((2 * hi + 1) ^ gv) << 4);
#define KLO(Kb_, t, ks) (*reinterpret_cast<const u32x4*>((Kb_) + kfo + (t) * 32 * RB + (((ks) * 64 + hi * 32) ^ swk)))
#define KHH(Kb_, t, ks) (*reinterpret_cast<const u32x4*>((Kb_) + kfo + (t) * 32 * RB + (((ks) * 64 + hi * 32 + 16) ^ swk)))
#define VLO(Vb_, d) (*reinterpret_cast<const u32x4*>((Vb_) + (d) * 2048 + vfo0))
#define VHH(Vb_, d) (*reinterpret_cast<const u32x4*>((Vb_) + (d) * 2048 + vfo1))
#define MK8(lo_, hh_) i32x8{(int)(lo_)[0], (int)(lo_)[1], (int)(lo_)[2], (int)(lo_)[3], (int)(hh_)[0], (int)(hh_)[1], (int)(hh_)[2], (int)(hh_)[3]}
  f32x16 X0, X1, Y0, Y1; i32x8 pb = {0, 0, 0, 0, 0, 0, 0, 0}; float ps4[4] = {0.f, 0.f, 0.f, 0.f}; const int NT = seq / 64;
#define TAIL(E0, E1, C0, C1, HAVE_C) do { \
    float ps = ps4[0] + ps4[1];        \
    if (__builtin_expect(__any(ps > SUM8), 0)) { \
      float hmax; { auto rr = __builtin_amdgcn_permlane32_swap(__float_as_uint(ps), __float_as_uint(ps), false, false); hmax = fmaxf(__uint_as_float(rr[0]), __uint_as_float(rr[1])); }        \
      const float dl = hmax > SUM8 ? ceilf(__builtin_amdgcn_logf(hmax)) - 6.f : 0.f; const float f = __builtin_amdgcn_exp2f(-dl); \
      mhat += dl; ps *= f; l_reg *= f; \
      asm volatile(NOP256 ::: "memory");        \
      _Pragma("unroll") for (int r = 0; r < 16; ++r) { E0[r] *= f; E1[r] *= f; negm[r] = -mhat; } \
      if (HAVE_C) { _Pragma("unroll") for (int r = 0; r < 16; ++r) { C0[r] -= dl; C1[r] -= dl; } } \
      _Pragma("unroll") for (int d = 0; d < NDB; ++d) _Pragma("unroll") for (int r = 0; r < 16; ++r) o[d][r] *= f; \
    } \
    l_reg += ps; if constexpr (!CHKC) asm volatile("" : "+v"(l_reg));        \
    _Pragma("unroll") for (int i = 0; i < 4; ++i) { int w = __builtin_amdgcn_cvt_pk_fp8_f32(E0[4 * i], E0[4 * i + 1], pb[i], false); pb[i] = __builtin_amdgcn_cvt_pk_fp8_f32(E0[4 * i + 2], E0[4 * i + 3], w, true); } \
    _Pragma("unroll") for (int i = 0; i < 4; ++i) { int w = __builtin_amdgcn_cvt_pk_fp8_f32(E1[4 * i], E1[4 * i + 1], pb[4 + i], false); pb[4 + i] = __builtin_amdgcn_cvt_pk_fp8_f32(E1[4 * i + 2], E1[4 * i + 3], w, true); } \
  } while (0)
#define PRECHECK(C0, C1, FIRST_) do { \
    float pmax = C0[0]; \
    _Pragma("unroll") for (int r = 1; r < 16; ++r) pmax = fmaxf(pmax, C0[r]); \
    _Pragma("unroll") for (int r = 0; r < 16; ++r) pmax = fmaxf(pmax, C1[r]); \
    { auto rr = __builtin_amdgcn_permlane32_swap(__float_as_uint(pmax), __float_as_uint(pmax), false, false); pmax = fmaxf(__uint_as_float(rr[0]), __uint_as_float(rr[1])); } \
    if ((FIRST_) || __builtin_expect(__any(pmax > THR8), 0)) { \
      const float dl = (FIRST_) ? pmax - OFF8 : (pmax > THR8 ? pmax - OFF8 : 0.f); mhat += dl; \
      _Pragma("unroll") for (int r = 0; r < 16; ++r) { C0[r] -= dl; C1[r] -= dl; negm[r] = -mhat; } \
      if (!(FIRST_)) { const float f = __builtin_amdgcn_exp2f(-dl); l_reg *= f; fpend = f; }        \
    } } while (0)
#define ITER(E0, E1, C0, C1, n_, HAVE_QK, KBI, VBI, WBI, SLOT) do {        \
    const char* Kb_ = K_lds + (KBI) * SHM_K; const char* Vb_ = V_lds + (VBI) * SHM_V; \
    u32x4 kl[2][KB8], kh[2][KB8], vl[NDB], vh[NDB]; float fpend = 1.f; \
    SBAR(); \
    if (HAVE_QK) { _Pragma("unroll") for (int ks = 0; ks < KB8; ++ks) _Pragma("unroll") for (int t = 0; t < 2; ++t) { kl[t][ks] = KLO(Kb_, t, ks); kh[t][ks] = KHH(Kb_, t, ks); } } \
    _Pragma("unroll") for (int d = 0; d < 2; ++d) { vl[d] = VLO(Vb_, d); vh[d] = VHH(Vb_, d); } \
    SBAR(); \
    TAIL(E0, E1, C0, C1, true); \
    if constexpr (CHKC) PRECHECK(C0, C1, false); \
    SBAR(); \
    if constexpr (KB8 == 1) {     \
      if (HAVE_QK) { mfma8_c(E0, MK8(kl[0][0], kh[0][0]), q8[0], negm); } SBAR(); exps2<0, 6>(C0, C1); PIN(C0, C1); SBAR(); \
      if (HAVE_QK) { mfma8_c(E1, MK8(kl[1][0], kh[1][0]), q8[0], negm); } SBAR(); exps2<6, 12>(C0, C1); adds2<0, 6, true>(ps4, C0, C1); PIN(C0, C1); vl[2] = VLO(Vb_, 2); vh[2] = VHH(Vb_, 2); vl[3] = VLO(Vb_, 3); vh[3] = VHH(Vb_, 3); SBAR(); \
      mfma8(o[0], MK8(vl[0], vh[0]), pb); SBAR(); exps2<12, 18>(C0, C1); adds2<6, 12>(ps4, C0, C1); PIN(C0, C1); SBAR(); \
      mfma8(o[1], MK8(vl[1], vh[1]), pb); SBAR(); exps2<18, 24>(C0, C1); adds2<12, 18>(ps4, C0, C1); PIN(C0, C1); SBAR(); \
      mfma8(o[2], MK8(vl[2], vh[2]), pb); SBAR(); exps2<24, 30>(C0, C1); adds2<18, 24>(ps4, C0, C1); PIN(C0, C1); SBAR(); \
      mfma8(o[3], MK8(vl[3], vh[3]), pb); SBAR(); exps2<30, 32>(C0, C1); adds2<24, 32>(ps4, C0, C1); PIN(C0, C1); SBAR(); \
    } else {                      \
      if (HAVE_QK) { mfma8_c(E0, MK8(kl[0][0], kh[0][0]), q8[0], negm); } SBAR(); exps2<0, 6>(C0, C1); PIN(C0, C1); SBAR(); \
      if (HAVE_QK) { mfma8_c(E1, MK8(kl[1][0], kh[1][0]), q8[0], negm); } SBAR(); exps2<6, 12>(C0, C1); adds2<0, 6, true>(ps4, C0, C1); PIN(C0, C1); SBAR(); \
      if (HAVE_QK) { mfma8(E0, MK8(kl[0][1], kh[0][1]), q8[1]); } SBAR(); exps2<12, 18>(C0, C1); adds2<6, 12>(ps4, C0, C1); PIN(C0, C1); SBAR(); \
      if (HAVE_QK) { mfma8(E1, MK8(kl[1][1], kh[1][1]), q8[1]); } SBAR(); exps2<18, 24>(C0, C1); adds2<12, 18>(ps4, C0, C1); PIN(C0, C1); SBAR(); \
      mfma8(o[0], MK8(vl[0], vh[0]), pb); SBAR(); exps2<24, 30>(C0, C1); adds2<18, 24>(ps4, C0, C1); PIN(C0, C1); SBAR(); \
      mfma8(o[1], MK8(vl[1], vh[1]), pb); SBAR(); exps2<30, 32>(C0, C1); adds2<24, 32>(ps4, C0, C1); PIN(C0, C1); SBAR(); \
    } \
    if constexpr (CHKC) { if (__any(fpend < 1.f)) { asm volatile(NOP256 ::: "memory"); _Pragma("unroll") for (int d = 0; d < NDB; ++d) _Pragma("unroll") for (int r = 0; r < 16; ++r) o[d][r] *= fpend; } } \
    SWRITE((WBI), (SLOT)); SLOAD((SLOT), ((n_) + 4) * 64);        \
    LBAR(); } while (0)
  LBAR();
  SLOAD(0, 0); SLOAD(1, 64); SWRITE(0, 0); SLOAD(0, 128); SWRITE(1, 1); SLOAD(1, 192);
  LBAR();
  { const char* Kb_ = K_lds; u32x4 kl[2][KB8], kh[2][KB8];
#pragma unroll
    for (int ks = 0; ks < KB8; ++ks)
#pragma unroll
      for (int t = 0; t < 2; ++t) { kl[t][ks] = KLO(Kb_, t, ks); kh[t][ks] = KHH(Kb_, t, ks); }
    mfma8_c(Y0, MK8(kl[0][0], kh[0][0]), q8[0], negm); mfma8_c(Y1, MK8(kl[1][0], kh[1][0]), q8[0], negm);
    if constexpr (KB8 == 2) { mfma8(Y0, MK8(kl[0][1], kh[0][1]), q8[1]); mfma8(Y1, MK8(kl[1][1], kh[1][1]), q8[1]); }
    asm volatile(NOP80 : "+v"(Y0), "+v"(Y1)); }
  { float fpend = 1.f; PRECHECK(Y0, Y1, true); (void)fpend; }
  const bool need = !CHKC && !__all(bnd - mhat <= THRL);
  { const char* Kb_ = K_lds + SHM_K; u32x4 kl[2][KB8], kh[2][KB8];
    SBAR();
#pragma unroll
    for (int ks = 0; ks < KB8; ++ks)
#pragma unroll
      for (int t = 0; t < 2; ++t) { kl[t][ks] = KLO(Kb_, t, ks); kh[t][ks] = KHH(Kb_, t, ks); }
    SBAR();
    mfma8_c(X0, MK8(kl[0][0], kh[0][0]), q8[0], negm); SBAR(); exps2<0, 8>(Y0, Y1); PIN(Y0, Y1); SBAR();
    mfma8_c(X1, MK8(kl[1][0], kh[1][0]), q8[0], negm); SBAR(); exps2<8, 16>(Y0, Y1); PIN(Y0, Y1); SBAR();
    if constexpr (KB8 == 2) { mfma8(X0, MK8(kl[0][1], kh[0][1]), q8[1]); SBAR(); exps2<16, 24>(Y0, Y1); PIN(Y0, Y1); SBAR(); mfma8(X1, MK8(kl[1][1], kh[1][1]), q8[1]); SBAR(); exps2<24, 32>(Y0, Y1); PIN(Y0, Y1); }
    else { exps2<16, 32>(Y0, Y1); PIN(Y0, Y1); }
    adds2<0, 32>(ps4, Y0, Y1); PIN(Y0, Y1); SBAR();
    SWRITE(2, 0); SLOAD(0, 256);
    LBAR(); }
  ITER(Y0, Y1, X0, X1, 1, true, 2, 0, 3, 1); ITER(X0, X1, Y0, Y1, 2, true, 3, 1, 0, 0);
  for (int n = 3; n + 2 < NT; n += 4) {
    ITER(Y0, Y1, X0, X1, n, true, 0, 2, 1, 1); ITER(X0, X1, Y0, Y1, n + 1, true, 1, 3, 2, 0);
    ITER(Y0, Y1, X0, X1, n + 2, true, 2, 0, 3, 1); ITER(X0, X1, Y0, Y1, n + 3, true, 3, 1, 0, 0); }
  ITER(Y0, Y1, X0, X1, NT - 1, false, 0, 2, 1, 1);
  { const char* Vb_ = V_lds + 3 * SHM_V; u32x4 vl[NDB], vh[NDB];
    SBAR();
#pragma unroll
    for (int d = 0; d < NDB; ++d) { vl[d] = VLO(Vb_, d); vh[d] = VHH(Vb_, d); }
    SBAR();
    TAIL(X0, X1, Y0, Y1, false);
    SBAR(); asm volatile("s_nop 7" : "+v"(pb)); SBAR();
#pragma unroll
    for (int d = 0; d < NDB; ++d) mfma8(o[d], MK8(vl[d], vh[d]), pb);
    asm volatile(NOP80 : "+v"(o[0]), "+v"(o[NDB - 1])); }
  { auto rr = __builtin_amdgcn_permlane32_swap(__float_as_uint(l_reg), __float_as_uint(l_reg), false, false); l_out = __uint_as_float(rr[0]) + __uint_as_float(rr[1]); }
  return need;
#undef ITER
#undef PIN
#undef PRECHECK
#undef TAIL
#undef MK8
#undef VHH
#undef VLO
#undef KHH
#undef KLO
#undef LBAR
#undef SWRITE
#undef SLOAD
#undef LD8B
}
}
typedef unsigned short bf16_fwd_decl_unused;
#define GAS __attribute__((address_space(1)))
#define LAS __attribute__((address_space(3)))
#define DI __device__ __forceinline__
typedef unsigned short bf16;
typedef float f32x4 __attribute__((ext_vector_type(4)));
typedef float f32x2 __attribute__((ext_vector_type(2)));
typedef unsigned u32x4 __attribute__((ext_vector_type(4)));
typedef unsigned u32x2 __attribute__((ext_vector_type(2)));
typedef short bf16x8 __attribute__((ext_vector_type(8)));

constexpr int DM = 1024, NB = 8, SEQ = 8192, CTX = 256;
constexpr int NL = NB * SEQ, NC = NB * CTX, NR = NL + NC;
constexpr int TKV = SEQ + CTX;
constexpr int NE = 16, FFE = 1024, CAPL = 1024, CAPC = 32;
constexpr int ROWS_E = NB * CAPL + NB * CAPC;
constexpr int MT_E = ROWS_E / 256;
constexpr float DN_ALPHA = 1.4142135623730951f;
constexpr float LAM_INIT = 0.35550906759f;
constexpr int NWAVES = 8, NTHR = 512;
constexpr float QSCALE_MLA = 0.10206207261596575f * 1.4426950408889634f;
constexpr float QSCALE_DIFF = 0.125f * 1.4426950408889634f;

constexpr size_t MiB = 1u << 20;
constexpr size_t WS_CTL = 0, CTL_ZERO_BYTES = 1 * MiB;
constexpr size_t WS_MOD = 1 * MiB;
constexpr size_t WS_ROPE16 = 2 * MiB;
constexpr size_t WS_ROPE32 = 3 * MiB;
constexpr size_t WS_RQ = 5 * MiB;
constexpr size_t WS_RKV = 5 * MiB + 512 * 1024;
constexpr size_t WS_AFF = 6 * MiB;
constexpr size_t WS_AFFC = 10 * MiB;
constexpr size_t WS_ROWIDX = 11 * MiB;
constexpr size_t WS_ROWGATE = 12 * MiB;
constexpr size_t WS_SLOTROW = 13 * MiB;
constexpr size_t WS_XC = 18 * MiB;
constexpr size_t WS_GWS = 26 * MiB;
constexpr size_t WS_SW = 27 * MiB;
constexpr size_t WS_SX = 28 * MiB;
constexpr size_t WS_WIN0 = 32 * MiB;
constexpr size_t WS_WUQ = 35 * MiB;
constexpr size_t WS_WUKV = 35 * MiB + 512 * 1024;
constexpr size_t WS_WOUT0 = 36 * MiB;
constexpr size_t WS_WGU0 = 38 * MiB;
constexpr size_t WS_WDN0 = 102 * MiB;
constexpr size_t WS_WIN1 = 134 * MiB;
constexpr size_t WS_WOUT1 = 140 * MiB;
constexpr size_t WS_WGU1 = 142 * MiB;
constexpr size_t WS_WDN1 = 206 * MiB;
constexpr size_t WS_R1 = 240 * MiB, WS_R2 = 520 * MiB, WS_R3 = 800 * MiB;
constexpr size_t WS_H = WS_R3;
constexpr size_t WS_CQ = WS_R3 + 132 * MiB;
constexpr size_t WS_CKV = WS_R3 + 165 * MiB;
constexpr size_t WS_UV = WS_R1;
constexpr size_t WS_QL = WS_R2;
constexpr size_t WS_KR = WS_R2;
constexpr size_t WS_QC = WS_R2 + 96 * MiB;
constexpr size_t WS_K0 = WS_R2 + 99 * MiB;
constexpr size_t WS_V0 = WS_R2 + 198 * MiB;
constexpr size_t WS_HID = WS_R1;
constexpr size_t WS_XS = WS_R2;
constexpr size_t WS_Y = WS_R2;
constexpr size_t WS_Q1 = WS_R1;
constexpr size_t WS_K1 = WS_R1 + 128 * MiB;
constexpr size_t WS_V1 = WS_R1 + 260 * MiB;
constexpr size_t WS_O1 = WS_R1 + 392 * MiB;
constexpr size_t WS_WGU8_0 = WS_R3 + 182 * MiB;
constexpr size_t WS_WGU8_1 = WS_WGU0;
constexpr size_t WS_WDN8_0 = WS_WGU0 + 32 * MiB, WS_WDN8_1 = WS_WGU0 + 48 * MiB;
constexpr float HID_SCALE = 8.f;
constexpr size_t WS_T16_0 = WS_R2, WS_T16_1 = WS_R1;
constexpr size_t WS_X1 = WS_R1 + 140 * MiB;
constexpr size_t WS_END = 1024 * MiB;
static_assert(WS_CKV + (size_t)NR * 128 * 2 <= WS_END, "ws map");
static_assert(WS_V0 + (size_t)NB * 8 * TKV * 64 * 2 <= WS_R3, "ws map");
static_assert(WS_O1 + (size_t)NL * 1024 * 2 <= WS_R3, "ws map");
static_assert(WS_XS + (size_t)NE * ROWS_E * 1024 * 2 <= WS_R3 && WS_HID + (size_t)NE * ROWS_E * 1024 * 2 <= WS_R2, "ws map");
static_assert(WS_WDN1 + 32 * MiB <= WS_R1 && WS_SLOTROW + (size_t)NR * 16 * 4 <= WS_XC && WS_XC + (size_t)NC * 1024 * 4 <= WS_GWS, "ws map");

constexpr int CW_BAR = 4096;
constexpr int CW_KCH0 = 65536;
constexpr int CW_KCHR = 65536 + 1024;
constexpr int CW_KCH1 = 65536 + 2048;
constexpr int RING_BYTES = 151552, LDSCTL_OFF = RING_BYTES, MISC_OFF = LDSCTL_OFF + 320, LDS_BYTES = 155648;
constexpr int GTBL_OFF = 131072;

struct Params {
    const float* in[41];
    float* out; unsigned char* ws;
    int ph_lo, ph_hi;
};
enum { I_X = 0, I_C, I_CTX, I_CCTX, I_WMOD0, I_BMOD0, I_WIN0, I_GLNG, I_GLNB, I_GWS, I_GBS, I_QNORM, I_WUQ, I_KVNORM, I_WUKV, I_WOUT0,
       I_LNMG0, I_LNMB0, I_ROUTER0, I_WGATE0, I_WUP0, I_WDOWN0, I_LNFG0, I_LNFB0,
       I_WMOD1, I_BMOD1, I_WIN1, I_LQ1, I_LK1, I_LQ2, I_LK2, I_SUBLN, I_WOUT1, I_LNMG1, I_LNMB1, I_ROUTER1, I_WGATE1, I_WUP1, I_WDOWN1, I_LNFG1, I_LNFB1 };

DI unsigned cvt_pk(float lo, float hi) { unsigned r; asm volatile("v_cvt_pk_bf16_f32 %0, %1, %2" : "=v"(r) : "v"(lo), "v"(hi)); return r; }
DI float bf_lo(unsigned u) { return __uint_as_float(u << 16); }
DI float bf_hi(unsigned u) { return __uint_as_float(u & 0xffff0000u); }
DI u32x4 pack8(f32x4 a, f32x4 b) { u32x4 w; w.x = cvt_pk(a[0], a[1]); w.y = cvt_pk(a[2], a[3]); w.z = cvt_pk(b[0], b[1]); w.w = cvt_pk(b[2], b[3]); return w; }
DI u32x2 pack8_fp8(f32x4 a, f32x4 b) { u32x2 w; const int t0 = __builtin_amdgcn_cvt_pk_fp8_f32(a[0], a[1], 0, false); w.x = (unsigned)__builtin_amdgcn_cvt_pk_fp8_f32(a[2], a[3], t0, true);
    const int t1 = __builtin_amdgcn_cvt_pk_fp8_f32(b[0], b[1], 0, false); w.y = (unsigned)__builtin_amdgcn_cvt_pk_fp8_f32(b[2], b[3], t1, true); return w; }
#define ST8(base, off, val) (*(u32x2*)((char*)(base) + (unsigned)(off)) = (val))
DI float wave_sum(float v) {
#pragma unroll
    for (int o = 1; o < 64; o <<= 1) v += __shfl_xor(v, o);
    return v;
}
DI float wave_max(float v) {
#pragma unroll
    for (int o = 1; o < 64; o <<= 1) v = fmaxf(v, __shfl_xor(v, o));
    return v;
}
#define LDS_WAIT() asm volatile("s_waitcnt lgkmcnt(0)" ::: "memory")
#define VM_WAIT() asm volatile("s_waitcnt vmcnt(0)" ::: "memory")

DI float max16_dpp(float v) {
    int x = __float_as_int(v);
    v = fmaxf(v, __int_as_float(__builtin_amdgcn_update_dpp(x, x, 0xB1, 0xf, 0xf, false))); x = __float_as_int(v);
    v = fmaxf(v, __int_as_float(__builtin_amdgcn_update_dpp(x, x, 0x4E, 0xf, 0xf, false))); x = __float_as_int(v);
    v = fmaxf(v, __int_as_float(__builtin_amdgcn_update_dpp(x, x, 0x141, 0xf, 0xf, false))); x = __float_as_int(v);
    v = fmaxf(v, __int_as_float(__builtin_amdgcn_update_dpp(x, x, 0x140, 0xf, 0xf, false)));
    return v;
}
DI void row_info(int row, int& b, int& tpos, int& t_rope) {
    if (row < NL) { b = row >> 13; tpos = row & (SEQ - 1); t_rope = tpos; }
    else { const int j = row - NL; b = j >> 8; tpos = SEQ + (j & (CTX - 1)); t_rope = -1; }
}
DI void rope8(f32x4& v0, f32x4& v1, const f32x2* cs) {
    const f32x2 c0 = cs[0], c1 = cs[1], c2 = cs[2], c3 = cs[3];
    float a, b;
    a = v0[0]; b = v0[1]; v0[0] = a * c0.x - b * c0.y; v0[1] = a * c0.y + b * c0.x;
    a = v0[2]; b = v0[3]; v0[2] = a * c1.x - b * c1.y; v0[3] = a * c1.y + b * c1.x;
    a = v1[0]; b = v1[1]; v1[0] = a * c2.x - b * c2.y; v1[1] = a * c2.y + b * c2.x;
    a = v1[2]; b = v1[3]; v1[2] = a * c3.x - b * c3.y; v1[3] = a * c3.y + b * c3.x;
}

DI unsigned vt_pos(unsigned t) { return (t & ~15u) | (t & 3u) | (((t >> 3) & 1u) << 2) | (((t >> 2) & 1u) << 3); }
DI void st_vt8(unsigned char* ws, unsigned off0  , f32x4 v0, f32x4 v1) {
    const unsigned w0 = cvt_pk(v0[0], v0[1]), w1 = cvt_pk(v0[2], v0[3]), w2 = cvt_pk(v1[0], v1[1]), w3 = cvt_pk(v1[2], v1[3]);
    constexpr unsigned RS = (unsigned)TKV * 2u;
    unsigned char* q = ws + off0;
    *(bf16*)q = (bf16)(w0 & 0xffffu); q += RS; *(bf16*)q = (bf16)(w0 >> 16); q += RS; __builtin_amdgcn_sched_barrier(0);
    *(bf16*)q = (bf16)(w1 & 0xffffu); q += RS; *(bf16*)q = (bf16)(w1 >> 16); q += RS; __builtin_amdgcn_sched_barrier(0);
    *(bf16*)q = (bf16)(w2 & 0xffffu); q += RS; *(bf16*)q = (bf16)(w2 >> 16); q += RS; __builtin_amdgcn_sched_barrier(0);
    *(bf16*)q = (bf16)(w3 & 0xffffu); q += RS; *(bf16*)q = (bf16)(w3 >> 16); __builtin_amdgcn_sched_barrier(0);
}

using pg8::Unit;
#define EPI_ARGS const f32x4 (&acc)[2][2][4][2], const Unit& u, int wr, int wc, int fr, int fq
#define EPI_FOR_ROWS _Pragma("unroll") for (int ai = 0; ai < 2; ++ai) _Pragma("unroll") for (int m = 0; m < 4; ++m)
#define EPI_ROW (u.pm * 256 + ai * 128 + wr * 64 + m * 16 + fr)
#define EPI_FOR_COLS _Pragma("unroll") for (int bj = 0; bj < 2; ++bj)
#define EPI_LCOL (bj * 128 + wc * 32 + 8 * fq)

DI f32x4 gelu4(f32x4 v) { f32x2 a = pg8::gelu_pk((f32x2){v[0], v[1]}), b = pg8::gelu_pk((f32x2){v[2], v[3]}); return (f32x4){a.x, a.y, b.x, b.y}; }

#define ST16(base, off, val) (*(u32x4*)((char*)(base) + (unsigned)(off)) = (val))
#define EPI_ROW_END __builtin_amdgcn_sched_barrier(0)
struct EpiA0 {
    static constexpr bool PERM = true, AFTER_DRAIN = false;
    unsigned char* ws;
    DI void operator()(EPI_ARGS) const {
        const int pn = u.pn;
        EPI_FOR_ROWS { const unsigned row = (unsigned)EPI_ROW;
            EPI_FOR_COLS { const unsigned lcol = (unsigned)EPI_LCOL; f32x4 v0 = acc[ai][bj][m][0], v1 = acc[ai][bj][m][1];
                if (pn < 4) { v0 = gelu4(v0); v1 = gelu4(v1); ST16(ws, (unsigned)WS_UV + (row * 1024u + (unsigned)pn * 256u + lcol) * 2u, pack8(v0, v1)); }
                else if (pn == 4) { ST16(ws, (unsigned)WS_CQ + (row * 256u + lcol) * 2u, pack8(v0, v1)); }
                else if (lcol < 128u) { ST16(ws, (unsigned)WS_CKV + (row * 128u + lcol) * 2u, pack8(v0, v1)); }
                else if (lcol < 160u) { ST16(ws, (unsigned)WS_KR + (row * 32u + (lcol - 128u)) * 2u, pack8(v0, v1)); }
            } EPI_ROW_END; }
    }
};
struct EpiQ {
    static constexpr bool PERM = true, AFTER_DRAIN = false;
    unsigned char* ws; const float* rq; const f32x2* rope16;
    DI void operator()(EPI_ARGS) const {
        EPI_FOR_ROWS { const int row = EPI_ROW; const float r = rq[row] * (QSCALE_MLA * 4.f); int b, tpos, tr; row_info(row, b, tpos, tr);
            const bool lat = tr >= 0; unsigned char* base = ws;
            const unsigned rowoff = lat ? (unsigned)WS_QL + (unsigned)(b * 8 * SEQ + tpos) * 128u : (unsigned)WS_QC + (unsigned)(b * 8 * CTX + (tpos - SEQ)) * 128u;
            const unsigned hstride = lat ? (unsigned)(SEQ * 128) : (unsigned)(CTX * 128);
            EPI_FOR_COLS { const unsigned col = (unsigned)(u.pn * 256 + EPI_LCOL); f32x4 v0 = acc[ai][bj][m][0] * r, v1 = acc[ai][bj][m][1] * r;
                const unsigned h = (col * 683u) >> 16;
                const unsigned d = col - h * 96u;
                if (d >= 64u && lat) rope8(v0, v1, (const f32x2*)((const char*)rope16 + (unsigned)(tr * 16 + (int)((d - 64u) >> 1)) * 8u));
                ST8(base, rowoff + h * hstride + d, pack8_fp8(v0, v1));
                if (d == 88u) { const u32x4 z = {0u, 0u, 0u, 0u}; ST16(base, rowoff + h * hstride + 96u, z); ST16(base, rowoff + h * hstride + 112u, z); }
            } EPI_ROW_END; }
    }
};
DI unsigned vt_pos8(unsigned t) { const unsigned k = t & 63u, kk = k & 31u; return (t & ~63u) | (((kk >> 2) & 1u) << 5) | ((k >> 5) << 4) | (kk & 3u) | ((kk >> 3) << 2); }
DI void st_vt8f(unsigned char* ws, unsigned off0  , f32x4 v0, f32x4 v1) {
    const unsigned w0 = (unsigned)__builtin_amdgcn_cvt_pk_fp8_f32(v0[0] * 16.f, v0[1] * 16.f, 0, false), w1 = (unsigned)__builtin_amdgcn_cvt_pk_fp8_f32(v0[2] * 16.f, v0[3] * 16.f, 0, false);
    const unsigned w2 = (unsigned)__builtin_amdgcn_cvt_pk_fp8_f32(v1[0] * 16.f, v1[1] * 16.f, 0, false), w3 = (unsigned)__builtin_amdgcn_cvt_pk_fp8_f32(v1[2] * 16.f, v1[3] * 16.f, 0, false);
    constexpr unsigned RS = (unsigned)TKV;
    unsigned char* q = ws + off0;
    *q = (unsigned char)(w0 & 0xffu); q += RS; *q = (unsigned char)((w0 >> 8) & 0xffu); q += RS; __builtin_amdgcn_sched_barrier(0);
    *q = (unsigned char)(w1 & 0xffu); q += RS; *q = (unsigned char)((w1 >> 8) & 0xffu); q += RS; __builtin_amdgcn_sched_barrier(0);
    *q = (unsigned char)(w2 & 0xffu); q += RS; *q = (unsigned char)((w2 >> 8) & 0xffu); q += RS; __builtin_amdgcn_sched_barrier(0);
    *q = (unsigned char)(w3 & 0xffu); q += RS; *q = (unsigned char)((w3 >> 8) & 0xffu); __builtin_amdgcn_sched_barrier(0);
}
struct EpiKV {
    static constexpr bool PERM = true, AFTER_DRAIN = false;
    unsigned char* ws; const float* rkv; unsigned* kch;
    DI void operator()(EPI_ARGS) const {
        float kmx[2] = {0.f, 0.f};
        EPI_FOR_ROWS { const int row = EPI_ROW; const float r = rkv[row]; int b, tpos, tr; row_info(row, b, tpos, tr);
            const unsigned tok = (unsigned)(b * 8 * TKV + tpos);
            EPI_FOR_COLS { const unsigned col = (unsigned)(u.pn * 256 + EPI_LCOL); const f32x4 v0 = acc[ai][bj][m][0] * r, v1 = acc[ai][bj][m][1] * r;
                const unsigned h = col >> 7, d = col & 127u; const unsigned th = tok + h * (unsigned)TKV;
                if (d < 64u) ST8(ws, (unsigned)WS_K0 + (th * 128u + d), pack8_fp8(v0 * 0.25f, v1 * 0.25f));
                else st_vt8f(ws, (unsigned)WS_V0 + ((((unsigned)b * 8u + h) * 64u + (d - 64u)) * (unsigned)TKV + vt_pos8((unsigned)tpos)), v0, v1);
                kmx[bj] = fmaxf(kmx[bj], (v0[0] * v0[0] + v0[1] * v0[1]) + (v0[2] * v0[2] + v0[3] * v0[3]) + (v1[0] * v1[0] + v1[1] * v1[1]) + (v1[2] * v1[2] + v1[3] * v1[3]));
            } EPI_ROW_END; }
        const int row0 = u.pm * 256; const int b = row0 < NL ? (row0 >> 13) : ((row0 - NL) >> 8);
#pragma unroll
        for (int bj = 0; bj < 2; ++bj) { const unsigned col = (unsigned)(u.pn * 256 + bj * 128 + wc * 32 + 8 * fq); const unsigned h = col >> 7, d = col & 127u;
            const float mx = max16_dpp(kmx[bj]);
            if (d < 64u && fr == 0) atomicMax(kch + (b * 8 + h) * 8 + (d >> 3), __float_as_uint(mx)); }
    }
};
struct EpiOut {
    static constexpr bool PERM = true, AFTER_DRAIN = false;
    const float* xl; const float* xc; bf16* T16; const float* gmod;
    DI void operator()(EPI_ARGS) const {
        EPI_FOR_ROWS { const int row = EPI_ROW; const bool lat = row < NL; const int b = lat ? (row >> 13) : 8;
            const char* xs = (const char*)(lat ? xl : xc); const unsigned roff = (unsigned)(lat ? row : row - NL) * 4096u;
            EPI_FOR_COLS { const unsigned col = (unsigned)(u.pn * 256 + EPI_LCOL); const f32x4 v0 = acc[ai][bj][m][0], v1 = acc[ai][bj][m][1];
                const f32x4 x0 = *(const f32x4*)(xs + (roff + col * 4u)), x1 = *(const f32x4*)(xs + (roff + col * 4u + 16u));
                const f32x4 g0 = *(const f32x4*)((const char*)gmod + ((unsigned)b * 6144u + col) * 4u), g1 = *(const f32x4*)((const char*)gmod + ((unsigned)b * 6144u + col) * 4u + 16u);
                ST16(T16, ((unsigned)row * 1024u + col) * 2u, pack8(x0 * DN_ALPHA + (g0 + 1.f) * v0, x1 * DN_ALPHA + (g1 + 1.f) * v1));
            } EPI_ROW_END; }
    }
};
struct EpiMoe1 {
    static constexpr bool PERM = true, AFTER_DRAIN = false;
    bf16* HID; int nN;
    DI void operator()(EPI_ARGS) const {
        const int e = u.pm / MT_E, pnl = u.pn - e * nN;
        EPI_FOR_ROWS { const unsigned row = (unsigned)EPI_ROW;
            EPI_FOR_COLS { const unsigned col = (unsigned)(pnl * 256 + EPI_LCOL); const f32x4 g = acc[ai][bj][m][0], up = acc[ai][bj][m][1];
                f32x4 h;
#pragma unroll
                for (int i = 0; i < 4; ++i) h[i] = g[i] / (1.f + __expf(-g[i])) * up[i];
                u32x2 w; w.x = cvt_pk(h[0], h[1]); w.y = cvt_pk(h[2], h[3]);
                *(u32x2*)((char*)HID + (row * 2048u + col)) = w;
            } EPI_ROW_END; }
    }
};
struct EpiMoe1F8 {
    static constexpr bool PERM = true, AFTER_DRAIN = false;
    unsigned char* HID8; const float* sx; const int* rowidx; const float* sw; int nN;
    DI void operator()(EPI_ARGS) const {
        const int e = u.pm / MT_E, pnl = u.pn - e * nN;
        f32x4 sg[2], su[2];
#pragma unroll
        for (int bj = 0; bj < 2; ++bj) { const float* s = sw + (size_t)u.pn * 256 + bj * 128 + wc * 32 + 8 * fq; sg[bj] = *(const f32x4*)s; su[bj] = *(const f32x4*)(s + 4); }
        EPI_FOR_ROWS { const unsigned row = (unsigned)EPI_ROW; const float rs = sx[rowidx[row]];
            EPI_FOR_COLS { const unsigned col = (unsigned)(pnl * 256 + EPI_LCOL); const f32x4 g = acc[ai][bj][m][0] * sg[bj] * rs, up = acc[ai][bj][m][1] * su[bj] * rs;
                f32x4 h;
#pragma unroll
                for (int i = 0; i < 4; ++i) h[i] = fminf(fmaxf(g[i] / (1.f + __expf(-g[i])) * up[i] * HID_SCALE, -448.f), 448.f);
                int w = __builtin_amdgcn_cvt_pk_fp8_f32(h[0], h[1], 0, false); w = __builtin_amdgcn_cvt_pk_fp8_f32(h[2], h[3], w, true);
                *(unsigned*)(HID8 + (row * 1024u + (col >> 1))) = (unsigned)w;
            } EPI_ROW_END; }
    }
};
struct EpiMoe2F8 {
    static constexpr bool PERM = true, AFTER_DRAIN = false;
    bf16* Y; const float* gate; const float* swd; int nN;
    DI void operator()(EPI_ARGS) const {
        const int e = u.pm / MT_E, pnl = u.pn - e * nN;
        f32x4 s0[2], s1[2];
#pragma unroll
        for (int bj = 0; bj < 2; ++bj) { const float* s = swd + (size_t)u.pn * 256 + bj * 128 + wc * 32 + 8 * fq; s0[bj] = *(const f32x4*)s * (1.f / HID_SCALE); s1[bj] = *(const f32x4*)(s + 4) * (1.f / HID_SCALE); }
        EPI_FOR_ROWS { const unsigned row = (unsigned)EPI_ROW; const float g = gate[row];
            EPI_FOR_COLS { const unsigned col = (unsigned)(pnl * 256 + EPI_LCOL);
                ST16(Y, (row * 1024u + col) * 2u, pack8(acc[ai][bj][m][0] * s0[bj] * g, acc[ai][bj][m][1] * s1[bj] * g));
            } EPI_ROW_END; }
    }
};
struct EpiMoe2 {
    static constexpr bool PERM = true, AFTER_DRAIN = false;
    bf16* Y; const float* gate; int nN;
    DI void operator()(EPI_ARGS) const {
        const int e = u.pm / MT_E, pnl = u.pn - e * nN;
        EPI_FOR_ROWS { const unsigned row = (unsigned)EPI_ROW; const float g = gate[row];
            EPI_FOR_COLS { const unsigned col = (unsigned)(pnl * 256 + EPI_LCOL);
                ST16(Y, (row * 1024u + col) * 2u, pack8(acc[ai][bj][m][0] * g, acc[ai][bj][m][1] * g));
            } EPI_ROW_END; }
    }
};
struct EpiA1 {
    static constexpr bool PERM = true, AFTER_DRAIN = false;
    unsigned char* ws; const f32x2* rope32; int row_off, col_off; unsigned* kch;
    DI void operator()(EPI_ARGS) const {
        const unsigned colt = (unsigned)(col_off + u.pn * 256); const unsigned s = colt >> 10;
        float kmx[2] = {0.f, 0.f};
        EPI_FOR_ROWS { const int row = row_off + EPI_ROW; int b, tpos, tr; row_info(row, b, tpos, tr);
            const unsigned tq = (unsigned)(b * 16 * SEQ + tpos), tk = (unsigned)(b * 16 * TKV + tpos);
            EPI_FOR_COLS { const unsigned sc = (colt & 1023u) + (unsigned)EPI_LCOL; f32x4 v0 = acc[ai][bj][m][0], v1 = acc[ai][bj][m][1];
                const unsigned hh = sc >> 6, d = sc & 63u;
                if (tr >= 0) rope8(v0, v1, (const f32x2*)((const char*)rope32 + (unsigned)(tr * 32 + (int)(d >> 1)) * 8u));
                if (s == 0) { v0 = v0 * (QSCALE_DIFF * 4.f); v1 = v1 * (QSCALE_DIFF * 4.f); }
                else { kmx[bj] = fmaxf(kmx[bj], (v0[0] * v0[0] + v0[1] * v0[1]) + (v0[2] * v0[2] + v0[3] * v0[3]) + (v1[0] * v1[0] + v1[1] * v1[1]) + (v1[2] * v1[2] + v1[3] * v1[3])); v0 = v0 * 0.25f; v1 = v1 * 0.25f; }
                const unsigned off = (s == 0) ? (unsigned)WS_Q1 + ((tq + hh * (unsigned)SEQ) * 64u + d) : (unsigned)WS_K1 + ((tk + hh * (unsigned)TKV) * 64u + d);
                { u32x2 w; int t0 = __builtin_amdgcn_cvt_pk_fp8_f32(v0[0], v0[1], 0, false); w.x = (unsigned)__builtin_amdgcn_cvt_pk_fp8_f32(v0[2], v0[3], t0, true);
                  int t1 = __builtin_amdgcn_cvt_pk_fp8_f32(v1[0], v1[1], 0, false); w.y = (unsigned)__builtin_amdgcn_cvt_pk_fp8_f32(v1[2], v1[3], t1, true);
                  *(u32x2*)((char*)ws + off) = w; }
            } EPI_ROW_END; }
        if (s == 1) { const int row0 = row_off + u.pm * 256; const int b = row0 < NL ? (row0 >> 13) : ((row0 - NL) >> 8);
#pragma unroll
            for (int bj = 0; bj < 2; ++bj) { const unsigned sc = (colt & 1023u) + (unsigned)(bj * 128 + wc * 32 + 8 * fq);
                const float mx = max16_dpp(kmx[bj]);
                if (fr == 0) atomicMax(kch + (b * 16 + (sc >> 6)) * 8 + ((sc & 63u) >> 3), __float_as_uint(mx)); } }
    }
};
struct EpiV1T {
    static constexpr bool PERM = true, AFTER_DRAIN = false;
    unsigned char* ws; int row_off;
    DI void operator()(EPI_ARGS) const {
        EPI_FOR_ROWS { const int row = row_off + EPI_ROW; int b, tpos, tr; row_info(row, b, tpos, tr);
            const unsigned rowpart = (unsigned)WS_V1 + ((unsigned)b * 8u * 128u * (unsigned)TKV + vt_pos8((unsigned)tpos));
            EPI_FOR_COLS { const unsigned sc = (unsigned)(u.pn * 256 + EPI_LCOL);
                st_vt8f(ws, rowpart + sc * (unsigned)TKV, acc[ai][bj][m][0], acc[ai][bj][m][1]);
            } EPI_ROW_END; }
    }
};

struct GroupedOrder {
    int MT, nN, c, G;
    DI bool next(int i, Unit& u) const {
        const int x = c & 7, j = c >> 3, per = G >> 3, q = i * per + j, per_e = MT * nN;
        if (q >= 2 * per_e) return false;
        const int el = q / per_e, rem = q - el * per_e, e = 2 * x + el;
        const int nig = 8 * nN, gid = rem / nig, fm = gid * 8, gsz = (MT - fm) < 8 ? (MT - fm) : 8, w = rem - gid * nig;
        u.pm = e * MT_E + fm + (w % gsz); u.pn = e * nN + (w / gsz); return true;
    }
    DI void a_ready(const Unit&) const {}
    DI void done(const Unit&) const {}
};
#define XB_TMO      128
#define XB_XCNT(j)  (256  + 64 * (j))
#define XB_XSUB(j)  (1280 + 64 * (j))
#define XB_XGEN(j)  (2304 + 64 * (j))
#define XB_TOP      3328
#define XB_TOPGEN   3392
#define XCD_BAR_WORDS 3456
#define XB_SPIN_CAP (1u << 18)

__device__ __forceinline__ unsigned xb_ld(unsigned* p)              { return __hip_atomic_load(p, __ATOMIC_RELAXED, __HIP_MEMORY_SCOPE_AGENT); }
__device__ __forceinline__ unsigned xb_add(unsigned* p, unsigned v) { return __hip_atomic_fetch_add(p, v, __ATOMIC_RELAXED, __HIP_MEMORY_SCOPE_AGENT); }
__device__ __forceinline__ unsigned xb_xcc_id() { return (unsigned)__builtin_amdgcn_s_getreg((3 << 11) | 20) & 0xFu; }
#define XB_SPIN(cond, bar) do { unsigned _sp = 0; while (cond) { __builtin_amdgcn_s_sleep(1); \
    if ((++_sp & 255u) == 0u) { if (xb_ld(&(bar)[XB_TMO])) break; if (_sp > XB_SPIN_CAP) { atomicAdd(&(bar)[XB_TMO], 1u); break; } } } } while (0)

struct XcdBarrier {
    unsigned* bar; unsigned x;
    volatile LAS unsigned* st;
};

__device__ __forceinline__ bool xb_thread0(const int wid) { unsigned ln = __builtin_amdgcn_mbcnt_hi(~0u, __builtin_amdgcn_mbcnt_lo(~0u, 0u)); asm volatile("" : "+v"(ln)); return wid == 0 && ln == 0u; }
__device__ __forceinline__ XcdBarrier xcd_barrier_post(unsigned* bar, volatile LAS unsigned* st, const int wid) {
    XcdBarrier b; b.bar = bar; b.x = xb_xcc_id(); b.st = st;
    if (xb_thread0(wid)) (void)xb_add(&bar[XB_XCNT(b.x)], 1u);
    return b;
}
__device__ __forceinline__ void xcd_barrier_complete(unsigned* bar, unsigned x, unsigned& nloc, unsigned& nx) {
    const unsigned G = gridDim.x * gridDim.y * gridDim.z;
    unsigned sum, cnt, mine, sp = 0u;
    for (;;) {
        sum = 0u; cnt = 0u; mine = 0u;
#pragma unroll
        for (unsigned j = 0; j < 16; ++j) { const unsigned c = xb_ld(&bar[XB_XCNT(j)]); sum += c; cnt += (c > 0u) ? 1u : 0u; mine = (j == x) ? c : mine; }
        if (sum == G) break;
        __builtin_amdgcn_s_sleep(1);
        if ((++sp & 255u) == 0u) { if (xb_ld(&bar[XB_TMO])) break; if (sp > XB_SPIN_CAP) { atomicAdd(&bar[XB_TMO], 1u); break; } }
    }
    nloc = mine > 0u ? mine : 1u; nx = cnt > 0u ? cnt : 1u;
}

__device__ __forceinline__ void xcd_barrier(const XcdBarrier& b, const int wid) {
    asm volatile("s_waitcnt vmcnt(0)" ::: "memory");
    __syncthreads();
    if (xb_thread0(wid)) {
        unsigned* bar = b.bar;
        __builtin_amdgcn_s_waitcnt(0);
        unsigned nloc = b.st[0], nx = b.st[1];
        if (nloc == 0u) { xcd_barrier_complete(bar, b.x, nloc, nx); b.st[0] = nloc; b.st[1] = nx; }
        const unsigned old = xb_add(&bar[XB_XSUB(b.x)], 1u);
        const unsigned gen = old / nloc;
        if (old + 1u == (gen + 1u) * nloc) {
            __builtin_amdgcn_fence(__ATOMIC_RELEASE, "agent");
            asm volatile("s_waitcnt vmcnt(0)" ::: "memory");
            const unsigned og = xb_add(&bar[XB_TOP], 1u);
            const unsigned tg = og / nx;
            if (og + 1u == (tg + 1u) * nx) xb_add(&bar[XB_TOPGEN], 1u);
            else XB_SPIN(xb_ld(&bar[XB_TOPGEN]) == tg, bar);
            __builtin_amdgcn_fence(__ATOMIC_ACQUIRE, "agent");
            xb_add(&bar[XB_XGEN(b.x)], 1u);
            asm volatile("s_waitcnt vmcnt(0)" ::: "memory");
        } else {
            XB_SPIN(xb_ld(&bar[XB_XGEN(b.x)]) == gen, bar);
            __builtin_amdgcn_fence(__ATOMIC_ACQUIRE, "agent");
            asm volatile("s_waitcnt vmcnt(0)" ::: "memory");
        }
    }
    __syncthreads();
}
__device__ const float INVF8[8] = {1.000000000e+00f, 3.162277639e-01f, 1.000000015e-01f, 3.162277490e-02f, 9.999999776e-03f, 3.162277630e-03f, 1.000000047e-03f, 3.162277571e-04f};
__device__ const float INVF16[16] = {1.000000000e+00f, 5.623413324e-01f, 3.162277639e-01f, 1.778279394e-01f, 1.000000015e-01f, 5.623413250e-02f, 3.162277490e-02f, 1.778279431e-02f,
                                     9.999999776e-03f, 5.623413250e-03f, 3.162277630e-03f, 1.778279431e-03f, 1.000000047e-03f, 5.623413017e-04f, 3.162277571e-04f, 1.778279402e-04f};
struct Ctx {
    unsigned char* lds; int tid, lane, wave, bid, G, gw, NGW;
};
DI Ctx make_ctx(unsigned char* lds, const int wid) {
    Ctx c; c.lds = lds; int ln = (int)__builtin_amdgcn_mbcnt_hi(~0u, __builtin_amdgcn_mbcnt_lo(~0u, 0u)); asm volatile("" : "+v"(ln)); c.lane = ln; c.wave = wid; c.tid = wid * 64 + c.lane;
    c.bid = blockIdx.x; c.G = gridDim.x; c.gw = c.bid * NWAVES + c.wave; c.NGW = c.G * NWAVES; return c;
}

DI unsigned pk4_fp8(float a, float b, float c, float d) { int w = __builtin_amdgcn_cvt_pk_fp8_f32(a, b, 0, false); w = __builtin_amdgcn_cvt_pk_fp8_f32(c, d, w, true); return (unsigned)w; }
DI void moe_quant_item(const Ctx& c, const float* W, int n0, int mode, int which, unsigned char* W8e, float* SWe) {
    LAS float* tile = (LAS float*)((LAS unsigned char*)c.lds);
    LAS float* red = tile + 1024 * 33;
    const int col = c.lane & 31, half = c.lane >> 5;
    float mx = 0.f;
    const float* src = W + (size_t)(c.wave * 128 + half) * 1024 + n0 + col;
    LAS float* dst = tile + (c.wave * 128 + half) * 33 + col;
#pragma unroll 8
    for (int i = 0; i < 64; ++i) { const float v = src[(size_t)i * 2048]; mx = fmaxf(mx, fabsf(v)); dst[i * 66] = v; }
    red[(c.wave * 2 + half) * 32 + col] = mx;
    __syncthreads();
    const int cc = c.lane & 7;
#pragma unroll
    for (int j = 0; j < 4; ++j) { const int n = (c.lane >> 3) + 8 * j;
        float am = 0.f;
#pragma unroll
        for (int q = 0; q < 16; ++q) am = fmaxf(am, red[q * 32 + n]);
        const float sc = am > 0.f ? am * (1.f / 448.f) : 1.f, inv = 1.f / sc;
        const LAS float* s = tile + (c.wave * 128 + 16 * cc) * 33 + n;
        u32x4 o;
        o.x = pk4_fp8(s[0 * 33] * inv, s[1 * 33] * inv, s[2 * 33] * inv, s[3 * 33] * inv); o.y = pk4_fp8(s[4 * 33] * inv, s[5 * 33] * inv, s[6 * 33] * inv, s[7 * 33] * inv);
        o.z = pk4_fp8(s[8 * 33] * inv, s[9 * 33] * inv, s[10 * 33] * inv, s[11 * 33] * inv); o.w = pk4_fp8(s[12 * 33] * inv, s[13 * 33] * inv, s[14 * 33] * inv, s[15 * 33] * inv);
        const int nn = n0 + n; const int drow = mode ? (((nn >> 2) << 3) + which * 4 + (nn & 3)) : nn;
        *(u32x4*)(W8e + (size_t)drow * 1024 + c.wave * 128 + 16 * cc) = o;
        if (c.wave == 0 && cc == 0) SWe[drow] = sc; }
    __syncthreads();
}
template <int MODE>
DI void transpose_item(const float* W, int K, int N, bf16* WT, LAS float* scr, int item, int lane, const float* kgain, int which) {
    const int nblk = N / 32, kb = item / nblk, nb = item - kb * nblk, k0 = 64 * kb, n0 = 32 * nb;
#pragma unroll 8
    for (int i = 0; i < 32; ++i) { const int kk = 2 * i + (lane >> 5); const float g = kgain ? kgain[k0 + kk] : 1.f; scr[kk * 33 + (lane & 31)] = W[(size_t)(k0 + kk) * N + n0 + (lane & 31)] * g; }
    LDS_WAIT(); asm volatile("" ::: "memory");
    const int c = lane & 7;
#pragma unroll
    for (int j = 0; j < 4; ++j) { const int n = (lane >> 3) + 8 * j; const LAS float* s = scr + (8 * c) * 33 + n;
        u32x4 o; o.x = cvt_pk(s[0 * 33], s[1 * 33]); o.y = cvt_pk(s[2 * 33], s[3 * 33]); o.z = cvt_pk(s[4 * 33], s[5 * 33]); o.w = cvt_pk(s[6 * 33], s[7 * 33]);
        const int nn = n0 + n; const int drow = MODE ? (((nn >> 2) << 3) + which * 4 + (nn & 3)) : nn;
        *(u32x4*)(WT + (size_t)drow * K + k0 + 8 * c) = o; }
    LDS_WAIT(); asm volatile("" ::: "memory");
}

DI void phase_prologue(const Params& p, const Ctx& c) {
    unsigned char* ws = p.ws;
    float* MOD = (float*)(ws + WS_MOD);
    for (int unit = c.bid; unit < 192; unit += c.G) {
        const int l = unit / 96, c0 = (unit % 96) * 64;
        float* sl = (float*)c.lds;
        for (int i = c.tid; i < 9 * 1024; i += NTHR) { const int bb = i >> 10, k = i & 1023; const float cv = bb < 8 ? p.in[I_C][bb * 1024 + k] : p.in[I_CCTX][k]; sl[i] = cv / (1.f + expf(-cv)); }
        __syncthreads();
        const float* W = p.in[l ? I_WMOD1 : I_WMOD0]; const float* bm = p.in[l ? I_BMOD1 : I_BMOD0];
        float a0 = 0, a1 = 0, a2 = 0, a3 = 0, a4 = 0, a5 = 0, a6 = 0, a7 = 0, a8 = 0;
        const int col = c0 + c.lane, ks = c.wave * 128;
        for (int k0 = ks; k0 < ks + 128; k0 += 16) { float wv[16];
#pragma unroll
            for (int u = 0; u < 16; ++u) wv[u] = W[(size_t)(k0 + u) * 6144 + col];
#pragma unroll
            for (int u = 0; u < 16; ++u) { const int k = k0 + u; const float w = wv[u];
                a0 += sl[k] * w; a1 += sl[1024 + k] * w; a2 += sl[2048 + k] * w; a3 += sl[3072 + k] * w; a4 += sl[4096 + k] * w;
                a5 += sl[5120 + k] * w; a6 += sl[6144 + k] * w; a7 += sl[7168 + k] * w; a8 += sl[8192 + k] * w; } }
        float* red = sl + 9 * 1024;
        float* rw = red + (c.wave * 9) * 64 + c.lane;
        rw[0] = a0; rw[64] = a1; rw[128] = a2; rw[192] = a3; rw[256] = a4; rw[320] = a5; rw[384] = a6; rw[448] = a7; rw[512] = a8;
        __syncthreads();
        for (int i = c.tid; i < 9 * 64; i += NTHR) { const int bb = i >> 6, cc = i & 63; float s = 0.f;
#pragma unroll
            for (int w = 0; w < 8; ++w) s += red[(w * 9 + bb) * 64 + cc];
            MOD[(size_t)(l * 9 + bb) * 6144 + c0 + cc] = s + bm[c0 + cc]; }
        __syncthreads();
    }
    LAS float* scr = (LAS float*)((LAS unsigned char*)c.lds + c.wave * 16384);
    constexpr int IT_IN0 = 16 * 45, IT_UQ = 4 * 24, IT_UKV = 2 * 32, IT_SQ = 16 * 32, IT_IN1 = 16 * 96;
    constexpr int NITEMS = IT_IN0 + IT_UQ + IT_UKV + IT_SQ + IT_IN1 + IT_SQ;
    for (int it = c.gw; it < NITEMS; it += c.NGW) {
        int r = it;
        if (r < IT_IN0) { transpose_item<0>(p.in[I_WIN0], 1024, 1440, (bf16*)(ws + WS_WIN0), scr, r, c.lane, nullptr, 0); continue; } r -= IT_IN0;
        if (r < IT_UQ) { transpose_item<0>(p.in[I_WUQ], 256, 768, (bf16*)(ws + WS_WUQ), scr, r, c.lane, p.in[I_QNORM], 0); continue; } r -= IT_UQ;
        if (r < IT_UKV) { transpose_item<0>(p.in[I_WUKV], 128, 1024, (bf16*)(ws + WS_WUKV), scr, r, c.lane, p.in[I_KVNORM], 0); continue; } r -= IT_UKV;
        if (r < IT_SQ) { transpose_item<0>(p.in[I_WOUT0], 1024, 1024, (bf16*)(ws + WS_WOUT0), scr, r, c.lane, nullptr, 0); continue; } r -= IT_SQ;
        if (r < IT_IN1) { transpose_item<0>(p.in[I_WIN1], 1024, 3072, (bf16*)(ws + WS_WIN1), scr, r, c.lane, nullptr, 0); continue; } r -= IT_IN1;
        if (r < IT_SQ) { transpose_item<0>(p.in[I_WOUT1], 1024, 1024, (bf16*)(ws + WS_WOUT1), scr, r, c.lane, nullptr, 0); continue; } r -= IT_SQ;
    }
    __syncthreads();
    { int first, cnt, stride;
      if (c.bid < 192) { first = c.bid; cnt = 11; stride = 192; } else { first = 2112 + (c.bid - 192); cnt = 14; stride = 64; }
      for (int k = 0; k <= cnt; ++k) {
        int r;
        if (k < cnt) r = first + k * stride; else if (c.bid < 64) r = 3008 + c.bid; else break;
        const int l = r / 1536, kind = (r / 512) % 3, e = (r >> 5) & 15, nb = r & 31;
        if (kind < 2) { const float* W = p.in[l ? (kind ? I_WUP1 : I_WGATE1) : (kind ? I_WUP0 : I_WGATE0)] + (size_t)e * 1024 * 1024;
            moe_quant_item(c, W, 32 * nb, 1, kind, ws + (l ? WS_WGU8_1 : WS_WGU8_0) + (size_t)e * 2048 * 1024, (float*)(ws + WS_SW) + (l ? NE * 2048 : 0) + e * 2048); }
        else { const float* W = p.in[l ? I_WDOWN1 : I_WDOWN0] + (size_t)e * 1024 * 1024;
            moe_quant_item(c, W, 32 * nb, 0, 0, ws + (l ? WS_WDN8_1 : WS_WDN8_0) + (size_t)e * 1024 * 1024, (float*)(ws + WS_SW) + 2 * NE * 2048 + (l ? NE * 1024 : 0) + e * 1024); }
      } }
    const int gt = c.bid * NTHR + c.tid, NGT = c.G * NTHR;
    f32x2* R16 = (f32x2*)(ws + WS_ROPE16); f32x2* R32 = (f32x2*)(ws + WS_ROPE32);
    for (int i = gt; i < SEQ * 48; i += NGT) { const int t = i / 48, jj = i - t * 48;
        int nf, j; if (jj < 16) { nf = 8; j = jj; } else { nf = 16; j = jj - 16; }
        const int f = j < nf ? j : j - nf; const float pos = (float)(j < nf ? (t >> 6) : (t & 63));
        const float invf = (nf == 8) ? INVF8[f] : INVF16[f];
        const float ang = pos * invf; const double da = (double)ang;
        const double qd = rint(da * 0.6366197723675814); const double y = fma(-qd, 1.5707963267948966, da) - qd * 6.123233995736766e-17; const double y2 = y * y;
        const double sy = y * (1.0 + y2 * (-1.0 / 6 + y2 * (1.0 / 120 + y2 * (-1.0 / 5040 + y2 * (1.0 / 362880 + y2 * (-1.0 / 39916800))))));
        const double cy = 1.0 + y2 * (-0.5 + y2 * (1.0 / 24 + y2 * (-1.0 / 720 + y2 * (1.0 / 40320 + y2 * (-1.0 / 3628800 + y2 * (1.0 / 479001600))))));
        const int qi = ((int)qd) & 3;
        const double cr = (qi == 0) ? cy : (qi == 1) ? -sy : (qi == 2) ? -cy : sy, sr = (qi == 0) ? sy : (qi == 1) ? cy : (qi == 2) ? -sy : -cy;
        const f32x2 cs = {(float)cr, (float)sr};
        if (jj < 16) R16[t * 16 + j] = cs; else R32[t * 32 + j] = cs; }
    bf16* GW = (bf16*)(ws + WS_GWS);
    for (int i = gt; i < 4 * 128 * 128 / 2; i += NGT) { const f32x2 v = *(const f32x2*)(p.in[I_GWS] + 2 * i); ((unsigned*)GW)[i] = cvt_pk(v.x, v.y); }
    unsigned* padz = (unsigned*)((bf16*)(ws + WS_WIN0) + (size_t)1440 * 1024);
    for (int i = gt; i < 96 * 1024 / 2; i += NGT) padz[i] = 0u;
}

DI void phase_mod_rows(const Ctx& c, const float* xl, const float* xc, const float* mod  , int sh_off, int sc_off, bf16* H) {
    for (int row = c.gw; row < NR; row += c.NGW) {
        const bool lat = row < NL; const int b = lat ? (row >> 13) : 8;
        const float* xs = lat ? xl + (size_t)row * 1024 : xc + (size_t)(row - NL) * 1024;
#pragma unroll
        for (int j = 0; j < 4; ++j) { const int col = 4 * c.lane + 256 * j;
            const f32x4 x = *(const f32x4*)(xs + col), sc = *(const f32x4*)(mod + b * 6144 + sc_off + col), sh = *(const f32x4*)(mod + b * 6144 + sh_off + col);
            const f32x4 h = x * (sc + 1.f) + sh;
            u32x2 w; w.x = cvt_pk(h[0], h[1]); w.y = cvt_pk(h[2], h[3]);
            *(u32x2*)(H + (size_t)row * 1024 + col) = w; }
    }
}

DI void phase_gmlp(const Params& p, const Ctx& c, bf16* UVd) {
    unsigned char* ws = p.ws;
    bf16* UV = (bf16*)(ws + WS_UV); const bf16* CQ = (const bf16*)(ws + WS_CQ); const bf16* CKV = (const bf16*)(ws + WS_CKV);
    float* RQ = (float*)(ws + WS_RQ); float* RKV = (float*)(ws + WS_RKV); const bf16* GW = (const bf16*)(ws + WS_GWS);
    const float* lng = p.in[I_GLNG]; const float* lnb = p.in[I_GLNB]; const float* bs = p.in[I_GBS];
    constexpr int PITCH = 136;
    bf16* WsL = (bf16*)c.lds;
    bf16* VT = WsL + 128 * PITCH;
    f32x2* st = (f32x2*)(VT + 128 * PITCH);
    const int tk = c.tid >> 2, part = c.tid & 3;
    for (int unit = c.bid; unit < (NR / 128) * 4; unit += c.G) {
        const int ch = unit >> 2, g = unit & 3, row0 = ch * 128;
        {
            const bf16* vrow = UV + (size_t)(row0 + tk) * 1024 + 512 + part * 128; float s = 0.f, s2 = 0.f;
#pragma unroll
            for (int i = 0; i < 16; ++i) { const u32x4 w = *(const u32x4*)(vrow + 8 * i);
#pragma unroll
                for (int k = 0; k < 4; ++k) { const float a = bf_lo(w[k]), b = bf_hi(w[k]); s += a + b; s2 += a * a + b * b; } }
            s += __shfl_xor(s, 1); s += __shfl_xor(s, 2); s2 += __shfl_xor(s2, 1); s2 += __shfl_xor(s2, 2);
            const float mean = s * (1.f / 512.f), var = fmaxf(s2 * (1.f / 512.f) - mean * mean, 0.f);
            if (part == 0) st[tk] = (f32x2){mean, 1.f / sqrtf(var + 1e-5f)};
            if (g == 0) {
                const bf16* q = CQ + (size_t)(row0 + tk) * 256 + part * 64; float ss = 0.f;
#pragma unroll
                for (int i = 0; i < 8; ++i) { const u32x4 w = *(const u32x4*)(q + 8 * i);
#pragma unroll
                    for (int k = 0; k < 4; ++k) { const float a = bf_lo(w[k]), b = bf_hi(w[k]); ss += a * a + b * b; } }
                ss += __shfl_xor(ss, 1); ss += __shfl_xor(ss, 2);
                const bf16* kv = CKV + (size_t)(row0 + tk) * 128 + part * 32; float sk = 0.f;
#pragma unroll
                for (int i = 0; i < 4; ++i) { const u32x4 w = *(const u32x4*)(kv + 8 * i);
#pragma unroll
                    for (int k = 0; k < 4; ++k) { const float a = bf_lo(w[k]), b = bf_hi(w[k]); sk += a * a + b * b; } }
                sk += __shfl_xor(sk, 1); sk += __shfl_xor(sk, 2);
                if (part == 0) { RQ[row0 + tk] = 1.f / sqrtf(ss * (1.f / 256.f) + 1e-6f); RKV[row0 + tk] = 1.f / sqrtf(sk * (1.f / 128.f) + 1e-6f); }
            }
        }
        for (int i = c.tid; i < 2048; i += NTHR) { const int pr = i >> 4, qc = (i & 15) * 8; *(u32x4*)(WsL + pr * PITCH + qc) = *(const u32x4*)(GW + (size_t)g * 16384 + pr * 128 + qc); }
        __syncthreads();
        {
            const f32x2 ms = st[tk]; const bf16* vrow = UV + (size_t)(row0 + tk) * 1024 + 512 + g * 128 + part * 32;
#pragma unroll
            for (int i = 0; i < 4; ++i) { const u32x4 w = *(const u32x4*)(vrow + 8 * i);
#pragma unroll
                for (int k = 0; k < 4; ++k) { const int cc = part * 32 + 8 * i + 2 * k; const int cg = g * 128 + cc;
                    const float a = (bf_lo(w[k]) - ms.x) * ms.y * lng[cg] + lnb[cg], b = (bf_hi(w[k]) - ms.x) * ms.y * lng[cg + 1] + lnb[cg + 1];
                    const unsigned pk = cvt_pk(a, b);
                    VT[cc * PITCH + tk] = (bf16)(pk & 0xffffu); VT[(cc + 1) * PITCH + tk] = (bf16)(pk >> 16); } }
        }
        __syncthreads();
        f32x4 acc[8];
#pragma unroll
        for (int pt = 0; pt < 8; ++pt) acc[pt] = (f32x4){0.f, 0.f, 0.f, 0.f};
        const int fr = c.lane & 15, fq = c.lane >> 4;
#pragma unroll
        for (int ks = 0; ks < 4; ++ks) {
            const bf16x8 a = *(const bf16x8*)(VT + (16 * c.wave + fr) * PITCH + 32 * ks + 8 * fq);
#pragma unroll
            for (int pt = 0; pt < 8; ++pt) { const bf16x8 b = *(const bf16x8*)(WsL + (16 * pt + fr) * PITCH + 32 * ks + 8 * fq);
                acc[pt] = __builtin_amdgcn_mfma_f32_16x16x32_bf16(a, b, acc[pt], 0, 0, 0); }
        }
#pragma unroll
        for (int pt = 0; pt < 8; ++pt) { const int pp = 16 * pt + fr; const float bias = bs[g * 128 + pp];
            bf16* up = UV + (size_t)(row0 + pp) * 1024 + g * 128 + 16 * c.wave + 4 * fq;
            const u32x2 uu = *(const u32x2*)up;
            u32x2 w; w.x = cvt_pk(bf_lo(uu.x) * (acc[pt][0] + bias), bf_hi(uu.x) * (acc[pt][1] + bias)); w.y = cvt_pk(bf_lo(uu.y) * (acc[pt][2] + bias), bf_hi(uu.y) * (acc[pt][3] + bias));
            *(u32x2*)(UVd + (up - UV)) = w; }
        __syncthreads();
    }
}

DI f32x4 ld4(const float* p) { return *(const f32x4*)p; }
DI void router_reduce(float (&lg)[16], const int lane) {
    const bool b5 = (lane & 32) != 0, b4 = (lane & 16) != 0, b3 = (lane & 8) != 0, b2 = (lane & 4) != 0;
#pragma unroll
    for (int e = 0; e < 8; ++e) { const float send = b5 ? lg[e] : lg[e + 8], keep = b5 ? lg[e + 8] : lg[e]; lg[e] = keep + __shfl_xor(send, 32); }
#pragma unroll
    for (int e = 0; e < 4; ++e) { const float send = b4 ? lg[e] : lg[e + 4], keep = b4 ? lg[e + 4] : lg[e]; lg[e] = keep + __shfl_xor(send, 16); }
#pragma unroll
    for (int e = 0; e < 2; ++e) { const float send = b3 ? lg[e] : lg[e + 2], keep = b3 ? lg[e + 2] : lg[e]; lg[e] = keep + __shfl_xor(send, 8); }
    { const float send = b2 ? lg[0] : lg[1], keep = b2 ? lg[1] : lg[0]; lg[0] = keep + __shfl_xor(send, 4); }
    lg[0] += __shfl_xor(lg[0], 2); lg[0] += __shfl_xor(lg[0], 1);
}
DI f32x4 ldbf4(const bf16* p) { const u32x2 w = *(const u32x2*)p; return (f32x4){bf_lo(w.x), bf_hi(w.x), bf_lo(w.y), bf_hi(w.y)}; }
DI void stbf4(bf16* p, f32x4 v) { u32x2 w; w.x = cvt_pk(v[0], v[1]); w.y = cvt_pk(v[2], v[3]); *(u32x2*)p = w; }
DI void phase_ln_router(const Ctx& c, const bf16* T16, bf16* X1, const float* lng, const float* lnb, const float* mod  , const float* router  ,
                        unsigned char* H8, float* SX, float* AFF, float* AFFC, int nrows) {
    float* rt = (float*)c.lds;
    for (int i = c.tid; i < 16384; i += NTHR) { const int k = i >> 4, e = i & 15; rt[e * 1024 + k] = router[i]; }
    __syncthreads();
    const int eidx = ((c.lane >> 2) & 1) | (((c.lane >> 3) & 1) << 1) | (((c.lane >> 4) & 1) << 2) | (((c.lane >> 5) & 1) << 3);
    for (int row = 2 * c.gw; row < nrows; row += 2 * c.NGW) {
        const bool lat = row < NL; const int b = lat ? (row >> 13) : 8;
        const bf16* ta = T16 + (size_t)row * 1024; const bf16* tb = ta + 1024;
        bf16* da = X1 + (size_t)row * 1024; bf16* db = da + 1024;
        const float* mrow = mod + b * 6144;
        f32x4 xa[4], xb[4]; float sa = 0.f, sa2 = 0.f, sb = 0.f, sb2 = 0.f;
#pragma unroll
        for (int j = 0; j < 4; ++j) { xa[j] = ldbf4(ta + 4 * c.lane + 256 * j); xb[j] = ldbf4(tb + 4 * c.lane + 256 * j); }
#pragma unroll
        for (int j = 0; j < 4; ++j) { sa += (xa[j][0] + xa[j][1]) + (xa[j][2] + xa[j][3]); sb += (xb[j][0] + xb[j][1]) + (xb[j][2] + xb[j][3]); }
        const float ma = wave_sum(sa) * (1.f / 1024.f), mb = wave_sum(sb) * (1.f / 1024.f);
#pragma unroll
        for (int j = 0; j < 4; ++j) { xa[j] = xa[j] - ma; xb[j] = xb[j] - mb;
            sa2 += (xa[j][0] * xa[j][0] + xa[j][1] * xa[j][1]) + (xa[j][2] * xa[j][2] + xa[j][3] * xa[j][3]);
            sb2 += (xb[j][0] * xb[j][0] + xb[j][1] * xb[j][1]) + (xb[j][2] * xb[j][2] + xb[j][3] * xb[j][3]); }
        const float ra = 1.f / sqrtf(wave_sum(sa2) * (1.f / 1024.f) + 1e-5f), rb = 1.f / sqrtf(wave_sum(sb2) * (1.f / 1024.f) + 1e-5f);
        float ivA, ivB;
        { float amA = 0.f, amB = 0.f;
#pragma unroll
          for (int j = 0; j < 4; ++j) { const int col = 4 * c.lane + 256 * j;
              const f32x4 g = ld4(lng + col), bt = ld4(lnb + col), sc = ld4(mrow + 4 * 1024 + col) + 1.f, sh = ld4(mrow + 3 * 1024 + col);
              const f32x4 ha = (xa[j] * ra * g + bt) * sc + sh, hb = (xb[j] * rb * g + bt) * sc + sh;
              amA = fmaxf(amA, fmaxf(fmaxf(fabsf(ha[0]), fabsf(ha[1])), fmaxf(fabsf(ha[2]), fabsf(ha[3])))); amB = fmaxf(amB, fmaxf(fmaxf(fabsf(hb[0]), fabsf(hb[1])), fmaxf(fabsf(hb[2]), fabsf(hb[3])))); }
          amA = wave_max(amA); amB = wave_max(amB);
          const float scA = amA > 0.f ? amA * (1.f / 448.f) : 1.f, scB = amB > 0.f ? amB * (1.f / 448.f) : 1.f; ivA = 1.f / scA; ivB = 1.f / scB;
          if (c.lane == 0) { SX[row] = scA; SX[row + 1] = scB; }
          __builtin_amdgcn_sched_barrier(0); }
        float la[16], lb[16];
#pragma unroll
        for (int e = 0; e < 16; ++e) { la[e] = 0.f; lb[e] = 0.f; }
#pragma unroll
        for (int j = 0; j < 4; ++j) { const int col = 4 * c.lane + 256 * j;
            const f32x4 g = ld4(lng + col), bt = ld4(lnb + col), sc = ld4(mrow + 4 * 1024 + col) + 1.f, sh = ld4(mrow + 3 * 1024 + col);
            const f32x4 x1a = xa[j] * ra * g + bt, x1b = xb[j] * rb * g + bt;
            stbf4(da + col, x1a); stbf4(db + col, x1b);
            const f32x4 ha = x1a * sc + sh, hb = x1b * sc + sh;
            *(unsigned*)(H8 + (size_t)row * 1024 + col) = pk4_fp8(ha[0] * ivA, ha[1] * ivA, ha[2] * ivA, ha[3] * ivA);
            *(unsigned*)(H8 + (size_t)(row + 1) * 1024 + col) = pk4_fp8(hb[0] * ivB, hb[1] * ivB, hb[2] * ivB, hb[3] * ivB);
#pragma unroll
            for (int e = 0; e < 16; ++e) { const f32x4 w = *(const f32x4*)(rt + e * 1024 + col);
                la[e] += (ha[0] * w[0] + ha[1] * w[1]) + (ha[2] * w[2] + ha[3] * w[3]); lb[e] += (hb[0] * w[0] + hb[1] * w[1]) + (hb[2] * w[2] + hb[3] * w[3]); } }
        router_reduce(la, c.lane); router_reduce(lb, c.lane);
        const float mxa = wave_max(la[0]), mxb = wave_max(lb[0]); const float ea = expf(la[0] - mxa), eb = expf(lb[0] - mxb);
        const float sea = wave_sum(ea) * 0.25f, seb = wave_sum(eb) * 0.25f;
        float* dst = lat ? AFF + (size_t)(b * 16) * SEQ + (row & (SEQ - 1)) : AFFC + (size_t)(((row - NL) >> 8) * 16) * CTX + ((row - NL) & (CTX - 1));
        const int estride = lat ? SEQ : CTX;
        if ((c.lane & 3) == 0) { dst[(size_t)eidx * estride] = ea / sea; dst[(size_t)eidx * estride + 1] = eb / seb; }
    }
    __syncthreads();
}

template <int PER>
DI void topk_unit(const Ctx& c, const float* aff, int n, int k, int* rowidx_out, float* gate_out, int* slotrow, int e, int tokrow0, int yrow0) {
    unsigned* cnts = (unsigned*)c.lds;
    unsigned* wtot = cnts + 16;
    const int i0 = c.tid * PER; const bool active = i0 < n;
    unsigned v[PER];
    if constexpr (PER == 16) {
#pragma unroll
        for (int q = 0; q < 4; ++q) { const u32x4 w = active ? *(const u32x4*)((const unsigned*)aff + i0 + 4 * q) : (u32x4){0u, 0u, 0u, 0u}; v[4 * q] = w.x; v[4 * q + 1] = w.y; v[4 * q + 2] = w.z; v[4 * q + 3] = w.w; }
    } else { v[0] = active ? __float_as_uint(aff[i0]) : 0u; }
    unsigned T = 0u;
    for (int b = 30; b >= 0; --b) {
        const unsigned cand = T | (1u << b); unsigned cw = 0u;
#pragma unroll
        for (int j = 0; j < PER; ++j) cw += (unsigned)__popcll(__ballot(v[j] >= cand));
        unsigned* cb = cnts + (b & 1) * 8;
        if (c.lane == 0) cb[c.wave] = cw;
        __syncthreads();
        unsigned tot = 0u;
#pragma unroll
        for (int w = 0; w < 8; ++w) tot += cb[w];
        if (tot >= (unsigned)k) T = cand;
    }
    unsigned cg = 0, ce = 0;
#pragma unroll
    for (int j = 0; j < PER; ++j) { cg += (v[j] > T) ? 1u : 0u; ce += (v[j] == T && active) ? 1u : 0u; }
    const unsigned packed = cg | (ce << 16); unsigned incl = packed;
#pragma unroll
    for (int o = 1; o < 64; o <<= 1) { const unsigned t = __shfl_up(incl, o); if (c.lane >= o) incl += t; }
    if (c.lane == 63) wtot[c.wave] = incl;
    __syncthreads();
    unsigned off = 0u, tot_gt = 0u;
    for (int w = 0; w < 8; ++w) { const unsigned t = wtot[w]; if (w < c.wave) off += t; tot_gt += t & 0xffffu; }
    const unsigned need_eq = (unsigned)k - tot_gt, cnt_gt = tot_gt;
    const unsigned excl = incl - packed + off; unsigned g_off = excl & 0xffffu, e_off = excl >> 16;
    if (active) { int sl[PER];
#pragma unroll
        for (int j = 0; j < PER; ++j) { const int i = i0 + j; const unsigned x = v[j]; int slot = -1;
            if (x > T) slot = (int)(g_off++);
            else if (x == T) { if (e_off < need_eq) slot = (int)(cnt_gt + e_off); ++e_off; }
            if (slot >= 0) { rowidx_out[slot] = tokrow0 + i; gate_out[slot] = __uint_as_float(x); sl[j] = yrow0 + slot; } else sl[j] = -1; }
        if constexpr (PER == 16) {
#pragma unroll
            for (int q = 0; q < 4; ++q) *(u32x4*)(slotrow + i0 + 4 * q) = (u32x4){(unsigned)sl[4 * q], (unsigned)sl[4 * q + 1], (unsigned)sl[4 * q + 2], (unsigned)sl[4 * q + 3]};
        } else slotrow[i0] = sl[0];
    }
    __syncthreads();
}
DI void phase_topk(const Params& p, const Ctx& c, bool with_ctx) {
    unsigned char* ws = p.ws;
    const float* AFF = (const float*)(ws + WS_AFF); const float* AFFC = (const float*)(ws + WS_AFFC);
    int* ROWIDX = (int*)(ws + WS_ROWIDX); float* ROWGATE = (float*)(ws + WS_ROWGATE); int* SLOTROW = (int*)(ws + WS_SLOTROW);
    const int nunits = with_ctx ? 256 : 128;
    for (int unit = c.bid; unit < nunits; unit += c.G) {
        if (unit < 128) { const int b = unit >> 4, e = unit & 15;
            topk_unit<16>(c, AFF + (size_t)(b * 16 + e) * SEQ, SEQ, CAPL, ROWIDX + e * ROWS_E + b * CAPL, ROWGATE + e * ROWS_E + b * CAPL, SLOTROW + (size_t)(b * 16 + e) * SEQ, e, b * SEQ, e * ROWS_E + b * CAPL); }
        else { const int uu = unit - 128, b = uu >> 4, e = uu & 15;
            topk_unit<1>(c, AFFC + (size_t)(b * 16 + e) * CTX, CTX, CAPC, ROWIDX + e * ROWS_E + NB * CAPL + b * CAPC, ROWGATE + e * ROWS_E + NB * CAPL + b * CAPC, SLOTROW + (size_t)NL * 16 + (size_t)(b * 16 + e) * CTX, e, NL + b * CTX, e * ROWS_E + NB * CAPL + b * CAPC); }
    }
}

DI void quant_row_fp8(const bf16* src, unsigned char* dst, float* scale_out, int lane) {
    const u32x4* s = (const u32x4*)src + 2 * lane; const u32x4 a = s[0], b = s[1];
    float v[16];
#pragma unroll
    for (int k = 0; k < 4; ++k) { v[2 * k] = bf_lo(a[k]); v[2 * k + 1] = bf_hi(a[k]); v[8 + 2 * k] = bf_lo(b[k]); v[8 + 2 * k + 1] = bf_hi(b[k]); }
    float mx = 0.f;
#pragma unroll
    for (int k = 0; k < 16; ++k) mx = fmaxf(mx, fabsf(v[k]));
    mx = wave_max(mx);
    const float sc = mx > 0.f ? mx * (1.f / 448.f) : 1.f, inv = 1.f / sc;
    u32x4 o;
    o.x = pk4_fp8(v[0] * inv, v[1] * inv, v[2] * inv, v[3] * inv); o.y = pk4_fp8(v[4] * inv, v[5] * inv, v[6] * inv, v[7] * inv);
    o.z = pk4_fp8(v[8] * inv, v[9] * inv, v[10] * inv, v[11] * inv); o.w = pk4_fp8(v[12] * inv, v[13] * inv, v[14] * inv, v[15] * inv);
    *((u32x4*)dst + lane) = o;
    if (lane == 0) *scale_out = sc;
}
DI void phase_quant_rows(const Params& p, const Ctx& c, int nrows, int first_block) {
    unsigned char* ws = p.ws; const bf16* H = (const bf16*)(ws + WS_H); unsigned char* H8 = ws + WS_XS; float* SX = (float*)(ws + WS_SX);
    if (c.bid < first_block) return;
    const int ngw = (c.G - first_block) * NWAVES;
    for (int r = (c.bid - first_block) * NWAVES + c.wave; r < nrows; r += ngw) quant_row_fp8(H + (size_t)r * 1024, H8 + (size_t)r * 1024, SX + r, c.lane);
}
DI void phase_kr(const Params& p, const Ctx& c) {
    unsigned char* ws = p.ws; const bf16* KR = (const bf16*)(ws + WS_KR); bf16* K0 = (bf16*)(ws + WS_K0); const f32x2* R16 = (const f32x2*)(ws + WS_ROPE16);
    unsigned* kchr = (unsigned*)(ws + WS_CTL) + CW_KCHR;
    const int gt = c.bid * NTHR + c.tid, NGT = c.G * NTHR;
    for (int i = gt; i < NR * 4; i += NGT) { const int row = i >> 2, ch = i & 3;
        const u32x4 w = *(const u32x4*)(KR + (size_t)row * 32 + ch * 8);
        f32x4 v0 = {bf_lo(w.x), bf_hi(w.x), bf_lo(w.y), bf_hi(w.y)}, v1 = {bf_lo(w.z), bf_hi(w.z), bf_lo(w.w), bf_hi(w.w)};
        int b, tpos, tr; row_info(row, b, tpos, tr);
        if (tr >= 0) rope8(v0, v1, R16 + tr * 16 + ch * 4);
        const u32x2 o = pack8_fp8(v0 * 0.25f, v1 * 0.25f); const u32x2 z = {0u, 0u};
#pragma unroll
        for (int h = 0; h < 8; ++h) { unsigned char* kr_ = (unsigned char*)K0 + ((size_t)(b * 8 + h) * TKV + tpos) * 128; *(u32x2*)(kr_ + 64 + ch * 8) = o; *(u32x2*)(kr_ + 96 + ch * 8) = z; }
        const float n2 = (v0[0] * v0[0] + v0[1] * v0[1]) + (v0[2] * v0[2] + v0[3] * v0[3]) + (v1[0] * v1[0] + v1[1] * v1[1]) + (v1[2] * v1[2] + v1[3] * v1[3]);
        float mx = n2; mx = fmaxf(mx, __shfl_xor(mx, 4)); mx = fmaxf(mx, __shfl_xor(mx, 8)); mx = fmaxf(mx, __shfl_xor(mx, 16)); mx = fmaxf(mx, __shfl_xor(mx, 32));
        if ((c.lane >> 2) == 0) atomicMax(kchr + b * 4 + ch, __float_as_uint(mx)); }
}
DI void quant_wgu(const Ctx& c, const bf16* W, unsigned char* W8, float* SW, int nrows, int first_block = 0) {
    if (c.bid < first_block) return;
    const int ngw = (c.G - first_block) * NWAVES;
    for (int n = (c.bid - first_block) * NWAVES + c.wave; n < nrows; n += ngw) quant_row_fp8(W + (size_t)n * 1024, W8 + (size_t)n * 1024, SW + n, c.lane);
}

DI void acc_y(f32x4 (&f)[4], const u32x2 (&y)[4]) {
#pragma unroll
    for (int j = 0; j < 4; ++j) { f[j][0] += bf_lo(y[j].x); f[j][1] += bf_hi(y[j].x); f[j][2] += bf_lo(y[j].y); f[j][3] += bf_hi(y[j].y); }
}
DI void ld_y(u32x2 (&y)[4], const bf16* Y, int s, int lane) {
    const bf16* yr = Y + (size_t)s * 1024 + 4 * lane;
#pragma unroll
    for (int j = 0; j < 4; ++j) y[j] = *(const u32x2*)(yr + 256 * j);
}
DI void phase_combine_ln(const Ctx& c, const bf16* X1, float* OUTL, float* OUTC, const bf16* Y, const int* SLOTROW, const float* lng, const float* lnb,
                         const float* mod  , const float* modn  , bf16* H, int nrows) {
    for (int row = 2 * c.gw; row < nrows; row += 2 * c.NGW) {
        const bool lat = row < NL; const int b = lat ? (row >> 13) : 8;
        const bf16* xs = X1 + (size_t)row * 1024; float* os = lat ? OUTL + (size_t)row * 1024 : OUTC + (size_t)(row - NL) * 1024;
        int sl = -1;
        if (c.lane < 32) { const int ee = c.lane & 15, dt = c.lane >> 4;
            sl = lat ? SLOTROW[(size_t)((row >> 13) * 16 + ee) * SEQ + (row & (SEQ - 1)) + dt] : SLOTROW[(size_t)NL * 16 + (size_t)(((row - NL) >> 8) * 16 + ee) * CTX + ((row - NL) & (CTX - 1)) + dt]; }
        f32x4 xa[4], xb[4];
#pragma unroll
        for (int j = 0; j < 4; ++j) { xa[j] = ldbf4(xs + 4 * c.lane + 256 * j); xb[j] = ldbf4(xs + 1024 + 4 * c.lane + 256 * j); }
        const unsigned long long bal = __ballot(sl >= 0);
        unsigned mA = (unsigned)(bal & 0xffffull), mB = (unsigned)((bal >> 16) & 0xffffull);
        f32x4 fa[4], fb[4];
#pragma unroll
        for (int j = 0; j < 4; ++j) { fa[j] = (f32x4){0.f, 0.f, 0.f, 0.f}; fb[j] = (f32x4){0.f, 0.f, 0.f, 0.f}; }
        while (mA | mB) {
            u32x2 ya0[4], ya1[4], yb0[4], yb1[4];
            const bool va0 = mA != 0; if (va0) { const int e0 = __builtin_ctz(mA); mA &= mA - 1; ld_y(ya0, Y, __builtin_amdgcn_readlane(sl, e0), c.lane); }
            const bool va1 = mA != 0; if (va1) { const int e1 = __builtin_ctz(mA); mA &= mA - 1; ld_y(ya1, Y, __builtin_amdgcn_readlane(sl, e1), c.lane); }
            const bool vb0 = mB != 0; if (vb0) { const int e0 = __builtin_ctz(mB); mB &= mB - 1; ld_y(yb0, Y, __builtin_amdgcn_readlane(sl, 16 + e0), c.lane); }
            const bool vb1 = mB != 0; if (vb1) { const int e1 = __builtin_ctz(mB); mB &= mB - 1; ld_y(yb1, Y, __builtin_amdgcn_readlane(sl, 16 + e1), c.lane); }
            if (va0) acc_y(fa, ya0); if (va1) acc_y(fa, ya1); if (vb0) acc_y(fb, yb0); if (vb1) acc_y(fb, yb1);
        }
        float sa = 0.f, sb = 0.f;
#pragma unroll
        for (int j = 0; j < 4; ++j) { const int col = 4 * c.lane + 256 * j; const f32x4 g = ld4(mod + b * 6144 + 5 * 1024 + col) + 1.f;
            xa[j] = xa[j] * DN_ALPHA + g * fa[j]; xb[j] = xb[j] * DN_ALPHA + g * fb[j];
            sa += (xa[j][0] + xa[j][1]) + (xa[j][2] + xa[j][3]); sb += (xb[j][0] + xb[j][1]) + (xb[j][2] + xb[j][3]); }
        const float ma = wave_sum(sa) * (1.f / 1024.f), mb = wave_sum(sb) * (1.f / 1024.f); float sa2 = 0.f, sb2 = 0.f;
#pragma unroll
        for (int j = 0; j < 4; ++j) { xa[j] = xa[j] - ma; xb[j] = xb[j] - mb;
            sa2 += (xa[j][0] * xa[j][0] + xa[j][1] * xa[j][1]) + (xa[j][2] * xa[j][2] + xa[j][3] * xa[j][3]);
            sb2 += (xb[j][0] * xb[j][0] + xb[j][1] * xb[j][1]) + (xb[j][2] * xb[j][2] + xb[j][3] * xb[j][3]); }
        const float ra = 1.f / sqrtf(wave_sum(sa2) * (1.f / 1024.f) + 1e-5f), rb = 1.f / sqrtf(wave_sum(sb2) * (1.f / 1024.f) + 1e-5f);
#pragma unroll
        for (int j = 0; j < 4; ++j) { const int col = 4 * c.lane + 256 * j; const f32x4 g = ld4(lng + col), bb = ld4(lnb + col);
            const f32x4 ya = xa[j] * ra * g + bb, yb = xb[j] * rb * g + bb; *(f32x4*)(os + col) = ya; *(f32x4*)(os + 1024 + col) = yb;
            if (modn) { const f32x4 sc = ld4(modn + b * 6144 + 1024 + col) + 1.f, sh = ld4(modn + b * 6144 + col); const f32x4 ha = ya * sc + sh, hb = yb * sc + sh;
                u32x2 wa, wb; wa.x = cvt_pk(ha[0], ha[1]); wa.y = cvt_pk(ha[2], ha[3]); wb.x = cvt_pk(hb[0], hb[1]); wb.y = cvt_pk(hb[2], hb[3]);
                *(u32x2*)(H + (size_t)row * 1024 + col) = wa; *(u32x2*)(H + (size_t)(row + 1) * 1024 + col) = wb; } }
    }
}
DI void vote_init(const Ctx& c, const int off) { volatile unsigned* w = (volatile unsigned*)(c.lds + off); if (c.tid == 0) { w[0] = 0u; w[1] = 0u; } __syncthreads(); }
DI bool vote_any(const Ctx& c, const int off, const bool need, int& par) {
    volatile unsigned* w = (volatile unsigned*)(c.lds + off);
    if (need && c.lane == 0) w[par] = 1u;
    __syncthreads();
    const bool r = __builtin_amdgcn_readfirstlane(w[par]) != 0u;
    par ^= 1;
    if (c.tid == 0) w[par] = 0u;
    return r;
}
DI void phase_attn_mla(const Params& p, const Ctx& c) {
    unsigned char* ws = p.ws;
    const bf16* QL = (const bf16*)(ws + WS_QL); const bf16* QC = (const bf16*)(ws + WS_QC); const bf16* K0 = (const bf16*)(ws + WS_K0); const unsigned char* V0T = ws + WS_V0;
    bf16* CAT = (bf16*)(ws + WS_UV);
    int par = 0; vote_init(c, att::Cfg2<96, 64>::WS_OFF);
    for (int i = 0;; ++i) {
        const int L = i * c.G + c.bid;
        if (L >= 2048 + 64) break;
        const bf16 *Qb, *Kh, *Vt; int seq, orow0, h;
        if (L < 2048) { const int bh = (L >> 8) * 8 + (L & 7), qb = (L & 255) >> 3; const int b = bh >> 3; h = bh & 7;
            Qb = (const bf16*)((const char*)QL + ((size_t)bh * SEQ + qb * 256) * 128); Kh = (const bf16*)((const char*)K0 + (size_t)bh * TKV * 128);     Vt = (const bf16*)(V0T + (size_t)bh * 64 * TKV); seq = TKV; orow0 = b * SEQ + qb * 256; }
        else { const int bh = L - 2048; const int b = bh >> 3; h = bh & 7;
            Qb = (const bf16*)((const char*)QC + (size_t)bh * CTX * 128); Kh = (const bf16*)((const char*)K0 + ((size_t)bh * TKV + SEQ) * 128); Vt = (const bf16*)(V0T + (size_t)bh * 64 * TKV + SEQ); seq = CTX; orow0 = NL + b * CTX; }
        float kmax2 = 0.f;
        { const float* kc = (const float*)(ws + WS_CTL) + CW_KCH0 + ((L < 2048 ? ((L >> 8) * 8 + (L & 7)) : (L - 2048))) * 8; const float* kr4 = (const float*)(ws + WS_CTL) + CW_KCHR + ((L < 2048 ? ((L >> 8) * 8 + (L & 7)) : (L - 2048)) >> 3) * 4;
#pragma unroll
          for (int i2 = 0; i2 < 8; ++i2) kmax2 += kc[i2];
#pragma unroll
          for (int i2 = 0; i2 < 4; ++i2) kmax2 += kr4[i2]; }
        att::f32x16 o[2]; float l_reg;
        { const bool need = att::attn_core2<96, 64, false>((const char*)Qb, (const char*)Kh, (const char*)Vt, TKV, seq, (char*)c.lds, o, l_reg, c.wave, kmax2);
          if (vote_any(c, att::Cfg2<96, 64>::WS_OFF, need, par)) att::attn_core2<96, 64, true>((const char*)Qb, (const char*)Kh, (const char*)Vt, TKV, seq, (char*)c.lds, o, l_reg, c.wave, kmax2); }
        int ln = c.lane; asm volatile("" : "+v"(ln));
        const int r32 = ln & 31, hi = ln >> 5; const float inv = 1.f / (l_reg * att::VSC8);
        const unsigned obase = ((unsigned)(orow0 + c.wave * 32 + r32) * 1024u + (unsigned)(512 + h * 64 + 8 * hi)) * 2u;
#pragma unroll
        for (int d0 = 0; d0 < 2; ++d0)
#pragma unroll
            for (int q4 = 0; q4 < 4; q4 += 2) { u32x2 wa, wb;
                wa.x = cvt_pk(o[d0][4 * q4] * inv, o[d0][4 * q4 + 1] * inv); wa.y = cvt_pk(o[d0][4 * q4 + 2] * inv, o[d0][4 * q4 + 3] * inv);
                wb.x = cvt_pk(o[d0][4 * q4 + 4] * inv, o[d0][4 * q4 + 5] * inv); wb.y = cvt_pk(o[d0][4 * q4 + 6] * inv, o[d0][4 * q4 + 7] * inv);
                { auto r0 = __builtin_amdgcn_permlane32_swap(wa.x, wb.x, false, false); wa.x = r0[0]; wb.x = r0[1]; auto r1 = __builtin_amdgcn_permlane32_swap(wa.y, wb.y, false, false); wa.y = r1[0]; wb.y = r1[1]; }
                const u32x4 w = {wa.x, wa.y, wb.x, wb.y};
                *(u32x4*)((char*)CAT + (obase + (unsigned)(d0 * 64 + q4 * 16))) = w; }
    }
    __syncthreads();
}
#ifdef ATT_PROF
#define PROF_ARG , prof
#else
#define PROF_ARG
#endif
DI void phase_attn_diff(const Params& p, const Ctx& c) {
    unsigned char* ws = p.ws;
    const bf16* Q1 = (const bf16*)(ws + WS_Q1); const bf16* K1 = (const bf16*)(ws + WS_K1); const unsigned char* V1T = ws + WS_V1;   bf16* O1 = (bf16*)(ws + WS_O1);
    using CF = att::Cfg2<64, 128>;
    float lam;
    { const float a = p.in[I_LQ1][c.lane] * p.in[I_LK1][c.lane], b = p.in[I_LQ2][c.lane] * p.in[I_LK2][c.lane];
      lam = expf(wave_sum(a)) - expf(wave_sum(b)) + LAM_INIT; }
    const float* sg = p.in[I_SUBLN];
#ifdef ATT_PROF
    unsigned long long prof[5] = {0, 0, 0, 0, 0};
#endif
    int par = 0; vote_init(c, CF::WS_OFF);
    for (int i = 0;; ++i) {
        const int L = i * c.G + c.bid;
        if (L >= 2048) break;
        const int bh = (L >> 8) * 8 + (L & 7), qb = (L & 255) >> 3, b = bh >> 3, h = bh & 7;
        const bf16* Vt = (const bf16*)(V1T + (size_t)bh * 128 * TKV);
        att::f32x16 o[4]; float l_reg;
        {
            const int hh = 2 * h; const bf16* Qb = (const bf16*)((const char*)Q1 + ((size_t)(b * 16 + hh) * SEQ + qb * 256) * 64); const bf16* Kh = (const bf16*)((const char*)K1 + (size_t)(b * 16 + hh) * TKV * 64);
            float kmax2 = 0.f; { const float* kc = (const float*)(ws + WS_CTL) + CW_KCH1 + (b * 16 + hh) * 8;
#pragma unroll
              for (int i2 = 0; i2 < 8; ++i2) kmax2 += kc[i2]; }
            { const bool need = att::attn_core2<64, 128, false>((const char*)Qb, (const char*)Kh, (const char*)Vt, TKV, TKV, (char*)c.lds, o, l_reg, c.wave, kmax2);
              if (vote_any(c, CF::WS_OFF, need, par)) att::attn_core2<64, 128, true>((const char*)Qb, (const char*)Kh, (const char*)Vt, TKV, TKV, (char*)c.lds, o, l_reg, c.wave, kmax2); }
            int ln = c.lane; asm volatile("" : "+v"(ln));
            unsigned* st = (unsigned*)(c.lds + CF::STASH_OFF) + c.wave * 2048 + ln; const float inv = 1.f / (l_reg * att::VSC8);
#pragma unroll
            for (int d0 = 0; d0 < 4; ++d0)
#pragma unroll
                for (int r = 0; r < 16; r += 2) st[(d0 * 8 + (r >> 1)) * 64] = cvt_pk(o[d0][r] * inv, o[d0][r + 1] * inv);
        }
        {
            const int hh = 2 * h + 1; const bf16* Qb = (const bf16*)((const char*)Q1 + ((size_t)(b * 16 + hh) * SEQ + qb * 256) * 64); const bf16* Kh = (const bf16*)((const char*)K1 + (size_t)(b * 16 + hh) * TKV * 64);
            float kmax2 = 0.f; { const float* kc = (const float*)(ws + WS_CTL) + CW_KCH1 + (b * 16 + hh) * 8;
#pragma unroll
              for (int i2 = 0; i2 < 8; ++i2) kmax2 += kc[i2]; }
            { const bool need = att::attn_core2<64, 128, false>((const char*)Qb, (const char*)Kh, (const char*)Vt, TKV, TKV, (char*)c.lds, o, l_reg, c.wave, kmax2);
              if (vote_any(c, CF::WS_OFF, need, par)) att::attn_core2<64, 128, true>((const char*)Qb, (const char*)Kh, (const char*)Vt, TKV, TKV, (char*)c.lds, o, l_reg, c.wave, kmax2); }
        }
        int ln = c.lane; asm volatile("" : "+v"(ln));
        const int r32 = ln & 31, hi = ln >> 5;
        const unsigned* st = (const unsigned*)(c.lds + CF::STASH_OFF) + c.wave * 2048 + ln;
        const float nl = -lam / (l_reg * att::VSC8); float ss = 0.f;
#pragma unroll
        for (int d0 = 0; d0 < 4; ++d0)
#pragma unroll
            for (int r = 0; r < 16; r += 2) { const unsigned w = st[(d0 * 8 + (r >> 1)) * 64];
                const float f0 = bf_lo(w) + nl * o[d0][r], f1 = bf_hi(w) + nl * o[d0][r + 1];
                o[d0][r] = f0; o[d0][r + 1] = f1; ss += f0 * f0 + f1 * f1; }
        { auto rr = __builtin_amdgcn_permlane32_swap(__float_as_uint(ss), __float_as_uint(ss), false, false); ss = __uint_as_float(rr[0]) + __uint_as_float(rr[1]); }
        const float sc = (1.f - LAM_INIT) / sqrtf(ss * (1.f / 128.f) + 1e-6f);
        const unsigned obase = ((unsigned)(b * SEQ + qb * 256 + c.wave * 32 + r32) * 1024u + (unsigned)(h * 128 + 8 * hi)) * 2u;
#pragma unroll
        for (int d0 = 0; d0 < 4; ++d0)
#pragma unroll
            for (int q4 = 0; q4 < 4; q4 += 2) { const f32x4 g = *(const f32x4*)(sg + d0 * 32 + q4 * 8 + 4 * hi), g2 = *(const f32x4*)(sg + d0 * 32 + q4 * 8 + 8 + 4 * hi);
                u32x2 wa, wb; wa.x = cvt_pk(o[d0][4 * q4] * sc * g[0], o[d0][4 * q4 + 1] * sc * g[1]); wa.y = cvt_pk(o[d0][4 * q4 + 2] * sc * g[2], o[d0][4 * q4 + 3] * sc * g[3]);
                wb.x = cvt_pk(o[d0][4 * q4 + 4] * sc * g2[0], o[d0][4 * q4 + 5] * sc * g2[1]); wb.y = cvt_pk(o[d0][4 * q4 + 6] * sc * g2[2], o[d0][4 * q4 + 7] * sc * g2[3]);
                { auto r0 = __builtin_amdgcn_permlane32_swap(wa.x, wb.x, false, false); wa.x = r0[0]; wb.x = r0[1]; auto r1 = __builtin_amdgcn_permlane32_swap(wa.y, wb.y, false, false); wa.y = r1[0]; wb.y = r1[1]; }
                const u32x4 w = {wa.x, wa.y, wb.x, wb.y};
                *(u32x4*)((char*)O1 + (obase + (unsigned)(d0 * 64 + q4 * 16))) = w; }
    }
#ifdef ATT_PROF
    if (c.bid == 0 && c.lane == 0 && (c.wave == 0 || c.wave == 4)) { unsigned long long* dbg = (unsigned long long*)(ws + WS_CTL + 512 * 1024) + (c.wave >> 2) * 8;
        for (int i = 0; i < 5; ++i) dbg[i] = prof[i]; }
#endif
    __syncthreads();
}

constexpr int NPHASE = 22;
#ifndef PROBE_REPEAT_MASK
#define PROBE_REPEAT_MASK 0u
#endif
#ifndef PROBE_DRY_MASK
#define PROBE_DRY_MASK 0u
#endif
#define REP(k) _Pragma("unroll") for (int rep_ = 0; rep_ < (int)((PROBE_REPEAT_MASK >> (k)) & 1u) + 1; ++rep_)
__global__ void __launch_bounds__(NTHR, 2) trunk_fwd(Params p) {
    extern __shared__ __attribute__((aligned(16))) unsigned char lds[];
    const int BID = blockIdx.x, GRD = gridDim.x, WID = __builtin_amdgcn_readfirstlane((int)threadIdx.x >> 6);
    unsigned char* ws = p.ws;
    LAS unsigned char* ldsl = (LAS unsigned char*)lds;
    for (int u = WID * 64 + (int)__builtin_amdgcn_mbcnt_hi(~0u, __builtin_amdgcn_mbcnt_lo(~0u, 0u)); u < (LDS_BYTES - LDSCTL_OFF) / 4; u += NTHR) ((LAS unsigned*)(ldsl + LDSCTL_OFF))[u] = 0u;
    __syncthreads();
    unsigned* ctl = (unsigned*)(ws + WS_CTL);
    const bool multi = (p.ph_hi - p.ph_lo) > 1;
    XcdBarrier bar; bar.bar = ctl + CW_BAR; bar.x = 0; bar.st = nullptr;
    if (multi) bar = xcd_barrier_post(ctl + CW_BAR, (volatile LAS unsigned*)(ldsl + MISC_OFF) + 8, WID);
    const int lo = __builtin_amdgcn_readfirstlane(p.ph_lo), hi = __builtin_amdgcn_readfirstlane(p.ph_hi);
#ifdef ONLY_PHASE
#define IN(k) ((k) == ONLY_PHASE && lo <= (k))
#else
#define IN(k) (lo <= (k) && (k) < hi)
#endif
#ifdef PH_PROF
    unsigned long long ph_t = __builtin_amdgcn_s_memrealtime(), ph_bar = 0, ph_sel = 0;
#define SEAM(k) do { if (IN(k) && IN((k) + 1)) { const unsigned long long a_ = __builtin_amdgcn_s_memrealtime(); if ((PH_PROF_MASK >> (k)) & 1u) ph_sel += a_ - ph_t; \
        xcd_barrier(bar, WID); const unsigned long long b_ = __builtin_amdgcn_s_memrealtime(); ph_bar += b_ - a_; ph_t = b_; } } while (0)
#else
#define SEAM(k) do { if (IN(k) && IN((k) + 1)) xcd_barrier(bar, WID); } while (0)
#endif
#define SEAM2(k) do { if (IN(k) && IN((k) + 2)) xcd_barrier(bar, WID); } while (0)
    float* MOD = (float*)(ws + WS_MOD);
    bf16* H = (bf16*)(ws + WS_H);
    float* XC = (float*)(ws + WS_XC);
    const f32x2* R16 = (const f32x2*)(ws + WS_ROPE16); const f32x2* R32 = (const f32x2*)(ws + WS_ROPE32);

    if (IN(0)) REP(0) { const Ctx c = make_ctx(lds, WID); phase_prologue(p, c); } SEAM(0);
#ifdef PROBE_EXTRA_BARRIERS
    for (int xb_i = 0; xb_i < PROBE_EXTRA_BARRIERS; ++xb_i) xcd_barrier(bar, WID);
#endif
    if (IN(1)) REP(1) { const Ctx c = make_ctx(lds, WID); phase_mod_rows(c, p.in[I_X], p.in[I_CTX], MOD, 0, 1024, H); } SEAM(1);
    if (IN(2)) REP(2) {
        pg8::Gemm g{H, (const bf16*)(ws + WS_WIN0), NR, 1536, 1024}; pg8::StaticOrder S; S.init(NR, 1536, GRD, BID);
        EpiA0 E{ws};
        pg8::gemm_phase<EpiA0, pg8::StaticOrder, true, true>(ldsl, g, S, E, WID);
    } SEAM(2);
    if (IN(3)) { const Ctx c = make_ctx(lds, WID);
        if (PROBE_DRY_MASK & (1u << 3)) phase_gmlp(p, c, (bf16*)p.out);
        phase_gmlp(p, c, (bf16*)(ws + WS_UV));
        phase_kr(p, c);
        } SEAM(3);
    if (IN(4)) REP(4) {
#ifndef P4_SKIP_Q
        { pg8::Gemm g{(const bf16*)(ws + WS_CQ), (const bf16*)(ws + WS_WUQ), NR, 768, 256}; pg8::StaticOrder S; S.init(NR, 768, GRD, BID);
          EpiQ E{ws, (const float*)(ws + WS_RQ), R16};
          pg8::gemm_phase<EpiQ, pg8::StaticOrder, true, true>(ldsl, g, S, E, WID); }
#endif
        __syncthreads();
#ifndef P4_SKIP_KV
        { pg8::Gemm g{(const bf16*)(ws + WS_CKV), (const bf16*)(ws + WS_WUKV), NR, 1024, 128}; pg8::StaticOrder S; S.init(NR, 1024, GRD, GRD - 1 - BID);
          EpiKV E{ws, (const float*)(ws + WS_RKV), ctl + CW_KCH0};
          pg8::gemm_phase<EpiKV, pg8::StaticOrder, true, true>(ldsl, g, S, E, WID); }
#endif
    } SEAM(4);
    if (IN(5)) REP(5) { const Ctx c = make_ctx(lds, WID); phase_attn_mla(p, c); } SEAM(5);
    if (IN(6)) REP(6) {
        pg8::Gemm g{(const bf16*)(ws + WS_UV), (const bf16*)(ws + WS_WOUT0), NR, 1024, 1024}; pg8::StaticOrder S; S.init(NR, 1024, GRD, BID);
        EpiOut E{p.in[I_X], p.in[I_CTX], (bf16*)(ws + WS_T16_0), MOD + 2 * 1024};
        pg8::gemm_phase<EpiOut, pg8::StaticOrder, true, true>(ldsl, g, S, E, WID);
    } SEAM(6);
    if (IN(7)) { const Ctx c = make_ctx(lds, WID); phase_ln_router(c, (const bf16*)(ws + WS_T16_0), (bf16*)(ws + WS_X1), p.in[I_LNMG0], p.in[I_LNMB0], MOD, p.in[I_ROUTER0], ws + WS_H, (float*)(ws + WS_SX), (float*)(ws + WS_AFF), (float*)(ws + WS_AFFC), NR); } SEAM(7);
    if (IN(8)) REP(8) { const Ctx c = make_ctx(lds, WID); phase_topk(p, c, true); } SEAM2(8);
    if (IN(10)) REP(10) {
        pg8::Gemm g{(const bf16*)(ws + WS_H), (const bf16*)(ws + WS_WGU8_0), NE * ROWS_E, NE * 2048, 512}; GroupedOrder S{MT_E, 8, BID, GRD};
        EpiMoe1F8 E{ws + WS_HID, (const float*)(ws + WS_SX), (const int*)(ws + WS_ROWIDX), (const float*)(ws + WS_SW), 8};
        pg8::gemm_phase<EpiMoe1F8, GroupedOrder, true, true, true, true>(ldsl, g, S, E, WID, (const int*)(ws + WS_ROWIDX), GTBL_OFF);
    } SEAM(10);
    if (IN(11)) REP(11) {
        pg8::Gemm g{(const bf16*)(ws + WS_HID), (const bf16*)(ws + WS_WDN8_0), NE * ROWS_E, NE * 1024, 512}; GroupedOrder S{MT_E, 4, BID, GRD};
        EpiMoe2F8 E{(bf16*)(ws + WS_Y), (const float*)(ws + WS_ROWGATE), (const float*)(ws + WS_SW) + 2 * NE * 2048, 4};
        pg8::gemm_phase<EpiMoe2F8, GroupedOrder, true, true, true>(ldsl, g, S, E, WID);
    } SEAM(11);
    if (IN(12)) { const Ctx c = make_ctx(lds, WID);
        phase_combine_ln(c, (const bf16*)(ws + WS_X1), p.out, XC, (const bf16*)(ws + WS_Y), (const int*)(ws + WS_SLOTROW), p.in[I_LNFG0], p.in[I_LNFB0], MOD, MOD + 9 * 6144, H, NR); } SEAM(12);
    if (IN(13)) REP(13) {
        { pg8::Gemm g{H, (const bf16*)(ws + WS_WIN1), NL, 2048, 1024}; pg8::StaticOrder S; S.init(NL, 2048, GRD, BID);
          EpiA1 E{ws, R32, 0, 0, ctl + CW_KCH1};
          pg8::gemm_phase<EpiA1, pg8::StaticOrder, true, true>(ldsl, g, S, E, WID); }
        __syncthreads();
        { pg8::Gemm g{H, (const bf16*)(ws + WS_WIN1) + (size_t)2048 * 1024, NL, 1024, 1024}; pg8::StaticOrder S; S.init(NL, 1024, GRD, BID);
          EpiV1T E{ws, 0};
          pg8::gemm_phase<EpiV1T, pg8::StaticOrder, true, true>(ldsl, g, S, E, WID); }
        __syncthreads();
        { pg8::Gemm g{H + (size_t)NL * 1024, (const bf16*)(ws + WS_WIN1) + (size_t)1024 * 1024, NC, 1024, 1024}; pg8::StaticOrder S; S.init(NC, 1024, GRD, BID);
          EpiA1 E{ws, R32, NL, 1024, ctl + CW_KCH1};
          pg8::gemm_phase<EpiA1, pg8::StaticOrder, true, true>(ldsl, g, S, E, WID); }
        __syncthreads();
        { pg8::Gemm g{H + (size_t)NL * 1024, (const bf16*)(ws + WS_WIN1) + (size_t)2048 * 1024, NC, 1024, 1024}; pg8::StaticOrder S; S.init(NC, 1024, GRD, GRD - 1 - BID);
          EpiV1T E{ws, NL};
          pg8::gemm_phase<EpiV1T, pg8::StaticOrder, true, true>(ldsl, g, S, E, WID); }
    } SEAM(13);
    if (IN(14)) REP(14) { const Ctx c = make_ctx(lds, WID); phase_attn_diff(p, c); } SEAM(14);
    if (IN(15)) REP(15) {
        pg8::Gemm g{(const bf16*)(ws + WS_O1), (const bf16*)(ws + WS_WOUT1), NL, 1024, 1024}; pg8::StaticOrder S; S.init(NL, 1024, GRD, BID);
        EpiOut E{p.out, XC, (bf16*)(ws + WS_T16_1), MOD + 9 * 6144 + 2 * 1024};
        pg8::gemm_phase<EpiOut, pg8::StaticOrder, true, true>(ldsl, g, S, E, WID);
    } SEAM(15);
    if (IN(16)) { const Ctx c = make_ctx(lds, WID); phase_ln_router(c, (const bf16*)(ws + WS_T16_1), (bf16*)(ws + WS_X1), p.in[I_LNMG1], p.in[I_LNMB1], MOD + 9 * 6144, p.in[I_ROUTER1], ws + WS_H, (float*)(ws + WS_SX), (float*)(ws + WS_AFF), (float*)(ws + WS_AFFC), NL); } SEAM(16);
    if (IN(17)) REP(17) { const Ctx c = make_ctx(lds, WID); phase_topk(p, c, false); } SEAM2(17);
    if (IN(19)) REP(19) {
        pg8::Gemm g{(const bf16*)(ws + WS_H), (const bf16*)(ws + WS_WGU8_1), NE * ROWS_E, NE * 2048, 512}; GroupedOrder S{32, 8, BID, GRD};
        EpiMoe1F8 E{ws + WS_HID, (const float*)(ws + WS_SX), (const int*)(ws + WS_ROWIDX), (const float*)(ws + WS_SW) + NE * 2048, 8};
        pg8::gemm_phase<EpiMoe1F8, GroupedOrder, true, true, true, true>(ldsl, g, S, E, WID, (const int*)(ws + WS_ROWIDX), GTBL_OFF);
    } SEAM(19);
    if (IN(20)) REP(20) {
        pg8::Gemm g{(const bf16*)(ws + WS_HID), (const bf16*)(ws + WS_WDN8_1), NE * ROWS_E, NE * 1024, 512}; GroupedOrder S{32, 4, BID, GRD};
        EpiMoe2F8 E{(bf16*)(ws + WS_Y), (const float*)(ws + WS_ROWGATE), (const float*)(ws + WS_SW) + 2 * NE * 2048 + NE * 1024, 4};
        pg8::gemm_phase<EpiMoe2F8, GroupedOrder, true, true, true>(ldsl, g, S, E, WID);
    } SEAM(20);
    if (IN(21)) { const Ctx c = make_ctx(lds, WID);
        phase_combine_ln(c, (const bf16*)(ws + WS_X1), p.out, XC, (const bf16*)(ws + WS_Y), (const int*)(ws + WS_SLOTROW), p.in[I_LNFG1], p.in[I_LNFB1], MOD + 9 * 6144, nullptr, H, NL); }
#ifdef PH_PROF
    { const unsigned long long a_ = __builtin_amdgcn_s_memrealtime(); if ((PH_PROF_MASK >> 21) & 1u) ph_sel += a_ - ph_t;
      xcd_barrier(bar, WID);
      if (BID == PH_PROF_BLOCK) { float v1 = (float)ph_bar, v2 = (float)ph_sel;
        v1 = exp2f((rintf(log2f(fmaxf(v1, 1.f)) * 2.f + PH_PROF_SHIFT) - PH_PROF_SHIFT) * 0.5f); v2 = exp2f((rintf(log2f(fmaxf(v2, 1.f)) * 2.f + PH_PROF_SHIFT) - PH_PROF_SHIFT) * 0.5f);
        const int t = WID * 64 + (int)__builtin_amdgcn_mbcnt_hi(~0u, __builtin_amdgcn_mbcnt_lo(~0u, 0u));
        for (int i = 1 + t; i <= 10000; i += NTHR) p.out[i] = v2;
        if (t == 0) p.out[0] = 16.f * v1; } }
#endif
#ifdef ATT_PROF
    xcd_barrier(bar, WID);
    if (BID == 0) { const unsigned long long* dbg = (const unsigned long long*)(ws + WS_CTL + 512 * 1024);
        const int i1 = ATT_PROF_SEL1, i2 = ATT_PROF_SEL2;
        float v1 = (float)dbg[i1 & 15] / (float)dbg[(i1 & 8) + 4], v2 = (float)dbg[i2 & 15] / (float)dbg[(i2 & 8) + 4];
        if (i1 & 16) v1 = (float)(dbg[(i1 & 8)] + dbg[(i1 & 8) + 1] + dbg[(i1 & 8) + 2] + dbg[(i1 & 8) + 3]) / (float)dbg[(i1 & 8) + 4];
        if (i2 & 16) v2 = (float)(dbg[(i2 & 8)] + dbg[(i2 & 8) + 1] + dbg[(i2 & 8) + 2] + dbg[(i2 & 8) + 3]) / (float)dbg[(i2 & 8) + 4];
        v1 = exp2f((rintf(log2f(fmaxf(v1, 1.f)) * 4.f + ATT_PROF_SHIFT) - ATT_PROF_SHIFT) * 0.25f); v2 = exp2f((rintf(log2f(fmaxf(v2, 1.f)) * 4.f + ATT_PROF_SHIFT) - ATT_PROF_SHIFT) * 0.25f);
        const int t = WID * 64 + (int)__builtin_amdgcn_mbcnt_hi(~0u, __builtin_amdgcn_mbcnt_lo(~0u, 0u));
        for (int i = 1 + t; i <= 10000; i += NTHR) p.out[i] = v2;
        if (t == 0) p.out[0] = 16.f * v1; }
#endif
#undef IN
#undef SEAM
}

#ifndef N_LAUNCH_MODE
#define N_LAUNCH_MODE 0
#endif
extern "C" void kernel_launch(void* const* d_in, const int* in_sizes, int n_in, void* d_out, int out_size, void* d_ws, size_t ws_size, hipStream_t stream) {
    static int ok = 0;
    if (ok == 0) {
        if (n_in != 41 || in_sizes[0] != NL * DM || out_size != NL * DM || ws_size < WS_END) { fprintf(stderr, "kernel_launch: unexpected shapes: n_in %d in0 %d out %d ws %zu (need %zu)\n", n_in, n_in > 0 ? in_sizes[0] : -1, out_size, ws_size, (size_t)WS_END); ok = -1; return; }
        if (hipFuncSetAttribute((const void*)trunk_fwd, hipFuncAttributeMaxDynamicSharedMemorySize, LDS_BYTES) != hipSuccess) { fprintf(stderr, "kernel_launch: hipFuncSetAttribute failed\n"); ok = -1; return; }
        int per_cu = 0;
        if (hipOccupancyMaxActiveBlocksPerMultiprocessor(&per_cu, (const void*)trunk_fwd, NTHR, LDS_BYTES) != hipSuccess || per_cu < 1) fprintf(stderr, "kernel_launch: note: occupancy query reports %d\n", per_cu);
        (void)hipGetLastError();
        ok = 1;
    }
    if (ok < 0) return;
    (void)hipMemsetAsync((char*)d_ws + WS_CTL, 0, CTL_ZERO_BYTES, stream);
    Params p{};
    for (int i = 0; i < 41; ++i) p.in[i] = (const float*)d_in[i];
    p.out = (float*)d_out; p.ws = (unsigned char*)d_ws;
    const int grid = 256;
#if N_LAUNCH_MODE == 0
    p.ph_lo = 0; p.ph_hi = NPHASE;
    hipLaunchKernelGGL(trunk_fwd, dim3(grid), dim3(NTHR), LDS_BYTES, stream, p);
#else
    for (int k = 0; k < NPHASE; ++k) { p.ph_lo = k; p.ph_hi = k + 1; hipLaunchKernelGGL(trunk_fwd, dim3(grid), dim3(NTHR), LDS_BYTES, stream, p); }
#endif
    const hipError_t le = hipPeekAtLastError();
    if (le != hipSuccess) fprintf(stderr, "kernel_launch: launch failed: %s\n", hipGetErrorName(le));
}
```

```cpp
#include <hip/hip_runtime.h>
#include <cstdio>
#include <cstdint>

namespace pg8 {
#define PG8_LAS __attribute__((address_space(3)))
typedef unsigned short bf16_t;
typedef short bf16x8 __attribute__((ext_vector_type(8)));
typedef float f32x4 __attribute__((ext_vector_type(4)));
typedef unsigned u32x4 __attribute__((ext_vector_type(4)));
constexpr int BM = 256, BK = 64, HALF = 128, HTB = HALF * BK * 2  , STAGE_BYTES = 8 * HTB, NXCD = 8, WGM = 8;

__host__ __device__ __forceinline__ int lds_byte(int r, int c) { const int st = (r >> 4) * 2 + (c >> 5), rr = r & 15, cc = c & 31, ob = rr * 64 + cc * 2; return st * 1024 + (ob ^ (((ob >> 9) & 1) << 5)); }
__host__ __device__ __forceinline__ void stage_rc(int b, int& R, int& C) { const int st = b / 1024, sb = b % 1024, swz = sb ^ (((sb >> 9) & 1) << 5); R = (st >> 1) * 16 + swz / 64; C = (st & 1) * 32 + (swz % 64) / 2; }
__host__ __device__ __forceinline__ int perm32(int rho) { const int n = rho >> 4, i = rho & 15; return 8 * (i >> 2) + 4 * n + (i & 3); }

struct Unit { int pm, pn; };
struct Gemm { const bf16_t* A; const bf16_t* Bt; int M, N, K; };

struct StaticOrder {
    int nM, nN, nwg, G, c;
    __host__ __device__ void init(int M, int N, int G_, int c_) { nM = M / BM; nN = N / BM; nwg = nM * nN; G = G_; c = c_; }
    __host__ __device__ bool next(int i, Unit& u) const {
        const long L = (long)i * G + c; if (L >= nwg) return false;
        int wgid = (int)L; { const int q = nwg / NXCD, r = nwg % NXCD, xcd = wgid % NXCD, off = wgid / NXCD; wgid = (xcd < r ? xcd * (q + 1) : r * (q + 1) + (xcd - r) * q) + off; }
        const int nig = WGM * nN, gid = wgid / nig, fm = gid * WGM, gsz = (nM - fm) < WGM ? (nM - fm) : WGM;
        u.pm = fm + ((wgid % nig) % gsz); u.pn = (wgid % nig) / gsz; return true;
    }
    __device__ __forceinline__ void a_ready(const Unit&) const {}
    __device__ __forceinline__ void done(const Unit&) const {}
};

__device__ __forceinline__ unsigned cvt_pk_bf16(float lo, float hi) { unsigned r; asm volatile("v_cvt_pk_bf16_f32 %0, %1, %2" : "=v"(r) : "v"(lo), "v"(hi)); return r; }
typedef float f32x2 __attribute__((ext_vector_type(2)));
__device__ __forceinline__ f32x2 gelu_pk(f32x2 v) {
    const f32x2 av = __builtin_elementwise_abs(v), d = av * 0.2316418882f + 1.0f;
    f32x2 t; t.x = __builtin_amdgcn_rcpf(d.x); t.y = __builtin_amdgcn_rcpf(d.y);
    f32x2 q = t * 0.5307027145f + (-0.7265760135f); q = q * t + 0.7107068705f; q = q * t + (-0.142248368f); q = q * t + 0.127414796f; q = q * t;
    const f32x2 s = (v * v) * (-0.72134752044f);
    f32x2 e; e.x = __builtin_amdgcn_exp2f(s.x); e.y = __builtin_amdgcn_exp2f(s.y);
    const f32x2 m = v * (q * e), r = v - m;
    f32x2 o; o.x = v.x < 0.f ? m.x : r.x; o.y = v.y < 0.f ? m.y : r.y; return o;
}
typedef int v8i32 __attribute__((ext_vector_type(8)));
template <class Epi, class Sched, bool ALIGN_EPI = false, bool SP2 = false, bool FP8 = false, bool GATHER = false>
__device__ __forceinline__ void gemm_phase(PG8_LAS unsigned char* lds, const Gemm g, const Sched& S, const Epi& E, const int wid_in, const int* rowidx = nullptr, const int tbl_off = 0) {
    int lane_ = (int)__builtin_amdgcn_mbcnt_hi(~0u, __builtin_amdgcn_mbcnt_lo(~0u, 0u)); asm volatile("" : "+v"(lane_));
    const int wid = wid_in, lane = lane_, tid = wid * 64 + lane, wr = wid >> 2, wc = wid & 3, fr = lane & 15, fq = lane >> 4;
    int K_ = g.K; asm volatile("" : "+s"(K_)); const int K = K_, nt = K / BK;
    unsigned voffA[2], voffB[2];
#pragma unroll
    for (int i = 0; i < 2; ++i) { int R, C; stage_rc(tid * 16 + i * 8192, R, C); const int Rb = Epi::PERM ? ((R & ~31) + perm32(R & 31)) : R;
        voffA[i] = (unsigned)(R * K + C) * 2u; voffB[i] = (unsigned)(Rb * K + C) * 2u; }
    int gR[2], gC[2];
#pragma unroll
    for (int i = 0; i < 2; ++i) { int R, C; stage_rc(tid * 16 + i * 8192, R, C); gR[i] = R; gC[i] = C * 2; }
    const PG8_LAS int* gtbl = (const PG8_LAS int*)(lds + tbl_off);
    unsigned offC[2][2], offN[2][2];
#define PG8_GOFF(dst, ui_) do { _Pragma("unroll") for (int h_ = 0; h_ < 2; ++h_) _Pragma("unroll") for (int i_ = 0; i_ < 2; ++i_) \
        dst[h_][i_] = (unsigned)gtbl[(ui_) * 256 + h_ * 128 + gR[i_]] * (unsigned)(K * 2) + (unsigned)gC[i_]; } while (0)
    const size_t kstep = (size_t)(BK * 2);
    const size_t hstep = (size_t)HALF * K * 2;
    const size_t tstep = 2 * hstep;
    const unsigned ldsw = (unsigned)wid * 1024u;
    const int aoff = lds_byte(wr * 64 + fr, fq * 8), boff = lds_byte(wc * 32 + fr, fq * 8);
#define PG8_SA(b, h) (((b) * 2 + (h)) * HTB)
#define PG8_SB(b, h) ((4 + (b) * 2 + (h)) * HTB)
#define PG8_STAGE(bufoff, gbase, voff) do { _Pragma("unroll") for (int _i = 0; _i < 2; ++_i) \
        __builtin_amdgcn_global_load_lds((const unsigned*)((const char*)(gbase) + (voff)[_i]), (PG8_LAS unsigned*)(lds + (bufoff) + ldsw + _i * 8192), 16, 0, 0); } while (0)
#define PG8_STAGE_A(bufoff, kk, h, nx) do { if constexpr (GATHER) { const unsigned sel_[2] = {(nx) ? offN[h][0] : offC[h][0], (nx) ? offN[h][1] : offC[h][1]}; PG8_STAGE(bufoff, (const char*)g.A + (size_t)(kk) * kstep, sel_); } \
        else { PG8_STAGE(bufoff, ((nx) ? nA : cA) + (size_t)(kk) * kstep + (size_t)(h) * hstep, voffA); } } while (0)
#define PG8_LD16(off) (*(const PG8_LAS u32x4*)(lds + (off)))
#define PG8_V8(l0, l1) ((v8i32){(int)(l0).x, (int)(l0).y, (int)(l0).z, (int)(l0).w, (int)(l1).x, (int)(l1).y, (int)(l1).z, (int)(l1).w})
#define PG8_LDA(dst, b, h) do { _Pragma("unroll") for (int m = 0; m < 4; ++m) { const u32x4 l0_ = PG8_LD16(PG8_SA(b, h) + aoff + m * 2048), l1_ = PG8_LD16(PG8_SA(b, h) + aoff + m * 2048 + 1024); \
        if constexpr (FP8) dst##8[m] = PG8_V8(l0_, l1_); else { dst[m][0] = __builtin_bit_cast(bf16x8, l0_); dst[m][1] = __builtin_bit_cast(bf16x8, l1_); } } } while (0)
#define PG8_LDB(dst, b, h) do { _Pragma("unroll") for (int n = 0; n < 2; ++n) { const u32x4 l0_ = PG8_LD16(PG8_SB(b, h) + boff + n * 2048), l1_ = PG8_LD16(PG8_SB(b, h) + boff + n * 2048 + 1024); \
        if constexpr (FP8) dst##8[n] = PG8_V8(l0_, l1_); else { dst[n][0] = __builtin_bit_cast(bf16x8, l0_); dst[n][1] = __builtin_bit_cast(bf16x8, l1_); } } } while (0)
#define PG8_MMA(ai, bj, At, Bt) do { __builtin_amdgcn_s_setprio(1); _Pragma("unroll") for (int m = 0; m < 4; ++m) _Pragma("unroll") for (int n = 0; n < 2; ++n) { \
        if constexpr (FP8) asm volatile("v_mfma_scale_f32_16x16x128_f8f6f4 %0, %1, %2, %0, %3, %3 op_sel_hi:[0,0,0]" : "+v"(acc[ai][bj][m][n]) : "v"(Bt##8[n]), "v"(At##8[m]), "v"(one_scale));   \
        else { _Pragma("unroll") for (int k = 0; k < 2; ++k) acc[ai][bj][m][n] = __builtin_amdgcn_mfma_f32_16x16x32_bf16(Bt[n][k], At[m][k], acc[ai][bj][m][n], 0, 0, 0); } } \
        __builtin_amdgcn_s_setprio(0); } while (0)
#define PG8_WAIT_V(n) asm volatile("s_waitcnt vmcnt(" #n ")" ::: "memory")
#define PG8_WAIT_L(n) asm volatile("s_waitcnt lgkmcnt(" #n ")" ::: "memory")
#define PG8_BAR __builtin_amdgcn_s_barrier()
#define PG8_SCHED __builtin_amdgcn_sched_barrier(0)
    Unit cur, nxt; int ui = 0;
    if (!S.next(0, cur)) return;
    f32x4 acc[2][2][4][2];
#pragma unroll
    for (int a = 0; a < 2; ++a)
#pragma unroll
        for (int b = 0; b < 2; ++b)
#pragma unroll
            for (int m = 0; m < 4; ++m)
#pragma unroll
                for (int n = 0; n < 2; ++n) acc[a][b][m][n] = (f32x4){0.f, 0.f, 0.f, 0.f};
    const int one_scale = 0x7f7f7f7f;
    bf16x8 At[4][2], B0[2][2], B1[2][2]; v8i32 At8[4], B08[2], B18[2];
    const char* cA = (const char*)g.A + (size_t)cur.pm * tstep; const char* cB = (const char*)g.Bt + (size_t)cur.pn * tstep;
    const char* nA = cA;
    if constexpr (GATHER) { Unit tu; for (int i = 0; S.next(i, tu); ++i) if (tid < 256) ((PG8_LAS int*)(lds + tbl_off))[i * 256 + tid] = rowidx[tu.pm * 256 + tid];
        asm volatile("s_waitcnt vmcnt(0) lgkmcnt(0)" ::: "memory"); PG8_BAR; PG8_GOFF(offC, 0); PG8_GOFF(offN, 0); }
    S.a_ready(cur);
    if constexpr (SP2) {
        PG8_STAGE(PG8_SB(0, 0), cB, voffB); PG8_STAGE(PG8_SB(0, 1), cB + hstep, voffB); PG8_STAGE_A(PG8_SA(0, 0), 0, 0, false); PG8_STAGE_A(PG8_SA(0, 1), 0, 1, false);
        if (wr == 1) PG8_BAR;
        PG8_WAIT_V(2); PG8_BAR;
        PG8_STAGE(PG8_SB(1, 0), cB + kstep, voffB); PG8_STAGE_A(PG8_SA(1, 0), 1, 0, false); PG8_STAGE(PG8_SB(1, 1), cB + hstep + kstep, voffB);
        PG8_WAIT_V(6); PG8_BAR;
    } else {
        PG8_STAGE(PG8_SB(0, 0), cB, voffB); PG8_STAGE_A(PG8_SA(0, 0), 0, 0, false); PG8_STAGE(PG8_SB(0, 1), cB + hstep, voffB); PG8_STAGE_A(PG8_SA(0, 1), 0, 1, false);
        if (wr == 1) PG8_BAR;
        PG8_WAIT_V(4); PG8_BAR;
        PG8_STAGE(PG8_SB(1, 0), cB + kstep, voffB); PG8_STAGE_A(PG8_SA(1, 0), 1, 0, false); PG8_STAGE(PG8_SB(1, 1), cB + hstep + kstep, voffB);
        PG8_WAIT_V(6); PG8_BAR;
    }
    for (;;) {
        const bool has_next = S.next(ui + 1, nxt);
        nA = has_next ? (const char*)g.A + (size_t)nxt.pm * tstep : cA; const char* nB = has_next ? (const char*)g.Bt + (size_t)nxt.pn * tstep : cB;
        if constexpr (GATHER) { if (has_next) PG8_GOFF(offN, ui + 1); }
        for (int t = 0; t < nt; t += 2) {
            const bool last = (t == nt - 2);
            const char* b2 = last ? nB : cB + (size_t)(t + 2) * kstep; const char* b3 = b2 + kstep;
            const int k2 = last ? 0 : t + 2, k3 = k2 + 1;
            if (last && has_next) S.a_ready(nxt);
            if constexpr (SP2) {
            PG8_LDB(B0, 0, 0); PG8_LDB(B1, 0, 1); PG8_SCHED; PG8_LDA(At, 0, 0); PG8_STAGE_A(PG8_SA(1, 1), t + 1, 1, false);
            PG8_WAIT_V(8); PG8_WAIT_L(0); PG8_BAR; PG8_MMA(0, 0, At, B0); PG8_MMA(0, 1, At, B1); PG8_BAR; PG8_SCHED;
            PG8_LDA(At, 0, 1); PG8_STAGE(PG8_SB(0, 0), b2, voffB); PG8_STAGE(PG8_SB(0, 1), b2 + hstep, voffB); PG8_STAGE_A(PG8_SA(0, 0), k2, 0, last);
            PG8_WAIT_V(8); PG8_WAIT_L(0); PG8_BAR; PG8_MMA(1, 0, At, B0); PG8_MMA(1, 1, At, B1); PG8_BAR; PG8_SCHED;
            PG8_LDB(B0, 1, 0); PG8_LDB(B1, 1, 1); PG8_SCHED; PG8_LDA(At, 1, 0); PG8_STAGE_A(PG8_SA(0, 1), k2, 1, last);
            PG8_WAIT_V(8); PG8_WAIT_L(0); PG8_BAR; PG8_MMA(0, 0, At, B0); PG8_MMA(0, 1, At, B1); PG8_BAR; PG8_SCHED;
            PG8_LDA(At, 1, 1); PG8_STAGE(PG8_SB(1, 0), b3, voffB); PG8_STAGE(PG8_SB(1, 1), b3 + hstep, voffB); PG8_STAGE_A(PG8_SA(1, 0), k3, 0, last);
            PG8_WAIT_V(8); PG8_WAIT_L(0); PG8_BAR; PG8_MMA(1, 0, At, B0); PG8_MMA(1, 1, At, B1); PG8_BAR; PG8_SCHED;
            } else {
            PG8_LDB(B0, 0, 0); PG8_SCHED; PG8_LDA(At, 0, 0); PG8_STAGE_A(PG8_SA(1, 1), t + 1, 1, false);
            PG8_WAIT_L(8); PG8_BAR; PG8_WAIT_L(0); PG8_MMA(0, 0, At, B0); PG8_BAR; PG8_SCHED;
            PG8_LDB(B1, 0, 1); PG8_STAGE(PG8_SB(0, 0), b2, voffB);
            PG8_BAR; PG8_WAIT_L(0); PG8_MMA(0, 1, At, B1); PG8_BAR;
            PG8_LDA(At, 0, 1); PG8_STAGE_A(PG8_SA(0, 0), k2, 0, last);
            PG8_BAR; PG8_WAIT_L(0); PG8_MMA(1, 0, At, B0); PG8_BAR; PG8_SCHED;
            PG8_STAGE(PG8_SB(0, 1), b2 + hstep, voffB);
            PG8_WAIT_V(6); PG8_BAR; PG8_MMA(1, 1, At, B1); PG8_BAR;
            PG8_LDB(B0, 1, 0); PG8_SCHED; PG8_LDA(At, 1, 0); PG8_STAGE_A(PG8_SA(0, 1), k2, 1, last);
            PG8_WAIT_L(8); PG8_BAR; PG8_WAIT_L(0); PG8_MMA(0, 0, At, B0); PG8_BAR; PG8_SCHED;
            PG8_LDB(B1, 1, 1); PG8_STAGE(PG8_SB(1, 0), b3, voffB);
            PG8_BAR; PG8_WAIT_L(0); PG8_MMA(0, 1, At, B1); PG8_BAR;
            PG8_LDA(At, 1, 1); PG8_STAGE_A(PG8_SA(1, 0), k3, 0, last);
            PG8_BAR; PG8_WAIT_L(0); PG8_MMA(1, 0, At, B0); PG8_BAR; PG8_SCHED;
            PG8_STAGE(PG8_SB(1, 1), b3 + hstep, voffB);
            PG8_WAIT_V(6); PG8_BAR; PG8_MMA(1, 1, At, B1); PG8_BAR;
            }
        }
        if constexpr (ALIGN_EPI) { if (wr == 0) PG8_BAR; }
        if constexpr (!Epi::AFTER_DRAIN) { E(acc, cur, wr, wc, fr, fq); S.done(cur); }
        if (!has_next) break;
#pragma unroll
        for (int a = 0; a < 2; ++a)
#pragma unroll
            for (int b = 0; b < 2; ++b)
#pragma unroll
                for (int m = 0; m < 4; ++m)
#pragma unroll
                    for (int n = 0; n < 2; ++n) acc[a][b][m][n] = (f32x4){0.f, 0.f, 0.f, 0.f};
        cur = nxt; cA = nA; cB = nB; ++ui;
        if constexpr (GATHER) { _Pragma("unroll") for (int h_ = 0; h_ < 2; ++h_) _Pragma("unroll") for (int i_ = 0; i_ < 2; ++i_) offC[h_][i_] = offN[h_][i_]; }
        if constexpr (ALIGN_EPI) { if (wr == 1) PG8_BAR; }
    }
    PG8_WAIT_V(0);
    if constexpr (!ALIGN_EPI) { if (wr == 0) PG8_BAR; }
    PG8_BAR;
    if constexpr (Epi::AFTER_DRAIN) { E.fused(acc, cur, wr, wc, fr, fq, lds, wid, lane); S.done(cur); }
#undef PG8_SA
#undef PG8_SB
#undef PG8_STAGE
#undef PG8_LDA
#undef PG8_LDB
#undef PG8_MMA
#undef PG8_STAGE_A
#undef PG8_GOFF
#undef PG8_LD16
#undef PG8_V8
#undef PG8_WAIT_V
#undef PG8_WAIT_L
#undef PG8_BAR
#undef PG8_SCHED
}
}
namespace att {
typedef unsigned short bf16_t;
using bf16x8 = __attribute__((ext_vector_type(8))) short;
using s16x4  = __attribute__((ext_vector_type(4))) short;
using f32x16 = __attribute__((ext_vector_type(16))) float;
using u32x4  = __attribute__((ext_vector_type(4))) unsigned;
#define SBAR() __builtin_amdgcn_sched_barrier(0)
#ifndef ATT_MPRIO
#define ATT_MPRIO 0
#define ATT_VPRIO 0
#endif
#define ADI __device__ __forceinline__
ADI int crow(int r, int hi) { return (r & 3) + 8 * (r >> 2) + 4 * hi; }
ADI unsigned cvtpk(float lo, float hi) { unsigned r; asm volatile("v_cvt_pk_bf16_f32 %0, %1, %2" : "=v"(r) : "v"(lo), "v"(hi)); return r; }
ADI bf16x8 ld8(const bf16_t* p) { return *reinterpret_cast<const bf16x8*>(p); }

constexpr float THRL = 60.f;
template <bool FIRST, int MODE = 1>
ADI void softmax_tile(f32x16& p0, f32x16& p1, float& mhat, f32x16& negm, float& l_reg, float& alpha, bf16x8& pa0, bf16x8& pa1, bf16x8& pa2, bf16x8& pa3, const bool chk = true) {
  alpha = 1.f;
  if ((FIRST || MODE != 0) && (FIRST || MODE == 1 || chk)) {
    float pmax = p0[0];
#pragma unroll
    for (int r = 1; r < 16; ++r) pmax = fmaxf(pmax, p0[r]);
#pragma unroll
    for (int r = 0; r < 16; ++r) pmax = fmaxf(pmax, p1[r]);
    { auto rr = __builtin_amdgcn_permlane32_swap(__float_as_uint(pmax), __float_as_uint(pmax), false, false);
      pmax = fmaxf(__uint_as_float(rr[0]), __uint_as_float(rr[1])); }
    if (FIRST || __builtin_expect(__any(pmax > THRL), 0)) {
      const float dl = FIRST ? pmax : fmaxf(pmax, 0.f);
      mhat += dl; alpha = FIRST ? 1.f : __builtin_amdgcn_exp2f(-dl);
#pragma unroll
      for (int r = 0; r < 16; ++r) { p0[r] -= dl; p1[r] -= dl; }
#pragma unroll
      for (int r = 0; r < 16; ++r) negm[r] = -mhat;
    }
  }
#pragma unroll
  for (int r = 0; r < 16; ++r) p0[r] = __builtin_amdgcn_exp2f(p0[r]);
#pragma unroll
  for (int r = 0; r < 16; ++r) p1[r] = __builtin_amdgcn_exp2f(p1[r]);
  float ps = 0;
#pragma unroll
  for (int r = 0; r < 16; ++r) ps += p0[r];
#pragma unroll
  for (int r = 0; r < 16; ++r) ps += p1[r];
  { auto rr = __builtin_amdgcn_permlane32_swap(__float_as_uint(ps), __float_as_uint(ps), false, false);
    ps = __uint_as_float(rr[0]) + __uint_as_float(rr[1]); }
  if constexpr (FIRST || MODE != 0) l_reg = l_reg * alpha + ps; else l_reg += ps;
#define PK8(P, BASE, OUT) do { u32x4 w = {cvtpk(P[BASE + 0], P[BASE + 1]), cvtpk(P[BASE + 2], P[BASE + 3]), cvtpk(P[BASE + 4], P[BASE + 5]), cvtpk(P[BASE + 6], P[BASE + 7])}; OUT = *reinterpret_cast<bf16x8*>(&w); } while (0)
  PK8(p0, 0, pa0); PK8(p0, 8, pa1); PK8(p1, 0, pa2); PK8(p1, 8, pa3);
#undef PK8
}
template <int KPITCH> ADI int kswz(int r) { return KPITCH == 256 ? (((r & 7) | (((r >> 4) & 1) << 3)) << 4) : (((r >> 1) & 7) << 4); }
template <int NKS, int KPITCH>
ADI void qkt(f32x16& p0, f32x16& p1, const char* Ks, const bf16x8* qr, const f32x16& negm, int r32, int hi) {
  const int sw = kswz<KPITCH>(r32);
#pragma unroll
  for (int d0 = 0; d0 < NKS; d0 += 2) {
    const int cb0 = ((d0 * 16 + hi * 8) * 2) ^ sw, cb1 = (((d0 + 1) * 16 + hi * 8) * 2) ^ sw;
    const bf16x8 a0 = *reinterpret_cast<const bf16x8*>(Ks + r32 * KPITCH + cb0), a1 = *reinterpret_cast<const bf16x8*>(Ks + (32 + r32) * KPITCH + cb0);
    const bf16x8 c0 = *reinterpret_cast<const bf16x8*>(Ks + r32 * KPITCH + cb1), c1 = *reinterpret_cast<const bf16x8*>(Ks + (32 + r32) * KPITCH + cb1);
    if (d0 == 0) { p0 = __builtin_amdgcn_mfma_f32_32x32x16_bf16(a0, qr[0], negm, 0, 0, 0); p1 = __builtin_amdgcn_mfma_f32_32x32x16_bf16(a1, qr[0], negm, 0, 0, 0); }
    else { p0 = __builtin_amdgcn_mfma_f32_32x32x16_bf16(a0, qr[d0], p0, 0, 0, 0); p1 = __builtin_amdgcn_mfma_f32_32x32x16_bf16(a1, qr[d0], p1, 0, 0, 0); }
    p0 = __builtin_amdgcn_mfma_f32_32x32x16_bf16(c0, qr[d0 + 1], p0, 0, 0, 0); p1 = __builtin_amdgcn_mfma_f32_32x32x16_bf16(c1, qr[d0 + 1], p1, 0, 0, 0);
    SBAR();
  }
}
template <int NDB> struct VTF { bf16x8 a[NDB]; };
template <int S, int NDB> ADI void vt_load(VTF<NDB>& f, const char* Vb, int r32, int hi) {
  const int off = r32 * 128 + (((2 * S + hi) * 16) ^ kswz<128>(r32));
#pragma unroll
  for (int d = 0; d < NDB; ++d) f.a[d] = *reinterpret_cast<const bf16x8*>(Vb + d * 4096 + off);
}
template <int NDB> ADI void vt_mma(f32x16* o, const VTF<NDB>& f, bf16x8 pb) {
#pragma unroll
  for (int d = 0; d < NDB; ++d) o[d] = __builtin_amdgcn_mfma_f32_32x32x16_bf16(f.a[d], pb, o[d], 0, 0, 0);
}
template <int NDB> ADI void pvT(f32x16* o, const char* Vb, bf16x8 pb0, bf16x8 pb1, bf16x8 pb2, bf16x8 pb3, int r32, int hi) {
  VTF<NDB> fA, fB;
  SBAR(); vt_load<0, NDB>(fA, Vb, r32, hi); vt_load<1, NDB>(fB, Vb, r32, hi); SBAR();
  vt_mma<NDB>(o, fA, pb0); SBAR(); vt_load<2, NDB>(fA, Vb, r32, hi); SBAR();
  vt_mma<NDB>(o, fB, pb1); SBAR(); vt_load<3, NDB>(fB, Vb, r32, hi); SBAR();
  vt_mma<NDB>(o, fA, pb2); SBAR(); vt_mma<NDB>(o, fB, pb3); SBAR();
}

using i32x8 = __attribute__((ext_vector_type(8))) int;
constexpr float VSC8 = 16.f;
constexpr float OFF8 = 4.f;
constexpr float THR8 = 8.f, SUM8 = 448.f;
ADI void mfma8(f32x16& acc, const i32x8& a, const i32x8& b) {
  asm volatile("v_mfma_f32_32x32x64_f8f6f4 %0, %1, %2, %0" : "+v"(acc) : "v"(a), "v"(b));
}
constexpr float QS8 = 4.f, KS8 = 0.25f;
ADI void mfma8_c(f32x16& dst, const i32x8& a, const i32x8& b, const f32x16& c) {
  asm volatile("v_mfma_f32_32x32x64_f8f6f4 %0, %1, %2, %3" : "=&v"(dst) : "v"(a), "v"(b), "v"(c));
}
template <int RB> ADI int kswz8(int r) { return RB == 64 ? (((r >> 2) & 3) << 4) : (((r >> 1) & 7) << 4); }
template <int KB8>
ADI void qkt8(f32x16& p0, f32x16& p1, const char* Ks, const i32x8* q8, const f32x16& negm, int r32, int hi) {
  constexpr int RB = 64 * KB8;
  const int sw = kswz8<RB>(r32);
  u32x4 lo[2][KB8], hh[2][KB8];
  SBAR();
#pragma unroll
  for (int ks = 0; ks < KB8; ++ks)
#pragma unroll
    for (int t = 0; t < 2; ++t) { const char* rowp = Ks + (32 * t + r32) * RB;
      lo[t][ks] = *reinterpret_cast<const u32x4*>(rowp + ((ks * 64 + hi * 32) ^ sw)); hh[t][ks] = *reinterpret_cast<const u32x4*>(rowp + ((ks * 64 + hi * 32 + 16) ^ sw)); }
  SBAR();
#pragma unroll
  for (int ks = 0; ks < KB8; ++ks) {
    const i32x8 a0 = {(int)lo[0][ks][0], (int)lo[0][ks][1], (int)lo[0][ks][2], (int)lo[0][ks][3], (int)hh[0][ks][0], (int)hh[0][ks][1], (int)hh[0][ks][2], (int)hh[0][ks][3]};
    const i32x8 a1 = {(int)lo[1][ks][0], (int)lo[1][ks][1], (int)lo[1][ks][2], (int)lo[1][ks][3], (int)hh[1][ks][0], (int)hh[1][ks][1], (int)hh[1][ks][2], (int)hh[1][ks][3]};
    if (ks == 0) { mfma8_c(p0, a0, q8[0], negm); mfma8_c(p1, a1, q8[0], negm); }
    else { mfma8(p0, a0, q8[ks]); mfma8(p1, a1, q8[ks]); }
  }
  SBAR();
}
template <int NDB> ADI void pvT8(f32x16* o, const char* Vb, const i32x8& pb, int r32, int hi) {
  const int g = (r32 >> 2) & 3;
  const int off0 = r32 * 64 + (((2 * hi) ^ g) << 4), off1 = r32 * 64 + (((2 * hi + 1) ^ g) << 4);
  u32x4 lo[NDB], hh[NDB];
  SBAR();
#pragma unroll
  for (int d = 0; d < NDB; ++d) { lo[d] = *reinterpret_cast<const u32x4*>(Vb + d * 2048 + off0); hh[d] = *reinterpret_cast<const u32x4*>(Vb + d * 2048 + off1); }
  SBAR();
#pragma unroll
  for (int d = 0; d < NDB; ++d) { const i32x8 a = {(int)lo[d][0], (int)lo[d][1], (int)lo[d][2], (int)lo[d][3], (int)hh[d][0], (int)hh[d][1], (int)hh[d][2], (int)hh[d][3]}; mfma8(o[d], a, pb); }
  SBAR();
}
template <bool FIRST>
ADI void softmax_tile8(f32x16& p0, f32x16& p1, float& mhat, f32x16& negm, float& l_reg, float& alpha, i32x8& pb, const bool chk) {
  alpha = 1.f;
  if (FIRST || chk) {
    float pmax = p0[0];
#pragma unroll
    for (int r = 1; r < 16; ++r) pmax = fmaxf(pmax, p0[r]);
#pragma unroll
    for (int r = 0; r < 16; ++r) pmax = fmaxf(pmax, p1[r]);
    { auto rr = __builtin_amdgcn_permlane32_swap(__float_as_uint(pmax), __float_as_uint(pmax), false, false);
      pmax = fmaxf(__uint_as_float(rr[0]), __uint_as_float(rr[1])); }
    if (FIRST || __builtin_expect(__any(pmax > THR8), 0)) {
      const float dl = FIRST ? pmax - OFF8 : (pmax > THR8 ? pmax - OFF8 : 0.f);
      mhat += dl; alpha = FIRST ? 1.f : __builtin_amdgcn_exp2f(-dl);
#pragma unroll
      for (int r = 0; r < 16; ++r) { p0[r] -= dl; p1[r] -= dl; }
#pragma unroll
      for (int r = 0; r < 16; ++r) negm[r] = -mhat;
    }
  }
#pragma unroll
  for (int r = 0; r < 16; ++r) p0[r] = __builtin_amdgcn_exp2f(p0[r]);
#pragma unroll
  for (int r = 0; r < 16; ++r) p1[r] = __builtin_amdgcn_exp2f(p1[r]);
  float ps = 0;
#pragma unroll
  for (int r = 0; r < 16; ++r) ps += p0[r];
#pragma unroll
  for (int r = 0; r < 16; ++r) ps += p1[r];
  float hmax;
  { auto rr = __builtin_amdgcn_permlane32_swap(__float_as_uint(ps), __float_as_uint(ps), false, false);
    const float h0 = __uint_as_float(rr[0]), h1 = __uint_as_float(rr[1]); ps = h0 + h1; hmax = fmaxf(h0, h1); }
  if (!FIRST && !chk) {
    if (__builtin_expect(__any(hmax > SUM8), 0)) {
      const float dl = hmax > SUM8 ? ceilf(__builtin_amdgcn_logf(hmax)) - 6.f : 0.f;
      const float f = __builtin_amdgcn_exp2f(-dl);
      mhat += dl; alpha = f; ps *= f;
#pragma unroll
      for (int r = 0; r < 16; ++r) { p0[r] *= f; p1[r] *= f; }
#pragma unroll
      for (int r = 0; r < 16; ++r) negm[r] = -mhat;
    }
  }
  l_reg = l_reg * alpha + ps;
#pragma unroll
  for (int i = 0; i < 4; ++i) { int w = __builtin_amdgcn_cvt_pk_fp8_f32(p0[4 * i], p0[4 * i + 1], 0, false); pb[i] = __builtin_amdgcn_cvt_pk_fp8_f32(p0[4 * i + 2], p0[4 * i + 3], w, true); }
#pragma unroll
  for (int i = 0; i < 4; ++i) { int w = __builtin_amdgcn_cvt_pk_fp8_f32(p1[4 * i], p1[4 * i + 1], 0, false); pb[4 + i] = __builtin_amdgcn_cvt_pk_fp8_f32(p1[4 * i + 2], p1[4 * i + 3], w, true); }
}

template <int DQK, int DV, int RING = 3, bool PV8 = false, bool QK8 = false> struct Cfg {
  static constexpr int KB8 = (DQK + 63) / 64, KPITCH = QK8 ? 64 * KB8 : (DQK <= 64) ? 128 : 256, SHM_K = 64 * KPITCH, SHM_V = PV8 ? 64 * DV : 64 * DV * 2, NDB = DV / 32, NKS = DQK / 16;
  static constexpr int NBUF = RING;
  static constexpr int WS_OFF = NBUF * (SHM_V + SHM_K);
  static constexpr int STASH_OFF = WS_OFF + 8 * 64 * 4;
};

template <int DQK, int DV, int RING = 3, bool SPEC = false, bool PV8 = false, bool QK8 = false>
ADI void attn_core(const bf16_t* __restrict__ Qb, const bf16_t* __restrict__ Kh, const bf16_t* __restrict__ Vt, const int vpitch, int seq, char* lds,
                   f32x16 (&o)[DV / 32], float& l_reg, const int wid, const float kmax2, unsigned long long* prof = nullptr) {
  using CF = Cfg<DQK, DV, RING, PV8, QK8>;
  constexpr int KB8 = CF::KB8;
  constexpr int KPITCH = CF::KPITCH, SHM_K = CF::SHM_K, SHM_V = CF::SHM_V, NDB = CF::NDB, NKS = CF::NKS;
  int lane_ = (int)__builtin_amdgcn_mbcnt_hi(~0u, __builtin_amdgcn_mbcnt_lo(~0u, 0u)); asm volatile("" : "+v"(lane_));
  const int lane = lane_, tid = wid * 64 + lane, r32 = lane & 31, hi = lane >> 5;
  const int grp = wid >> 2;
  char* K_lds = lds; char* V_lds = lds + RING * SHM_K;
  float mhat = 0.f; l_reg = 0.f; f32x16 negm = f32x16{};
#pragma unroll
  for (int d = 0; d < NDB; ++d) o[d] = f32x16{};
  bf16x8 qr[NKS]; i32x8 q8[KB8];
  float bnd;
  if constexpr (QK8) {
    const char* Qw8 = (const char*)Qb + (size_t)(wid * 32 + r32) * (64 * KB8) + hi * 32;
    float qn2 = 0.f;
#pragma unroll
    for (int ks = 0; ks < KB8; ++ks) { const u32x4 a = *reinterpret_cast<const u32x4*>(Qw8 + ks * 64), b = *reinterpret_cast<const u32x4*>(Qw8 + ks * 64 + 16);
      q8[ks] = i32x8{(int)a[0], (int)a[1], (int)a[2], (int)a[3], (int)b[0], (int)b[1], (int)b[2], (int)b[3]};
#pragma unroll
      for (int j = 0; j < 8; ++j) { const auto x = __builtin_amdgcn_cvt_pk_f32_fp8(q8[ks][j], false), y = __builtin_amdgcn_cvt_pk_f32_fp8(q8[ks][j], true); qn2 += (x[0] * x[0] + x[1] * x[1]) + (y[0] * y[0] + y[1] * y[1]); } }
    auto rr = __builtin_amdgcn_permlane32_swap(__float_as_uint(qn2), __float_as_uint(qn2), false, false);
    qn2 = __uint_as_float(rr[0]) + __uint_as_float(rr[1]);
    bnd = sqrtf(qn2 * kmax2) * (1.07f / QS8);
  } else {
  const bf16_t* Qw = Qb + (long)(wid * 32 + r32) * DQK + hi * 8;
#pragma unroll
  for (int d0 = 0; d0 < NKS; ++d0) qr[d0] = ld8(Qw + d0 * 16);
  { float qn2 = 0.f;
#pragma unroll
    for (int d0 = 0; d0 < NKS; ++d0) {
#pragma unroll
      for (int j = 0; j < 8; ++j) { const float x = __uint_as_float(((unsigned)(unsigned short)qr[d0][j]) << 16); qn2 += x * x; } }
    auto rr = __builtin_amdgcn_permlane32_swap(__float_as_uint(qn2), __float_as_uint(qn2), false, false);
    qn2 = __uint_as_float(rr[0]) + __uint_as_float(rr[1]);
    bnd = sqrtf(qn2 * kmax2) * 1.02f; }
  }
  constexpr int KCH = DQK / 8, TPRK = (KCH <= 8) ? 8 : 16, NKL = (TPRK == 8) ? 1 : 2, KRPP = 512 / TPRK;
  constexpr int NVL = DV / 64;
  static_assert(DV == 64 || DV == 128, "DV is 64 or 128");
  constexpr int CPR8 = 4 * KB8;
  const int krow = QK8 ? tid / CPR8 : tid / TPRK, kch = QK8 ? tid % CPR8 : tid % TPRK; const bool kvalid = QK8 ? (krow < 64) : (kch < KCH);
  const int vrow = PV8 ? (tid >> 2) : (tid >> 3), vch = PV8 ? (tid & 3) : (tid & 7);
  const bool vvalid = !PV8 || DV == 128 || tid < 256;
  struct { bf16x8 k0, k1, v0, v1; } sr_[2];
  const unsigned koff = QK8 ? (unsigned)(krow * (64 * KB8) + kch * 16) : (unsigned)(krow * DQK + kch * 8) * 2u, voff = PV8 ? (unsigned)(vrow * vpitch + vch * 16) : (unsigned)(vrow * vpitch + vch * 8) * 2u;
  const int kst0 = QK8 ? (krow * KPITCH + ((kch * 16) ^ kswz8<64 * KB8>(krow))) : (krow * KPITCH + ((kch * 16) ^ kswz<KPITCH>(krow))), kst1 = (krow + KRPP) * KPITCH + ((kch * 16) ^ kswz<KPITCH>(krow + KRPP));
  const int vst0 = PV8 ? (vrow * 64 + ((vch ^ ((vrow >> 2) & 3)) << 4)) : (vrow * 128 + ((vch * 16) ^ kswz<128>(vrow))), vst1 = vst0 + 64 * 128;
#define LD8B(base, off) (*reinterpret_cast<const bf16x8*>((const char*)(base) + (off)))
#define SLOAD(i, kk0) do { const char* kp_ = (const char*)Kh + (size_t)(kk0) * (QK8 ? 64 * KB8 : DQK * 2); const char* vp_ = (const char*)Vt + (size_t)(kk0) * (PV8 ? 1 : 2); \
    if (kvalid) { sr_[i].k0 = LD8B(kp_, koff); if constexpr (NKL == 2 && !QK8) sr_[i].k1 = LD8B(kp_ + KRPP * DQK * 2, koff); } \
    if constexpr (PV8) { if (vvalid) sr_[i].v0 = LD8B(vp_, voff); } else { sr_[i].v0 = LD8B(vp_, voff); if constexpr (NVL == 2) sr_[i].v1 = LD8B(vp_ + (size_t)64 * vpitch * 2, voff); } } while (0)
#define SWRITE(b, i) do { \
    if (kvalid) { *(bf16x8*)(K_lds + (b) * SHM_K + kst0) = sr_[i].k0; if constexpr (NKL == 2 && !QK8) *(bf16x8*)(K_lds + (b) * SHM_K + kst1) = sr_[i].k1; } \
    if constexpr (PV8) { if (vvalid) *(bf16x8*)(V_lds + (b) * SHM_V + vst0) = sr_[i].v0; } else { *(bf16x8*)(V_lds + (b) * SHM_V + vst0) = sr_[i].v0; if constexpr (NVL == 2) *(bf16x8*)(V_lds + (b) * SHM_V + vst1) = sr_[i].v1; } } while (0)
#define LBAR() asm volatile("s_waitcnt lgkmcnt(0)\n\ts_barrier" ::: "memory")
#define RESC(a) do { if (__any((a) < 1.f)) { _Pragma("unroll") for (int d = 0; d < NDB; ++d) _Pragma("unroll") for (int r = 0; r < 16; ++r) o[d][r] *= (a); } } while (0)
  f32x16 p0, p1; float alpha; bf16x8 pa0, pa1, pa2, pa3; i32x8 pb; const int NT = seq / 64;
#define QKCALL(Ks_) do { if constexpr (QK8) qkt8<KB8>(p0, p1, Ks_, q8, negm, r32, hi); else qkt<NKS, KPITCH>(p0, p1, Ks_, qr, negm, r32, hi); } while (0)
#define PVCALL(Vb_) do { if constexpr (PV8) pvT8<NDB>(o, Vb_, pb, r32, hi); else pvT<NDB>(o, Vb_, pa0, pa1, pa2, pa3, r32, hi); } while (0)
#define SMX(FIRST_, CHK_, chk_) do { if constexpr (PV8) softmax_tile8<FIRST_>(p0, p1, mhat, negm, l_reg, alpha, pb, (FIRST_) || (CHK_) == 1 || ((CHK_) == 2 && (chk_))); \
    else softmax_tile<FIRST_, CHK_>(p0, p1, mhat, negm, l_reg, alpha, pa0, pa1, pa2, pa3, chk_); } while (0)
#ifdef ATT_PROF
#define TS(x) do { x = __builtin_amdgcn_s_memtime(); asm volatile("s_waitcnt lgkmcnt(0)" ::: "memory"); } while (0)
#define PROF_DECL unsigned long long t0_, t1_, t2_, t3_, t4_
#define PROF_ACC() do { if (prof) { prof[0] += t1_ - t0_; prof[1] += t2_ - t1_; prof[2] += t3_ - t2_; prof[3] += t4_ - t3_; prof[4] += 1; } } while (0)
#else
#define TS(x) do { } while (0)
#define PROF_DECL
#define PROF_ACC() do { } while (0)
#endif
#define STEP(n_, SL, CHK_) do { PROF_DECL; TS(t0_); __builtin_amdgcn_s_setprio(ATT_MPRIO);     \
    QKCALL(K_lds + kb * SHM_K); SBAR(); \
    PVCALL(V_lds + vbi * SHM_V); \
    __builtin_amdgcn_s_setprio(ATT_VPRIO); \
    if ((n_) + 1 < NT) SWRITE(wb, SL); \
    TS(t1_); if (grp == 1) LBAR(); TS(t2_); \
    if ((n_) + 3 < NT) SLOAD(SL, ((n_) + 3) * 64); \
    SBAR(); \
    SMX(false, CHK_, chk); SBAR(); \
    if constexpr ((CHK_) != 0 || PV8) RESC(alpha); \
    TS(t3_); if (grp == 0) LBAR(); TS(t4_); PROF_ACC(); \
    vbi = kb; kb = wb; wb = (wb == 2) ? 0 : wb + 1; } while (0)
  if constexpr (RING == 3) {
  LBAR();
    SLOAD(0, 0); SLOAD(1, 64); SWRITE(0, 0); if (2 < NT) SLOAD(0, 128);
    LBAR();
    QKCALL(K_lds); if constexpr (QK8) { asm volatile("s_nop 15\n\ts_nop 15\n\ts_nop 15\n\ts_nop 15\n\ts_nop 15" : "+v"(p0), "+v"(p1)); }
    SWRITE(1, 1);
    if (grp == 1) LBAR();
    if (3 < NT) SLOAD(1, 192);
    SBAR();
    SMX(true, 1, true); SBAR();
    const bool chk = !__all(bnd - mhat <= THRL);
    if (grp == 0) LBAR();
    int kb = 1, vbi = 0, wb = 2;
    if constexpr (SPEC) {
    if (!chk) { for (int n = 1; n + 1 < NT; n += 2) { STEP(n, 0, 0); STEP(n + 1, 1, 0); } STEP(NT - 1, 0, 0); }
    else { for (int n = 1; n + 1 < NT; n += 2) { STEP(n, 0, 1); STEP(n + 1, 1, 1); } STEP(NT - 1, 0, 1); }
    } else { for (int n = 1; n + 1 < NT; n += 2) { STEP(n, 0, 2); STEP(n + 1, 1, 2); } STEP(NT - 1, 0, 2); }
    { __builtin_amdgcn_s_setprio(1); PVCALL(V_lds + vbi * SHM_V); __builtin_amdgcn_s_setprio(0); }
    __builtin_amdgcn_s_setprio(0);
  } else {
#define STEP5(n_, SL, BAR_, CHK_) do { __builtin_amdgcn_s_setprio(ATT_MPRIO); \
    QKCALL(K_lds + kb * SHM_K); SBAR(); \
    PVCALL(V_lds + vbi * SHM_V); \
    __builtin_amdgcn_s_setprio(ATT_VPRIO); \
    if ((n_) + 2 < NT) SWRITE(wb, SL); \
    if ((BAR_) && grp == 1) LBAR(); \
    if ((n_) + 4 < NT) SLOAD(SL, ((n_) + 4) * 64); \
    SBAR(); \
    SMX(false, CHK_, chk); SBAR(); \
    if constexpr ((CHK_) != 0 || PV8) RESC(alpha); \
    if ((BAR_) && grp == 0) LBAR(); \
    vbi = kb; kb = (kb == 4) ? 0 : kb + 1; wb = (wb == 4) ? 0 : wb + 1; } while (0)
  LBAR();
  SLOAD(0, 0); SLOAD(1, 64); SWRITE(0, 0); SLOAD(0, 128); SWRITE(1, 1); SLOAD(1, 192);
  LBAR();
  QKCALL(K_lds); if constexpr (QK8) { asm volatile("s_nop 15\n\ts_nop 15\n\ts_nop 15\n\ts_nop 15\n\ts_nop 15" : "+v"(p0), "+v"(p1)); }
  SWRITE(2, 0);
  if (4 < NT) SLOAD(0, 256);
  SBAR();
  SMX(true, 1, true); SBAR();
  const bool chk = !__all(bnd - mhat <= THRL);
  int kb = 1, vbi = 0, wb = 3;
  if constexpr (SPEC) {
  if (!chk) { for (int n = 1; n + 1 < NT; n += 2) { STEP5(n, 1, true, 0); STEP5(n + 1, 0, false, 0); } STEP5(NT - 1, 1, true, 0); }
  else { for (int n = 1; n + 1 < NT; n += 2) { STEP5(n, 1, true, 1); STEP5(n + 1, 0, false, 1); } STEP5(NT - 1, 1, true, 1); }
  } else { for (int n = 1; n + 1 < NT; n += 2) { STEP5(n, 1, true, 2); STEP5(n + 1, 0, false, 2); } STEP5(NT - 1, 1, true, 2); }
  { __builtin_amdgcn_s_setprio(1); PVCALL(V_lds + vbi * SHM_V); __builtin_amdgcn_s_setprio(0); }
#undef STEP5
  }
  if constexpr (PV8) { asm volatile("s_nop 15\n\ts_nop 15\n\ts_nop 15\n\ts_nop 15\n\ts_nop 15" : "+v"(o[0]), "+v"(o[NDB - 1])); }
#undef PVCALL
#undef QKCALL
#undef SMX
#undef STEP
#undef SLOAD
#undef LD8B
#undef SWRITE
#undef LBAR
#undef RESC
}

template <int DQK, int DV> struct Cfg2 {
  static constexpr int KB8 = (DQK + 63) / 64, RB = 64 * KB8, SHM_K = 64 * RB, NDB = DV / 32, SHM_V = DV * 64, NBUF = 4;
  static constexpr int WS_OFF = NBUF * (SHM_K + SHM_V), STASH_OFF = WS_OFF + 2048;
};
#define NOP80 "s_nop 15\n\ts_nop 15\n\ts_nop 15\n\ts_nop 15\n\ts_nop 15"
#define NOP256 NOP80 "\n\t" NOP80 "\n\t" NOP80 "\n\ts_nop 15"
template <int A, int B> ADI void exps2(f32x16& x0, f32x16& x1) {
#pragma unroll
  for (int e = A; e < B; ++e) { if (e < 16) x0[e] = __builtin_amdgcn_exp2f(x0[e]); else x1[e - 16] = __builtin_amdgcn_exp2f(x1[e - 16]); }
}
template <int A, int B, bool INIT = false> ADI void adds2(float (&s4)[4], const f32x16& x0, const f32x16& x1) {
#pragma unroll
  for (int e = A; e < B; ++e) { const float x = (e < 16) ? x0[e] : x1[e - 16]; if (INIT && e < 2) s4[e & 1] = x; else s4[e & 1] += x; }
}
ADI __amdgpu_buffer_rsrc_t mk_rsrc(const char* p) {
  const unsigned long long a = (unsigned long long)p;
  const unsigned lo = __builtin_amdgcn_readfirstlane((unsigned)a), hi = __builtin_amdgcn_readfirstlane((unsigned)(a >> 32));
  return __builtin_amdgcn_make_buffer_rsrc((void*)(((unsigned long long)hi << 32) | lo), 0, 0x7ffffff0, 0x00020000);
}
template <int DQK, int DV, bool CHKC>
ADI bool attn_core2(const char* __restrict__ Qb, const char* __restrict__ Kh, const char* __restrict__ Vt, const int vpitch, const int seq, char* lds,
                    f32x16 (&o)[DV / 32], float& l_out, const int wid, const float kmax2) {
  using CF = Cfg2<DQK, DV>;
  constexpr int KB8 = CF::KB8, RB = CF::RB, SHM_K = CF::SHM_K, NDB = CF::NDB, SHM_V = CF::SHM_V;
  static_assert((KB8 == 1 && NDB == 4) || (KB8 == 2 && NDB == 2), "six MFMAs per tile: (64,128) or (96,64)");
  int lane_ = (int)__builtin_amdgcn_mbcnt_hi(~0u, __builtin_amdgcn_mbcnt_lo(~0u, 0u)); asm volatile("" : "+v"(lane_));
  const int lane = lane_, tid = wid * 64 + lane, r32 = lane & 31, hi = lane >> 5;
  char* K_lds = lds; char* V_lds = lds + CF::NBUF * SHM_K;
  float mhat = 0.f, l_reg = 0.f; f32x16 negm = f32x16{};
#pragma unroll
  for (int d = 0; d < NDB; ++d) o[d] = f32x16{};
  i32x8 q8[KB8]; float bnd;
  { const char* Qw8 = Qb + (size_t)(wid * 32 + r32) * RB + hi * 32; float qn2 = 0.f;
#pragma unroll
    for (int ks = 0; ks < KB8; ++ks) { const u32x4 a = *reinterpret_cast<const u32x4*>(Qw8 + ks * 64), b = *reinterpret_cast<const u32x4*>(Qw8 + ks * 64 + 16);
      q8[ks] = i32x8{(int)a[0], (int)a[1], (int)a[2], (int)a[3], (int)b[0], (int)b[1], (int)b[2], (int)b[3]};
#pragma unroll
      for (int j = 0; j < 8; ++j) { const auto x = __builtin_amdgcn_cvt_pk_f32_fp8(q8[ks][j], false), y = __builtin_amdgcn_cvt_pk_f32_fp8(q8[ks][j], true); qn2 += (x[0] * x[0] + x[1] * x[1]) + (y[0] * y[0] + y[1] * y[1]); } }
    auto rr = __builtin_amdgcn_permlane32_swap(__float_as_uint(qn2), __float_as_uint(qn2), false, false);
    qn2 = __uint_as_float(rr[0]) + __uint_as_float(rr[1]);
    bnd = sqrtf(qn2 * kmax2) * (1.07f / QS8); }
  constexpr int CPR8 = 4 * KB8;
  const int krow = tid / CPR8, kch = tid % CPR8; const bool kvalid = (KB8 == 2) || wid < 4;
  const int vrow = tid >> 2, vch = tid & 3; const bool vvalid = (DV == 128) || wid < 4;
  struct { bf16x8 k0, v0; } sr_[2];
  const unsigned koff = (unsigned)(krow * RB + kch * 16), voff = (unsigned)(vrow * vpitch + vch * 16);
  const int kst0 = krow * RB + ((kch * 16) ^ kswz8<RB>(krow)), vst0 = vrow * 64 + ((vch ^ ((vrow >> 2) & 3)) << 4);
#define LD8B(base, off) (*reinterpret_cast<const bf16x8*>((const char*)(base) + (off)))
  const __amdgpu_buffer_rsrc_t krs = mk_rsrc(Kh), vrs = mk_rsrc(Vt);
#define SLOAD(i, kk0) do { if (kvalid) sr_[i].k0 = __builtin_bit_cast(bf16x8, __builtin_amdgcn_raw_buffer_load_b128(krs, (int)koff, (int)((kk0) * RB), 0)); if (vvalid) sr_[i].v0 = __builtin_bit_cast(bf16x8, __builtin_amdgcn_raw_buffer_load_b128(vrs, (int)voff, (int)(kk0), 0)); } while (0)
#define SWRITE(b, i) do { if (kvalid) *(bf16x8*)(K_lds + (b) * SHM_K + kst0) = sr_[i].k0; if (vvalid) *(bf16x8*)(V_lds + (b) * SHM_V + vst0) = sr_[i].v0; } while (0)
#define LBAR() asm volatile("s_waitcnt lgkmcnt(0)\n\ts_barrier" ::: "memory")
#define PIN(a_, b_) asm volatile("" : "+v"(a_), "+v"(b_), "+v"(ps4[0]), "+v"(ps4[1]))
  const int swk = kswz8<RB>(r32), gv = (r32 >> 2) & 3;
  const int kfo = r32 * RB, vfo0 = r32 * 64 + (((2 * hi) ^ gv) << 4), vfo1 = r32 * 64 + (((2 * hi + 1) ^ gv) << 4);
#define KLO(Kb_, t, ks) (*reinterpret_cast<const u32x4*>((Kb_) + kfo + (t) * 32 * RB + (((ks) * 64 + hi * 32) ^ swk)))
#define KHH(Kb_, t, ks) (*reinterpret_cast<const u32x4*>((Kb_) + kfo + (t) * 32 * RB + (((ks) * 64 + hi * 32 + 16) ^ swk)))
#define VLO(Vb_, d) (*reinterpret_cast<const u32x4*>((Vb_) + (d) * 2048 + vfo0))
#define VHH(Vb_, d) (*reinterpret_cast<const u32x4*>((Vb_) + (d) * 2048 + vfo1))
#define MK8(lo_, hh_) i32x8{(int)(lo_)[0], (int)(lo_)[1], (int)(lo_)[2], (int)(lo_)[3], (int)(hh_)[0], (int)(hh_)[1], (int)(hh_)[2], (int)(hh_)[3]}
  f32x16 X0, X1, Y0, Y1; i32x8 pb = {0, 0, 0, 0, 0, 0, 0, 0}; float ps4[4] = {0.f, 0.f, 0.f, 0.f}; const int NT = seq / 64;
#define TAIL(E0, E1, C0, C1, HAVE_C) do { \
    float ps = ps4[0] + ps4[1];        \
    if (__builtin_expect(__any(ps > SUM8), 0)) { \
      float hmax; { auto rr = __builtin_amdgcn_permlane32_swap(__float_as_uint(ps), __float_as_uint(ps), false, false); hmax = fmaxf(__uint_as_float(rr[0]), __uint_as_float(rr[1])); }        \
      const float dl = hmax > SUM8 ? ceilf(__builtin_amdgcn_logf(hmax)) - 6.f : 0.f; const float f = __builtin_amdgcn_exp2f(-dl); \
      mhat += dl; ps *= f; l_reg *= f; \
      asm volatile(NOP256 ::: "memory");        \
      _Pragma("unroll") for (int r = 0; r < 16; ++r) { E0[r] *= f; E1[r] *= f; negm[r] -= dl; }        \
      if (HAVE_C) { _Pragma("unroll") for (int r = 0; r < 16; ++r) { C0[r] -= dl; C1[r] -= dl; } } \
      _Pragma("unroll") for (int d = 0; d < NDB; ++d) _Pragma("unroll") for (int r = 0; r < 16; ++r) o[d][r] *= f; \
    } \
    l_reg += ps; if constexpr (!CHKC) asm volatile("" : "+v"(l_reg));        \
    _Pragma("unroll") for (int i = 0; i < 4; ++i) { int w = __builtin_amdgcn_cvt_pk_fp8_f32(E0[4 * i], E0[4 * i + 1], pb[i], false); pb[i] = __builtin_amdgcn_cvt_pk_fp8_f32(E0[4 * i + 2], E0[4 * i + 3], w, true); } \
    _Pragma("unroll") for (int i = 0; i < 4; ++i) { int w = __builtin_amdgcn_cvt_pk_fp8_f32(E1[4 * i], E1[4 * i + 1], pb[4 + i], false); pb[4 + i] = __builtin_amdgcn_cvt_pk_fp8_f32(E1[4 * i + 2], E1[4 * i + 3], w, true); } \
  } while (0)
#define PRECHECK(C0, C1, FIRST_) do { \
    float pmax = C0[0]; \
    _Pragma("unroll") for (int r = 1; r < 16; ++r) pmax = fmaxf(pmax, C0[r]); \
    _Pragma("unroll") for (int r = 0; r < 16; ++r) pmax = fmaxf(pmax, C1[r]); \
    { auto rr = __builtin_amdgcn_permlane32_swap(__float_as_uint(pmax), __float_as_uint(pmax), false, false); pmax = fmaxf(__uint_as_float(rr[0]), __uint_as_float(rr[1])); } \
    if ((FIRST_) || __builtin_expect(__any(pmax > THR8), 0)) { \
      const float dl = (FIRST_) ? pmax - OFF8 : (pmax > THR8 ? pmax - OFF8 : 0.f); mhat += dl; \
      _Pragma("unroll") for (int r = 0; r < 16; ++r) { C0[r] -= dl; C1[r] -= dl; negm[r] = -mhat; } \
      if (!(FIRST_)) { const float f = __builtin_amdgcn_exp2f(-dl); l_reg *= f; fpend = f; }        \
    } } while (0)
#define ITER(E0, E1, C0, C1, n_, HAVE_QK, KBI, VBI, WBI, SLOT) do {        \
    const char* Kb_ = K_lds + (KBI) * SHM_K; const char* Vb_ = V_lds + (VBI) * SHM_V; \
    u32x4 kl[2][KB8], kh[2][KB8], vl[NDB], vh[NDB]; float fpend = 1.f; \
    SBAR(); \
    if (HAVE_QK) { _Pragma("unroll") for (int ks = 0; ks < KB8; ++ks) _Pragma("unroll") for (int t = 0; t < 2; ++t) { kl[t][ks] = KLO(Kb_, t, ks); kh[t][ks] = KHH(Kb_, t, ks); } } \
    _Pragma("unroll") for (int d = 0; d < 2; ++d) { vl[d] = VLO(Vb_, d); vh[d] = VHH(Vb_, d); } \
    SBAR(); \
    TAIL(E0, E1, C0, C1, true); \
    if constexpr (CHKC) PRECHECK(C0, C1, false); \
    SBAR(); \
    if constexpr (KB8 == 1) {     \
      if (HAVE_QK) { mfma8_c(E0, MK8(kl[0][0], kh[0][0]), q8[0], negm); } SBAR(); exps2<0, 6>(C0, C1); PIN(C0, C1); SBAR(); \
      if (HAVE_QK) { mfma8_c(E1, MK8(kl[1][0], kh[1][0]), q8[0], negm); } SBAR(); exps2<6, 12>(C0, C1); adds2<0, 6, true>(ps4, C0, C1); PIN(C0, C1); vl[2] = VLO(Vb_, 2); vh[2] = VHH(Vb_, 2); vl[3] = VLO(Vb_, 3); vh[3] = VHH(Vb_, 3); SBAR(); \
      mfma8(o[0], MK8(vl[0], vh[0]), pb); SBAR(); exps2<12, 18>(C0, C1); adds2<6, 12>(ps4, C0, C1); PIN(C0, C1); SBAR(); \
      mfma8(o[1], MK8(vl[1], vh[1]), pb); SBAR(); exps2<18, 24>(C0, C1); adds2<12, 18>(ps4, C0, C1); PIN(C0, C1); SBAR(); \
      mfma8(o[2], MK8(vl[2], vh[2]), pb); SBAR(); exps2<24, 30>(C0, C1); adds2<18, 24>(ps4, C0, C1); PIN(C0, C1); SBAR(); \
      mfma8(o[3], MK8(vl[3], vh[3]), pb); SBAR(); exps2<30, 32>(C0, C1); adds2<24, 32>(ps4, C0, C1); PIN(C0, C1); SBAR(); \
    } else {                      \
      if (HAVE_QK) { mfma8_c(E0, MK8(kl[0][0], kh[0][0]), q8[0], negm); } SBAR(); exps2<0, 6>(C0, C1); PIN(C0, C1); SBAR(); \
      if (HAVE_QK) { mfma8_c(E1, MK8(kl[1][0], kh[1][0]), q8[0], negm); } SBAR(); exps2<6, 12>(C0, C1); adds2<0, 6, true>(ps4, C0, C1); PIN(C0, C1); SBAR(); \
      if (HAVE_QK) { mfma8(E0, MK8(kl[0][1], kh[0][1]), q8[1]); } SBAR(); exps2<12, 18>(C0, C1); adds2<6, 12>(ps4, C0, C1); PIN(C0, C1); SBAR(); \
      if (HAVE_QK) { mfma8(E1, MK8(kl[1][1], kh[1][1]), q8[1]); } SBAR(); exps2<18, 24>(C0, C1); adds2<12, 18>(ps4, C0, C1); PIN(C0, C1); SBAR(); \
      mfma8(o[0], MK8(vl[0], vh[0]), pb); SBAR(); exps2<24, 30>(C0, C1); adds2<18, 24>(ps4, C0, C1); PIN(C0, C1); SBAR(); \
      mfma8(o[1], MK8(vl[1], vh[1]), pb); SBAR(); exps2<30, 32>(C0, C1); adds2<24, 32>(ps4, C0, C1); PIN(C0, C1); SBAR(); \
    } \
    if constexpr (CHKC) { if (__any(fpend < 1.f)) { asm volatile(NOP256 ::: "memory"); _Pragma("unroll") for (int d = 0; d < NDB; ++d) _Pragma("unroll") for (int r = 0; r < 16; ++r) o[d][r] *= fpend; } } \
    SWRITE((WBI), (SLOT)); SLOAD((SLOT), ((n_) + 4) * 64);        \
    LBAR(); } while (0)
  LBAR();
  SLOAD(0, 0); SLOAD(1, 64); SWRITE(0, 0); SLOAD(0, 128); SWRITE(1, 1); SLOAD(1, 192);
  LBAR();
  { const char* Kb_ = K_lds; u32x4 kl[2][KB8], kh[2][KB8];
#pragma unroll
    for (int ks = 0; ks < KB8; ++ks)
#pragma unroll
      for (int t = 0; t < 2; ++t) { kl[t][ks] = KLO(Kb_, t, ks); kh[t][ks] = KHH(Kb_, t, ks); }
    mfma8_c(Y0, MK8(kl[0][0], kh[0][0]), q8[0], negm); mfma8_c(Y1, MK8(kl[1][0], kh[1][0]), q8[0], negm);
    if constexpr (KB8 == 2) { mfma8(Y0, MK8(kl[0][1], kh[0][1]), q8[1]); mfma8(Y1, MK8(kl[1][1], kh[1][1]), q8[1]); }
    asm volatile(NOP80 : "+v"(Y0), "+v"(Y1)); }
  { float fpend = 1.f; PRECHECK(Y0, Y1, true); (void)fpend; }
  const bool need = !CHKC && !__all(bnd - mhat <= THRL);
  { const char* Kb_ = K_lds + SHM_K; u32x4 kl[2][KB8], kh[2][KB8];
    SBAR();
#pragma unroll
    for (int ks = 0; ks < KB8; ++ks)
#pragma unroll
      for (int t = 0; t < 2; ++t) { kl[t][ks] = KLO(Kb_, t, ks); kh[t][ks] = KHH(Kb_, t, ks); }
    SBAR();
    mfma8_c(X0, MK8(kl[0][0], kh[0][0]), q8[0], negm); SBAR(); exps2<0, 8>(Y0, Y1); PIN(Y0, Y1); SBAR();
    mfma8_c(X1, MK8(kl[1][0], kh[1][0]), q8[0], negm); SBAR(); exps2<8, 16>(Y0, Y1); PIN(Y0, Y1); SBAR();
    if constexpr (KB8 == 2) { mfma8(X0, MK8(kl[0][1], kh[0][1]), q8[1]); SBAR(); exps2<16, 24>(Y0, Y1); PIN(Y0, Y1); SBAR(); mfma8(X1, MK8(kl[1][1], kh[1][1]), q8[1]); SBAR(); exps2<24, 32>(Y0, Y1); PIN(Y0, Y1); }
    else { exps2<16, 32>(Y0, Y1); PIN(Y0, Y1); }
    adds2<0, 32>(ps4, Y0, Y1); PIN(Y0, Y1); SBAR();
    SWRITE(2, 0); SLOAD(0, 256);
    LBAR(); }
  ITER(Y0, Y1, X0, X1, 1, true, 2, 0, 3, 1); ITER(X0, X1, Y0, Y1, 2, true, 3, 1, 0, 0);
  for (int n = 3; n + 2 < NT; n += 4) {
    ITER(Y0, Y1, X0, X1, n, true, 0, 2, 1, 1); ITER(X0, X1, Y0, Y1, n + 1, true, 1, 3, 2, 0);
    ITER(Y0, Y1, X0, X1, n + 2, true, 2, 0, 3, 1); ITER(X0, X1, Y0, Y1, n + 3, true, 3, 1, 0, 0); }
  ITER(Y0, Y1, X0, X1, NT - 1, false, 0, 2, 1, 1);
  { const char* Vb_ = V_lds + 3 * SHM_V; u32x4 vl[NDB], vh[NDB];
    SBAR();
#pragma unroll
    for (int d = 0; d < NDB; ++d) { vl[d] = VLO(Vb_, d); vh[d] = VHH(Vb_, d); }
    SBAR();
    TAIL(X0, X1, Y0, Y1, false);
    SBAR(); asm volatile("s_nop 7" : "+v"(pb)); SBAR();
#pragma unroll
    for (int d = 0; d < NDB; ++d) mfma8(o[d], MK8(vl[d], vh[d]), pb);
    asm volatile(NOP80 : "+v"(o[0]), "+v"(o[NDB - 1])); }
  { auto rr = __builtin_amdgcn_permlane32_swap(__float_as_uint(l_reg), __float_as_uint(l_reg), false, false); l_out = __uint_as_float(rr[0]) + __uint_as_float(rr[1]); }
  return need;
#undef ITER
#undef PIN
#undef PRECHECK
#undef TAIL
#undef MK8
#undef VHH
#undef VLO
#undef KHH
#undef KLO
#undef LBAR
#undef SWRITE
#undef SLOAD
#undef LD8B
}
}
typedef unsigned short bf16_fwd_decl_unused;
#define GAS __attribute__((address_space(1)))
#define LAS __attribute__((address_space(3)))
#define DI __device__ __forceinline__
typedef unsigned short bf16;
typedef float f32x4 __attribute__((ext_vector_type(4)));
typedef float f32x2 __attribute__((ext_vector_type(2)));
typedef unsigned u32x4 __attribute__((ext_vector_type(4)));
typedef unsigned u32x2 __attribute__((ext_vector_type(2)));
typedef short bf16x8 __attribute__((ext_vector_type(8)));

constexpr int DM = 1024, NB = 8, SEQ = 8192, CTX = 256;
constexpr int NL = NB * SEQ, NC = NB * CTX, NR = NL + NC;
constexpr int TKV = SEQ + CTX;
constexpr int NE = 16, FFE = 1024, CAPL = 1024, CAPC = 32;
constexpr int ROWS_E = NB * CAPL + NB * CAPC;
constexpr int MT_E = ROWS_E / 256;
constexpr float DN_ALPHA = 1.4142135623730951f;
constexpr float LAM_INIT = 0.35550906759f;
constexpr int NWAVES = 8, NTHR = 512;
constexpr float QSCALE_MLA = 0.10206207261596575f * 1.4426950408889634f;
constexpr float QSCALE_DIFF = 0.125f * 1.4426950408889634f;

constexpr size_t MiB = 1u << 20;
constexpr size_t WS_CTL = 0, CTL_ZERO_BYTES = 1 * MiB;
constexpr size_t WS_MOD = 1 * MiB;
constexpr size_t WS_ROPE16 = 2 * MiB;
constexpr size_t WS_ROPE32 = 3 * MiB;
constexpr size_t WS_RQ = 5 * MiB;
constexpr size_t WS_RKV = 5 * MiB + 512 * 1024;
constexpr size_t WS_AFF = 6 * MiB;
constexpr size_t WS_AFFC = 10 * MiB;
constexpr size_t WS_ROWIDX = 11 * MiB;
constexpr size_t WS_ROWGATE = 12 * MiB;
constexpr size_t WS_SLOTROW = 13 * MiB;
constexpr size_t WS_XC = 18 * MiB;
constexpr size_t WS_GWS = 26 * MiB;
constexpr size_t WS_SW = 27 * MiB;
constexpr size_t WS_SX = 28 * MiB;
constexpr size_t WS_WIN0 = 32 * MiB;
constexpr size_t WS_WUQ = 35 * MiB;
constexpr size_t WS_WUKV = 35 * MiB + 512 * 1024;
constexpr size_t WS_WOUT0 = 36 * MiB;
constexpr size_t WS_WGU0 = 38 * MiB;
constexpr size_t WS_WDN0 = 102 * MiB;
constexpr size_t WS_WIN1 = 134 * MiB;
constexpr size_t WS_WOUT1 = 140 * MiB;
constexpr size_t WS_WGU1 = 142 * MiB;
constexpr size_t WS_WDN1 = 206 * MiB;
constexpr size_t WS_R1 = 240 * MiB, WS_R2 = 520 * MiB, WS_R3 = 800 * MiB;
constexpr size_t WS_H = WS_R3;
constexpr size_t WS_CQ = WS_R3 + 132 * MiB;
constexpr size_t WS_CKV = WS_R3 + 165 * MiB;
constexpr size_t WS_UV = WS_R1;
constexpr size_t WS_QL = WS_R2;
constexpr size_t WS_KR = WS_R2;
constexpr size_t WS_QC = WS_R2 + 96 * MiB;
constexpr size_t WS_K0 = WS_R2 + 99 * MiB;
constexpr size_t WS_V0 = WS_R2 + 198 * MiB;
constexpr size_t WS_HID = WS_R1;
constexpr size_t WS_XS = WS_R2;
constexpr size_t WS_Y = WS_R2;
constexpr size_t WS_Q1 = WS_R1;
constexpr size_t WS_K1 = WS_R1 + 128 * MiB;
constexpr size_t WS_V1 = WS_R1 + 260 * MiB;
constexpr size_t WS_O1 = WS_R1 + 392 * MiB;
constexpr size_t WS_WGU8_0 = WS_R3 + 182 * MiB;
constexpr size_t WS_WGU8_1 = WS_WGU0;
constexpr size_t WS_WDN8_0 = WS_WGU0 + 32 * MiB, WS_WDN8_1 = WS_WGU0 + 48 * MiB;
constexpr float HID_SCALE = 8.f;
constexpr size_t WS_T16_0 = WS_R2, WS_T16_1 = WS_R1;
constexpr size_t WS_X1 = WS_R1 + 140 * MiB;
constexpr size_t WS_END = 1024 * MiB;
static_assert(WS_CKV + (size_t)NR * 128 * 2 <= WS_END, "ws map");
static_assert(WS_V0 + (size_t)NB * 8 * TKV * 64 * 2 <= WS_R3, "ws map");
static_assert(WS_O1 + (size_t)NL * 1024 * 2 <= WS_R3, "ws map");
static_assert(WS_XS + (size_t)NE * ROWS_E * 1024 * 2 <= WS_R3 && WS_HID + (size_t)NE * ROWS_E * 1024 * 2 <= WS_R2, "ws map");
static_assert(WS_WDN1 + 32 * MiB <= WS_R1 && WS_SLOTROW + (size_t)NR * 16 * 4 <= WS_XC && WS_XC + (size_t)NC * 1024 * 4 <= WS_GWS, "ws map");

constexpr int CW_BAR = 4096;
constexpr int CW_KCH0 = 65536;
constexpr int CW_KCHR = 65536 + 1024;
constexpr int CW_KCH1 = 65536 + 2048;
constexpr int RING_BYTES = 151552, LDSCTL_OFF = RING_BYTES, MISC_OFF = LDSCTL_OFF + 320, LDS_BYTES = 155648;
constexpr int GTBL_OFF = 131072;

struct Params {
    const float* in[41];
    float* out; unsigned char* ws;
    int ph_lo, ph_hi;
};
enum { I_X = 0, I_C, I_CTX, I_CCTX, I_WMOD0, I_BMOD0, I_WIN0, I_GLNG, I_GLNB, I_GWS, I_GBS, I_QNORM, I_WUQ, I_KVNORM, I_WUKV, I_WOUT0,
       I_LNMG0, I_LNMB0, I_ROUTER0, I_WGATE0, I_WUP0, I_WDOWN0, I_LNFG0, I_LNFB0,
       I_WMOD1, I_BMOD1, I_WIN1, I_LQ1, I_LK1, I_LQ2, I_LK2, I_SUBLN, I_WOUT1, I_LNMG1, I_LNMB1, I_ROUTER1, I_WGATE1, I_WUP1, I_WDOWN1, I_LNFG1, I_LNFB1 };

DI unsigned cvt_pk(float lo, float hi) { unsigned r; asm volatile("v_cvt_pk_bf16_f32 %0, %1, %2" : "=v"(r) : "v"(lo), "v"(hi)); return r; }
DI float bf_lo(unsigned u) { return __uint_as_float(u << 16); }
DI float bf_hi(unsigned u) { return __uint_as_float(u & 0xffff0000u); }
DI u32x4 pack8(f32x4 a, f32x4 b) { u32x4 w; w.x = cvt_pk(a[0], a[1]); w.y = cvt_pk(a[2], a[3]); w.z = cvt_pk(b[0], b[1]); w.w = cvt_pk(b[2], b[3]); return w; }
DI u32x2 pack8_fp8(f32x4 a, f32x4 b) { u32x2 w; const int t0 = __builtin_amdgcn_cvt_pk_fp8_f32(a[0], a[1], 0, false); w.x = (unsigned)__builtin_amdgcn_cvt_pk_fp8_f32(a[2], a[3], t0, true);
    const int t1 = __builtin_amdgcn_cvt_pk_fp8_f32(b[0], b[1], 0, false); w.y = (unsigned)__builtin_amdgcn_cvt_pk_fp8_f32(b[2], b[3], t1, true); return w; }
#define ST8(base, off, val) (*(u32x2*)((char*)(base) + (unsigned)(off)) = (val))
DI float wave_sum(float v) {
#pragma unroll
    for (int o = 1; o < 64; o <<= 1) v += __shfl_xor(v, o);
    return v;
}
DI float wave_max(float v) {
#pragma unroll
    for (int o = 1; o < 64; o <<= 1) v = fmaxf(v, __shfl_xor(v, o));
    return v;
}
#define LDS_WAIT() asm volatile("s_waitcnt lgkmcnt(0)" ::: "memory")
#define VM_WAIT() asm volatile("s_waitcnt vmcnt(0)" ::: "memory")

DI float max16_dpp(float v) {
    int x = __float_as_int(v);
    v = fmaxf(v, __int_as_float(__builtin_amdgcn_update_dpp(x, x, 0xB1, 0xf, 0xf, false))); x = __float_as_int(v);
    v = fmaxf(v, __int_as_float(__builtin_amdgcn_update_dpp(x, x, 0x4E, 0xf, 0xf, false))); x = __float_as_int(v);
    v = fmaxf(v, __int_as_float(__builtin_amdgcn_update_dpp(x, x, 0x141, 0xf, 0xf, false))); x = __float_as_int(v);
    v = fmaxf(v, __int_as_float(__builtin_amdgcn_update_dpp(x, x, 0x140, 0xf, 0xf, false)));
    return v;
}
DI void row_info(int row, int& b, int& tpos, int& t_rope) {
    if (row < NL) { b = row >> 13; tpos = row & (SEQ - 1); t_rope = tpos; }
    else { const int j = row - NL; b = j >> 8; tpos = SEQ + (j & (CTX - 1)); t_rope = -1; }
}
DI void rope8(f32x4& v0, f32x4& v1, const f32x2* cs) {
    const f32x2 c0 = cs[0], c1 = cs[1], c2 = cs[2], c3 = cs[3];
    float a, b;
    a = v0[0]; b = v0[1]; v0[0] = a * c0.x - b * c0.y; v0[1] = a * c0.y + b * c0.x;
    a = v0[2]; b = v0[3]; v0[2] = a * c1.x - b * c1.y; v0[3] = a * c1.y + b * c1.x;
    a = v1[0]; b = v1[1]; v1[0] = a * c2.x - b * c2.y; v1[1] = a * c2.y + b * c2.x;
    a = v1[2]; b = v1[3]; v1[2] = a * c3.x - b * c3.y; v1[3] = a * c3.y + b * c3.x;
}

DI unsigned vt_pos(unsigned t) { return (t & ~15u) | (t & 3u) | (((t >> 3) & 1u) << 2) | (((t >> 2) & 1u) << 3); }
DI void st_vt8(unsigned char* ws, unsigned off0  , f32x4 v0, f32x4 v1) {
    const unsigned w0 = cvt_pk(v0[0], v0[1]), w1 = cvt_pk(v0[2], v0[3]), w2 = cvt_pk(v1[0], v1[1]), w3 = cvt_pk(v1[2], v1[3]);
    constexpr unsigned RS = (unsigned)TKV * 2u;
    unsigned char* q = ws + off0;
    *(bf16*)q = (bf16)(w0 & 0xffffu); q += RS; *(bf16*)q = (bf16)(w0 >> 16); q += RS; __builtin_amdgcn_sched_barrier(0);
    *(bf16*)q = (bf16)(w1 & 0xffffu); q += RS; *(bf16*)q = (bf16)(w1 >> 16); q += RS; __builtin_amdgcn_sched_barrier(0);
    *(bf16*)q = (bf16)(w2 & 0xffffu); q += RS; *(bf16*)q = (bf16)(w2 >> 16); q += RS; __builtin_amdgcn_sched_barrier(0);
    *(bf16*)q = (bf16)(w3 & 0xffffu); q += RS; *(bf16*)q = (bf16)(w3 >> 16); __builtin_amdgcn_sched_barrier(0);
}

using pg8::Unit;
#define EPI_ARGS const f32x4 (&acc)[2][2][4][2], const Unit& u, int wr, int wc, int fr, int fq
#define EPI_FOR_ROWS _Pragma("unroll") for (int ai = 0; ai < 2; ++ai) _Pragma("unroll") for (int m = 0; m < 4; ++m)
#define EPI_ROW (u.pm * 256 + ai * 128 + wr * 64 + m * 16 + fr)
#define EPI_FOR_COLS _Pragma("unroll") for (int bj = 0; bj < 2; ++bj)
#define EPI_LCOL (bj * 128 + wc * 32 + 8 * fq)

DI f32x4 gelu4(f32x4 v) { f32x2 a = pg8::gelu_pk((f32x2){v[0], v[1]}), b = pg8::gelu_pk((f32x2){v[2], v[3]}); return (f32x4){a.x, a.y, b.x, b.y}; }

#define ST16(base, off, val) (*(u32x4*)((char*)(base) + (unsigned)(off)) = (val))
#define EPI_ROW_END __builtin_amdgcn_sched_barrier(0)
struct EpiA0 {
    static constexpr bool PERM = true, AFTER_DRAIN = false;
    unsigned char* ws;
    DI void operator()(EPI_ARGS) const {
        const int pn = u.pn;
        EPI_FOR_ROWS { const unsigned row = (unsigned)EPI_ROW;
            EPI_FOR_COLS { const unsigned lcol = (unsigned)EPI_LCOL; f32x4 v0 = acc[ai][bj][m][0], v1 = acc[ai][bj][m][1];
                if (pn < 4) { v0 = gelu4(v0); v1 = gelu4(v1); ST16(ws, (unsigned)WS_UV + (row * 1024u + (unsigned)pn * 256u + lcol) * 2u, pack8(v0, v1)); }
                else if (pn == 4) { ST16(ws, (unsigned)WS_CQ + (row * 256u + lcol) * 2u, pack8(v0, v1)); }
                else if (lcol < 128u) { ST16(ws, (unsigned)WS_CKV + (row * 128u + lcol) * 2u, pack8(v0, v1)); }
                else if (lcol < 160u) { ST16(ws, (unsigned)WS_KR + (row * 32u + (lcol - 128u)) * 2u, pack8(v0, v1)); }
            } EPI_ROW_END; }
    }
};
struct EpiQ {
    static constexpr bool PERM = true, AFTER_DRAIN = false;
    unsigned char* ws; const float* rq; const f32x2* rope16;
    DI void operator()(EPI_ARGS) const {
        EPI_FOR_ROWS { const int row = EPI_ROW; const float r = rq[row] * (QSCALE_MLA * 4.f); int b, tpos, tr; row_info(row, b, tpos, tr);
            const bool lat = tr >= 0; unsigned char* base = ws;
            const unsigned rowoff = lat ? (unsigned)WS_QL + (unsigned)(b * 8 * SEQ + tpos) * 128u : (unsigned)WS_QC + (unsigned)(b * 8 * CTX + (tpos - SEQ)) * 128u;
            const unsigned hstride = lat ? (unsigned)(SEQ * 128) : (unsigned)(CTX * 128);
            EPI_FOR_COLS { const unsigned col = (unsigned)(u.pn * 256 + EPI_LCOL); f32x4 v0 = acc[ai][bj][m][0] * r, v1 = acc[ai][bj][m][1] * r;
                const unsigned h = (col * 683u) >> 16;
                const unsigned d = col - h * 96u;
                if (d >= 64u && lat) rope8(v0, v1, (const f32x2*)((const char*)rope16 + (unsigned)(tr * 16 + (int)((d - 64u) >> 1)) * 8u));
                ST8(base, rowoff + h * hstride + d, pack8_fp8(v0, v1));
                if (d == 88u) { const u32x4 z = {0u, 0u, 0u, 0u}; ST16(base, rowoff + h * hstride + 96u, z); ST16(base, rowoff + h * hstride + 112u, z); }
            } EPI_ROW_END; }
    }
};
DI unsigned vt_pos8(unsigned t) { const unsigned k = t & 63u, kk = k & 31u; return (t & ~63u) | (((kk >> 2) & 1u) << 5) | ((k >> 5) << 4) | (kk & 3u) | ((kk >> 3) << 2); }
DI void st_vt8f(unsigned char* ws, unsigned off0  , f32x4 v0, f32x4 v1) {
    const unsigned w0 = (unsigned)__builtin_amdgcn_cvt_pk_fp8_f32(v0[0] * 16.f, v0[1] * 16.f, 0, false), w1 = (unsigned)__builtin_amdgcn_cvt_pk_fp8_f32(v0[2] * 16.f, v0[3] * 16.f, 0, false);
    const unsigned w2 = (unsigned)__builtin_amdgcn_cvt_pk_fp8_f32(v1[0] * 16.f, v1[1] * 16.f, 0, false), w3 = (unsigned)__builtin_amdgcn_cvt_pk_fp8_f32(v1[2] * 16.f, v1[3] * 16.f, 0, false);
    constexpr unsigned RS = (unsigned)TKV;
    unsigned char* q = ws + off0;
    *q = (unsigned char)(w0 & 0xffu); q += RS; *q = (unsigned char)((w0 >> 8) & 0xffu); q += RS; __builtin_amdgcn_sched_barrier(0);
    *q = (unsigned char)(w1 & 0xffu); q += RS; *q = (unsigned char)((w1 >> 8) & 0xffu); q += RS; __builtin_amdgcn_sched_barrier(0);
    *q = (unsigned char)(w2 & 0xffu); q += RS; *q = (unsigned char)((w2 >> 8) & 0xffu); q += RS; __builtin_amdgcn_sched_barrier(0);
    *q = (unsigned char)(w3 & 0xffu); q += RS; *q = (unsigned char)((w3 >> 8) & 0xffu); __builtin_amdgcn_sched_barrier(0);
}
struct EpiKV {
    static constexpr bool PERM = true, AFTER_DRAIN = false;
    unsigned char* ws; const float* rkv; unsigned* kch;
    DI void operator()(EPI_ARGS) const {
        float kmx[2] = {0.f, 0.f};
        EPI_FOR_ROWS { const int row = EPI_ROW; const float r = rkv[row]; int b, tpos, tr; row_info(row, b, tpos, tr);
            const unsigned tok = (unsigned)(b * 8 * TKV + tpos);
            EPI_FOR_COLS { const unsigned col = (unsigned)(u.pn * 256 + EPI_LCOL); const f32x4 v0 = acc[ai][bj][m][0] * r, v1 = acc[ai][bj][m][1] * r;
                const unsigned h = col >> 7, d = col & 127u; const unsigned th = tok + h * (unsigned)TKV;
                if (d < 64u) ST8(ws, (unsigned)WS_K0 + (th * 128u + d), pack8_fp8(v0 * 0.25f, v1 * 0.25f));
                else st_vt8f(ws, (unsigned)WS_V0 + ((((unsigned)b * 8u + h) * 64u + (d - 64u)) * (unsigned)TKV + vt_pos8((unsigned)tpos)), v0, v1);
                kmx[bj] = fmaxf(kmx[bj], (v0[0] * v0[0] + v0[1] * v0[1]) + (v0[2] * v0[2] + v0[3] * v0[3]) + (v1[0] * v1[0] + v1[1] * v1[1]) + (v1[2] * v1[2] + v1[3] * v1[3]));
            } EPI_ROW_END; }
        const int row0 = u.pm * 256; const int b = row0 < NL ? (row0 >> 13) : ((row0 - NL) >> 8);
#pragma unroll
        for (int bj = 0; bj < 2; ++bj) { const unsigned col = (unsigned)(u.pn * 256 + bj * 128 + wc * 32 + 8 * fq); const unsigned h = col >> 7, d = col & 127u;
            const float mx = max16_dpp(kmx[bj]);
            if (d < 64u && fr == 0) atomicMax(kch + (b * 8 + h) * 8 + (d >> 3), __float_as_uint(mx)); }
    }
};
struct EpiOut {
    static constexpr bool PERM = true, AFTER_DRAIN = false;
    const float* xl; const float* xc; bf16* T16; const float* gmod;
    DI void operator()(EPI_ARGS) const {
        EPI_FOR_ROWS { const int row = EPI_ROW; const bool lat = row < NL; const int b = lat ? (row >> 13) : 8;
            const char* xs = (const char*)(lat ? xl : xc); const unsigned roff = (unsigned)(lat ? row : row - NL) * 4096u;
            EPI_FOR_COLS { const unsigned col = (unsigned)(u.pn * 256 + EPI_LCOL); const f32x4 v0 = acc[ai][bj][m][0], v1 = acc[ai][bj][m][1];
                const f32x4 x0 = *(const f32x4*)(xs + (roff + col * 4u)), x1 = *(const f32x4*)(xs + (roff + col * 4u + 16u));
                const f32x4 g0 = *(const f32x4*)((const char*)gmod + ((unsigned)b * 6144u + col) * 4u), g1 = *(const f32x4*)((const char*)gmod + ((unsigned)b * 6144u + col) * 4u + 16u);
                ST16(T16, ((unsigned)row * 1024u + col) * 2u, pack8(x0 * DN_ALPHA + (g0 + 1.f) * v0, x1 * DN_ALPHA + (g1 + 1.f) * v1));
            } EPI_ROW_END; }
    }
};
struct EpiMoe1 {
    static constexpr bool PERM = true, AFTER_DRAIN = false;
    bf16* HID; int nN;
    DI void operator()(EPI_ARGS) const {
        const int e = u.pm / MT_E, pnl = u.pn - e * nN;
        EPI_FOR_ROWS { const unsigned row = (unsigned)EPI_ROW;
            EPI_FOR_COLS { const unsigned col = (unsigned)(pnl * 256 + EPI_LCOL); const f32x4 g = acc[ai][bj][m][0], up = acc[ai][bj][m][1];
                f32x4 h;
#pragma unroll
                for (int i = 0; i < 4; ++i) h[i] = g[i] / (1.f + __expf(-g[i])) * up[i];
                u32x2 w; w.x = cvt_pk(h[0], h[1]); w.y = cvt_pk(h[2], h[3]);
                *(u32x2*)((char*)HID + (row * 2048u + col)) = w;
            } EPI_ROW_END; }
    }
};
struct EpiMoe1F8 {
    static constexpr bool PERM = true, AFTER_DRAIN = false;
    unsigned char* HID8; const float* sx; const int* rowidx; const float* sw; int nN;
    DI void operator()(EPI_ARGS) const {
        const int e = u.pm / MT_E, pnl = u.pn - e * nN;
        f32x4 sg[2], su[2];
#pragma unroll
        for (int bj = 0; bj < 2; ++bj) { const float* s = sw + (size_t)u.pn * 256 + bj * 128 + wc * 32 + 8 * fq; sg[bj] = *(const f32x4*)s; su[bj] = *(const f32x4*)(s + 4); }
        EPI_FOR_ROWS { const unsigned row = (unsigned)EPI_ROW; const float rs = sx[rowidx[row]];
            EPI_FOR_COLS { const unsigned col = (unsigned)(pnl * 256 + EPI_LCOL); const f32x4 g = acc[ai][bj][m][0] * sg[bj] * rs, up = acc[ai][bj][m][1] * su[bj] * rs;
                f32x4 h;
#pragma unroll
                for (int i = 0; i < 4; ++i) h[i] = fminf(fmaxf(g[i] / (1.f + __expf(-g[i])) * up[i] * HID_SCALE, -448.f), 448.f);
                int w = __builtin_amdgcn_cvt_pk_fp8_f32(h[0], h[1], 0, false); w = __builtin_amdgcn_cvt_pk_fp8_f32(h[2], h[3], w, true);
                *(unsigned*)(HID8 + (row * 1024u + (col >> 1))) = (unsigned)w;
            } EPI_ROW_END; }
    }
};
struct EpiMoe2F8 {
    static constexpr bool PERM = true, AFTER_DRAIN = false;
    bf16* Y; const float* gate; const float* swd; int nN;
    DI void operator()(EPI_ARGS) const {
        const int e = u.pm / MT_E, pnl = u.pn - e * nN;
        f32x4 s0[2], s1[2];
#pragma unroll
        for (int bj = 0; bj < 2; ++bj) { const float* s = swd + (size_t)u.pn * 256 + bj * 128 + wc * 32 + 8 * fq; s0[bj] = *(const f32x4*)s * (1.f / HID_SCALE); s1[bj] = *(const f32x4*)(s + 4) * (1.f / HID_SCALE); }
        EPI_FOR_ROWS { const unsigned row = (unsigned)EPI_ROW; const float g = gate[row];
            EPI_FOR_COLS { const unsigned col = (unsigned)(pnl * 256 + EPI_LCOL);
                ST16(Y, (row * 1024u + col) * 2u, pack8(acc[ai][bj][m][0] * s0[bj] * g, acc[ai][bj][m][1] * s1[bj] * g));
            } EPI_ROW_END; }
    }
};
struct EpiMoe2 {
    static constexpr bool PERM = true, AFTER_DRAIN = false;
    bf16* Y; const float* gate; int nN;
    DI void operator()(EPI_ARGS) const {
        const int e = u.pm / MT_E, pnl = u.pn - e * nN;
        EPI_FOR_ROWS { const unsigned row = (unsigned)EPI_ROW; const float g = gate[row];
            EPI_FOR_COLS { const unsigned col = (unsigned)(pnl * 256 + EPI_LCOL);
                ST16(Y, (row * 1024u + col) * 2u, pack8(acc[ai][bj][m][0] * g, acc[ai][bj][m][1] * g));
            } EPI_ROW_END; }
    }
};
struct EpiA1 {
    static constexpr bool PERM = true, AFTER_DRAIN = false;
    unsigned char* ws; const f32x2* rope32; int row_off, col_off; unsigned* kch;
    DI void operator()(EPI_ARGS) const {
        const unsigned colt = (unsigned)(col_off + u.pn * 256); const unsigned s = colt >> 10;
        float kmx[2] = {0.f, 0.f};
        EPI_FOR_ROWS { const int row = row_off + EPI_ROW; int b, tpos, tr; row_info(row, b, tpos, tr);
            const unsigned tq = (unsigned)(b * 16 * SEQ + tpos), tk = (unsigned)(b * 16 * TKV + tpos);
            EPI_FOR_COLS { const unsigned sc = (colt & 1023u) + (unsigned)EPI_LCOL; f32x4 v0 = acc[ai][bj][m][0], v1 = acc[ai][bj][m][1];
                const unsigned hh = sc >> 6, d = sc & 63u;
                if (tr >= 0) rope8(v0, v1, (const f32x2*)((const char*)rope32 + (unsigned)(tr * 32 + (int)(d >> 1)) * 8u));
                if (s == 0) { v0 = v0 * (QSCALE_DIFF * 4.f); v1 = v1 * (QSCALE_DIFF * 4.f); }
                else { kmx[bj] = fmaxf(kmx[bj], (v0[0] * v0[0] + v0[1] * v0[1]) + (v0[2] * v0[2] + v0[3] * v0[3]) + (v1[0] * v1[0] + v1[1] * v1[1]) + (v1[2] * v1[2] + v1[3] * v1[3])); v0 = v0 * 0.25f; v1 = v1 * 0.25f; }
                const unsigned off = (s == 0) ? (unsigned)WS_Q1 + ((tq + hh * (unsigned)SEQ) * 64u + d) : (unsigned)WS_K1 + ((tk + hh * (unsigned)TKV) * 64u + d);
                { u32x2 w; int t0 = __builtin_amdgcn_cvt_pk_fp8_f32(v0[0], v0[1], 0, false); w.x = (unsigned)__builtin_amdgcn_cvt_pk_fp8_f32(v0[2], v0[3], t0, true);
                  int t1 = __builtin_amdgcn_cvt_pk_fp8_f32(v1[0], v1[1], 0, false); w.y = (unsigned)__builtin_amdgcn_cvt_pk_fp8_f32(v1[2], v1[3], t1, true);
                  *(u32x2*)((char*)ws + off) = w; }
            } EPI_ROW_END; }
        if (s == 1) { const int row0 = row_off + u.pm * 256; const int b = row0 < NL ? (row0 >> 13) : ((row0 - NL) >> 8);
#pragma unroll
            for (int bj = 0; bj < 2; ++bj) { const unsigned sc = (colt & 1023u) + (unsigned)(bj * 128 + wc * 32 + 8 * fq);
                const float mx = max16_dpp(kmx[bj]);
                if (fr == 0) atomicMax(kch + (b * 16 + (sc >> 6)) * 8 + ((sc & 63u) >> 3), __float_as_uint(mx)); } }
    }
};
struct EpiV1T {
    static constexpr bool PERM = true, AFTER_DRAIN = false;
    unsigned char* ws; int row_off;
    DI void operator()(EPI_ARGS) const {
        EPI_FOR_ROWS { const int row = row_off + EPI_ROW; int b, tpos, tr; row_info(row, b, tpos, tr);
            const unsigned rowpart = (unsigned)WS_V1 + ((unsigned)b * 8u * 128u * (unsigned)TKV + vt_pos8((unsigned)tpos));
            EPI_FOR_COLS { const unsigned sc = (unsigned)(u.pn * 256 + EPI_LCOL);
                st_vt8f(ws, rowpart + sc * (unsigned)TKV, acc[ai][bj][m][0], acc[ai][bj][m][1]);
            } EPI_ROW_END; }
    }
};

struct GroupedOrder {
    int MT, nN, c, G;
    DI bool next(int i, Unit& u) const {
        const int x = c & 7, j = c >> 3, per = G >> 3, q = i * per + j, per_e = MT * nN;
        if (q >= 2 * per_e) return false;
        const int el = q / per_e, rem = q - el * per_e, e = 2 * x + el;
        const int nig = 8 * nN, gid = rem / nig, fm = gid * 8, gsz = (MT - fm) < 8 ? (MT - fm) : 8, w = rem - gid * nig;
        u.pm = e * MT_E + fm + (w % gsz); u.pn = e * nN + (w / gsz); return true;
    }
    DI void a_ready(const Unit&) const {}
    DI void done(const Unit&) const {}
};
#define XB_TMO      128
#define XB_XCNT(j)  (256  + 64 * (j))
#define XB_XSUB(j)  (1280 + 64 * (j))
#define XB_XGEN(j)  (2304 + 64 * (j))
#define XB_TOP      3328
#define XB_TOPGEN   3392
#define XCD_BAR_WORDS 3456
#define XB_SPIN_CAP (1u << 18)

__device__ __forceinline__ unsigned xb_ld(unsigned* p)              { return __hip_atomic_load(p, __ATOMIC_RELAXED, __HIP_MEMORY_SCOPE_AGENT); }
__device__ __forceinline__ unsigned xb_add(unsigned* p, unsigned v) { return __hip_atomic_fetch_add(p, v, __ATOMIC_RELAXED, __HIP_MEMORY_SCOPE_AGENT); }
__device__ __forceinline__ unsigned xb_xcc_id() { return (unsigned)__builtin_amdgcn_s_getreg((3 << 11) | 20) & 0xFu; }
#define XB_SPIN(cond, bar) do { unsigned _sp = 0; while (cond) { __builtin_amdgcn_s_sleep(1); \
    if ((++_sp & 255u) == 0u) { if (xb_ld(&(bar)[XB_TMO])) break; if (_sp > XB_SPIN_CAP) { atomicAdd(&(bar)[XB_TMO], 1u); break; } } } } while (0)

struct XcdBarrier {
    unsigned* bar; unsigned x;
    volatile LAS unsigned* st;
};

__device__ __forceinline__ bool xb_thread0(const int wid) { unsigned ln = __builtin_amdgcn_mbcnt_hi(~0u, __builtin_amdgcn_mbcnt_lo(~0u, 0u)); asm volatile("" : "+v"(ln)); return wid == 0 && ln == 0u; }
__device__ __forceinline__ XcdBarrier xcd_barrier_post(unsigned* bar, volatile LAS unsigned* st, const int wid) {
    XcdBarrier b; b.bar = bar; b.x = xb_xcc_id(); b.st = st;
    if (xb_thread0(wid)) (void)xb_add(&bar[XB_XCNT(b.x)], 1u);
    return b;
}
__device__ __forceinline__ void xcd_barrier_complete(unsigned* bar, unsigned x, unsigned& nloc, unsigned& nx) {
    const unsigned G = gridDim.x * gridDim.y * gridDim.z;
    unsigned sum, cnt, mine, sp = 0u;
    for (;;) {
        sum = 0u; cnt = 0u; mine = 0u;
#pragma unroll
        for (unsigned j = 0; j < 16; ++j) { const unsigned c = xb_ld(&bar[XB_XCNT(j)]); sum += c; cnt += (c > 0u) ? 1u : 0u; mine = (j == x) ? c : mine; }
        if (sum == G) break;
        __builtin_amdgcn_s_sleep(1);
        if ((++sp & 255u) == 0u) { if (xb_ld(&bar[XB_TMO])) break; if (sp > XB_SPIN_CAP) { atomicAdd(&bar[XB_TMO], 1u); break; } }
    }
    nloc = mine > 0u ? mine : 1u; nx = cnt > 0u ? cnt : 1u;
}

__device__ __forceinline__ void xcd_barrier(const XcdBarrier& b, const int wid) {
    asm volatile("s_waitcnt vmcnt(0)" ::: "memory");
    __syncthreads();
    if (xb_thread0(wid)) {
        unsigned* bar = b.bar;
        __builtin_amdgcn_s_waitcnt(0);
        unsigned nloc = b.st[0], nx = b.st[1];
        if (nloc == 0u) { xcd_barrier_complete(bar, b.x, nloc, nx); b.st[0] = nloc; b.st[1] = nx; }
        const unsigned old = xb_add(&bar[XB_XSUB(b.x)], 1u);
        const unsigned gen = old / nloc;
        if (old + 1u == (gen + 1u) * nloc) {
            __builtin_amdgcn_fence(__ATOMIC_RELEASE, "agent");
            asm volatile("s_waitcnt vmcnt(0)" ::: "memory");
            const unsigned og = xb_add(&bar[XB_TOP], 1u);
            const unsigned tg = og / nx;
            if (og + 1u == (tg + 1u) * nx) xb_add(&bar[XB_TOPGEN], 1u);
            else XB_SPIN(xb_ld(&bar[XB_TOPGEN]) == tg, bar);
            __builtin_amdgcn_fence(__ATOMIC_ACQUIRE, "agent");
            xb_add(&bar[XB_XGEN(b.x)], 1u);
            asm volatile("s_waitcnt vmcnt(0)" ::: "memory");
        } else {
            XB_SPIN(xb_ld(&bar[XB_XGEN(b.x)]) == gen, bar);
            __builtin_amdgcn_fence(__ATOMIC_ACQUIRE, "agent");
            asm volatile("s_waitcnt vmcnt(0)" ::: "memory");
        }
    }
    __syncthreads();
}
__device__ const float INVF8[8] = {1.000000000e+00f, 3.162277639e-01f, 1.000000015e-01f, 3.162277490e-02f, 9.999999776e-03f, 3.162277630e-03f, 1.000000047e-03f, 3.162277571e-04f};
__device__ const float INVF16[16] = {1.000000000e+00f, 5.623413324e-01f, 3.162277639e-01f, 1.778279394e-01f, 1.000000015e-01f, 5.623413250e-02f, 3.162277490e-02f, 1.778279431e-02f,
                                     9.999999776e-03f, 5.623413250e-03f, 3.162277630e-03f, 1.778279431e-03f, 1.000000047e-03f, 5.623413017e-04f, 3.162277571e-04f, 1.778279402e-04f};
struct Ctx {
    unsigned char* lds; int tid, lane, wave, bid, G, gw, NGW;
};
DI Ctx make_ctx(unsigned char* lds, const int wid) {
    Ctx c; c.lds = lds; int ln = (int)__builtin_amdgcn_mbcnt_hi(~0u, __builtin_amdgcn_mbcnt_lo(~0u, 0u)); asm volatile("" : "+v"(ln)); c.lane = ln; c.wave = wid; c.tid = wid * 64 + c.lane;
    c.bid = blockIdx.x; c.G = gridDim.x; c.gw = c.bid * NWAVES + c.wave; c.NGW = c.G * NWAVES; return c;
}

DI unsigned pk4_fp8(float a, float b, float c, float d) { int w = __builtin_amdgcn_cvt_pk_fp8_f32(a, b, 0, false); w = __builtin_amdgcn_cvt_pk_fp8_f32(c, d, w, true); return (unsigned)w; }
DI void moe_quant_item(const Ctx& c, const float* W, int n0, int mode, int which, unsigned char* W8e, float* SWe) {
    LAS float* tile = (LAS float*)((LAS unsigned char*)c.lds);
    LAS float* red = tile + 1024 * 33;
    const int col = c.lane & 31, half = c.lane >> 5;
    float mx = 0.f;
    const float* src = W + (size_t)(c.wave * 128 + half) * 1024 + n0 + col;
    LAS float* dst = tile + (c.wave * 128 + half) * 33 + col;
#pragma unroll 8
    for (int i = 0; i < 64; ++i) { const float v = src[(size_t)i * 2048]; mx = fmaxf(mx, fabsf(v)); dst[i * 66] = v; }
    red[(c.wave * 2 + half) * 32 + col] = mx;
    __syncthreads();
    const int cc = c.lane & 7;
#pragma unroll
    for (int j = 0; j < 4; ++j) { const int n = (c.lane >> 3) + 8 * j;
        float am = 0.f;
#pragma unroll
        for (int q = 0; q < 16; ++q) am = fmaxf(am, red[q * 32 + n]);
        const float sc = am > 0.f ? am * (1.f / 448.f) : 1.f, inv = 1.f / sc;
        const LAS float* s = tile + (c.wave * 128 + 16 * cc) * 33 + n;
        u32x4 o;
        o.x = pk4_fp8(s[0 * 33] * inv, s[1 * 33] * inv, s[2 * 33] * inv, s[3 * 33] * inv); o.y = pk4_fp8(s[4 * 33] * inv, s[5 * 33] * inv, s[6 * 33] * inv, s[7 * 33] * inv);
        o.z = pk4_fp8(s[8 * 33] * inv, s[9 * 33] * inv, s[10 * 33] * inv, s[11 * 33] * inv); o.w = pk4_fp8(s[12 * 33] * inv, s[13 * 33] * inv, s[14 * 33] * inv, s[15 * 33] * inv);
        const int nn = n0 + n; const int drow = mode ? (((nn >> 2) << 3) + which * 4 + (nn & 3)) : nn;
        *(u32x4*)(W8e + (size_t)drow * 1024 + c.wave * 128 + 16 * cc) = o;
        if (c.wave == 0 && cc == 0) SWe[drow] = sc; }
    __syncthreads();
}
template <int MODE>
DI void transpose_item(const float* W, int K, int N, bf16* WT, LAS float* scr, int item, int lane, const float* kgain, int which) {
    const int nblk = N / 32, kb = item / nblk, nb = item - kb * nblk, k0 = 64 * kb, n0 = 32 * nb;
#pragma unroll 8
    for (int i = 0; i < 32; ++i) { const int kk = 2 * i + (lane >> 5); const float g = kgain ? kgain[k0 + kk] : 1.f; scr[kk * 33 + (lane & 31)] = W[(size_t)(k0 + kk) * N + n0 + (lane & 31)] * g; }
    LDS_WAIT(); asm volatile("" ::: "memory");
    const int c = lane & 7;
#pragma unroll
    for (int j = 0; j < 4; ++j) { const int n = (lane >> 3) + 8 * j; const LAS float* s = scr + (8 * c) * 33 + n;
        u32x4 o; o.x = cvt_pk(s[0 * 33], s[1 * 33]); o.y = cvt_pk(s[2 * 33], s[3 * 33]); o.z = cvt_pk(s[4 * 33], s[5 * 33]); o.w = cvt_pk(s[6 * 33], s[7 * 33]);
        const int nn = n0 + n; const int drow = MODE ? (((nn >> 2) << 3) + which * 4 + (nn & 3)) : nn;
        *(u32x4*)(WT + (size_t)drow * K + k0 + 8 * c) = o; }
    LDS_WAIT(); asm volatile("" ::: "memory");
}

DI void phase_prologue(const Params& p, const Ctx& c) {
    unsigned char* ws = p.ws;
    float* MOD = (float*)(ws + WS_MOD);
    for (int unit = c.bid; unit < 192; unit += c.G) {
        const int l = unit / 96, c0 = (unit % 96) * 64;
        float* sl = (float*)c.lds;
        for (int i = c.tid; i < 9 * 1024; i += NTHR) { const int bb = i >> 10, k = i & 1023; const float cv = bb < 8 ? p.in[I_C][bb * 1024 + k] : p.in[I_CCTX][k]; sl[i] = cv / (1.f + expf(-cv)); }
        __syncthreads();
        const float* W = p.in[l ? I_WMOD1 : I_WMOD0]; const float* bm = p.in[l ? I_BMOD1 : I_BMOD0];
        float a0 = 0, a1 = 0, a2 = 0, a3 = 0, a4 = 0, a5 = 0, a6 = 0, a7 = 0, a8 = 0;
        const int col = c0 + c.lane, ks = c.wave * 128;
        for (int k0 = ks; k0 < ks + 128; k0 += 16) { float wv[16];
#pragma unroll
            for (int u = 0; u < 16; ++u) wv[u] = W[(size_t)(k0 + u) * 6144 + col];
#pragma unroll
            for (int u = 0; u < 16; ++u) { const int k = k0 + u; const float w = wv[u];
                a0 += sl[k] * w; a1 += sl[1024 + k] * w; a2 += sl[2048 + k] * w; a3 += sl[3072 + k] * w; a4 += sl[4096 + k] * w;
                a5 += sl[5120 + k] * w; a6 += sl[6144 + k] * w; a7 += sl[7168 + k] * w; a8 += sl[8192 + k] * w; } }
        float* red = sl + 9 * 1024;
        float* rw = red + (c.wave * 9) * 64 + c.lane;
        rw[0] = a0; rw[64] = a1; rw[128] = a2; rw[192] = a3; rw[256] = a4; rw[320] = a5; rw[384] = a6; rw[448] = a7; rw[512] = a8;
        __syncthreads();
        for (int i = c.tid; i < 9 * 64; i += NTHR) { const int bb = i >> 6, cc = i & 63; float s = 0.f;
#pragma unroll
            for (int w = 0; w < 8; ++w) s += red[(w * 9 + bb) * 64 + cc];
            MOD[(size_t)(l * 9 + bb) * 6144 + c0 + cc] = s + bm[c0 + cc]; }
        __syncthreads();
    }
    LAS float* scr = (LAS float*)((LAS unsigned char*)c.lds + c.wave * 16384);
    constexpr int IT_IN0 = 16 * 45, IT_UQ = 4 * 24, IT_UKV = 2 * 32, IT_SQ = 16 * 32, IT_IN1 = 16 * 96;
    constexpr int NITEMS = IT_IN0 + IT_UQ + IT_UKV + IT_SQ + IT_IN1 + IT_SQ;
    for (int it = c.gw; it < NITEMS; it += c.NGW) {
        int r = it;
        if (r < IT_IN0) { transpose_item<0>(p.in[I_WIN0], 1024, 1440, (bf16*)(ws + WS_WIN0), scr, r, c.lane, nullptr, 0); continue; } r -= IT_IN0;
        if (r < IT_UQ) { transpose_item<0>(p.in[I_WUQ], 256, 768, (bf16*)(ws + WS_WUQ), scr, r, c.lane, p.in[I_QNORM], 0); continue; } r -= IT_UQ;
        if (r < IT_UKV) { transpose_item<0>(p.in[I_WUKV], 128, 1024, (bf16*)(ws + WS_WUKV), scr, r, c.lane, p.in[I_KVNORM], 0); continue; } r -= IT_UKV;
        if (r < IT_SQ) { transpose_item<0>(p.in[I_WOUT0], 1024, 1024, (bf16*)(ws + WS_WOUT0), scr, r, c.lane, nullptr, 0); continue; } r -= IT_SQ;
        if (r < IT_IN1) { transpose_item<0>(p.in[I_WIN1], 1024, 3072, (bf16*)(ws + WS_WIN1), scr, r, c.lane, nullptr, 0); continue; } r -= IT_IN1;
        if (r < IT_SQ) { transpose_item<0>(p.in[I_WOUT1], 1024, 1024, (bf16*)(ws + WS_WOUT1), scr, r, c.lane, nullptr, 0); continue; } r -= IT_SQ;
    }
    __syncthreads();
    { int first, cnt, stride;
      if (c.bid < 192) { first = c.bid; cnt = 11; stride = 192; } else { first = 2112 + (c.bid - 192); cnt = 14; stride = 64; }
      for (int k = 0; k <= cnt; ++k) {
        int r;
        if (k < cnt) r = first + k * stride; else if (c.bid < 64) r = 3008 + c.bid; else break;
        const int l = r / 1536, kind = (r / 512) % 3, e = (r >> 5) & 15, nb = r & 31;
        if (kind < 2) { const float* W = p.in[l ? (kind ? I_WUP1 : I_WGATE1) : (kind ? I_WUP0 : I_WGATE0)] + (size_t)e * 1024 * 1024;
            moe_quant_item(c, W, 32 * nb, 1, kind, ws + (l ? WS_WGU8_1 : WS_WGU8_0) + (size_t)e * 2048 * 1024, (float*)(ws + WS_SW) + (l ? NE * 2048 : 0) + e * 2048); }
        else { const float* W = p.in[l ? I_WDOWN1 : I_WDOWN0] + (size_t)e * 1024 * 1024;
            moe_quant_item(c, W, 32 * nb, 0, 0, ws + (l ? WS_WDN8_1 : WS_WDN8_0) + (size_t)e * 1024 * 1024, (float*)(ws + WS_SW) + 2 * NE * 2048 + (l ? NE * 1024 : 0) + e * 1024); }
      } }
    const int gt = c.bid * NTHR + c.tid, NGT = c.G * NTHR;
    f32x2* R16 = (f32x2*)(ws + WS_ROPE16); f32x2* R32 = (f32x2*)(ws + WS_ROPE32);
    for (int i = gt; i < SEQ * 48; i += NGT) { const int t = i / 48, jj = i - t * 48;
        int nf, j; if (jj < 16) { nf = 8; j = jj; } else { nf = 16; j = jj - 16; }
        const int f = j < nf ? j : j - nf; const float pos = (float)(j < nf ? (t >> 6) : (t & 63));
        const float invf = (nf == 8) ? INVF8[f] : INVF16[f];
        const float ang = pos * invf; const double da = (double)ang;
        const double qd = rint(da * 0.6366197723675814); const double y = fma(-qd, 1.5707963267948966, da) - qd * 6.123233995736766e-17; const double y2 = y * y;
        const double sy = y * (1.0 + y2 * (-1.0 / 6 + y2 * (1.0 / 120 + y2 * (-1.0 / 5040 + y2 * (1.0 / 362880 + y2 * (-1.0 / 39916800))))));
        const double cy = 1.0 + y2 * (-0.5 + y2 * (1.0 / 24 + y2 * (-1.0 / 720 + y2 * (1.0 / 40320 + y2 * (-1.0 / 3628800 + y2 * (1.0 / 479001600))))));
        const int qi = ((int)qd) & 3;
        const double cr = (qi == 0) ? cy : (qi == 1) ? -sy : (qi == 2) ? -cy : sy, sr = (qi == 0) ? sy : (qi == 1) ? cy : (qi == 2) ? -sy : -cy;
        const f32x2 cs = {(float)cr, (float)sr};
        if (jj < 16) R16[t * 16 + j] = cs; else R32[t * 32 + j] = cs; }
    bf16* GW = (bf16*)(ws + WS_GWS);
    for (int i = gt; i < 4 * 128 * 128 / 2; i += NGT) { const f32x2 v = *(const f32x2*)(p.in[I_GWS] + 2 * i); ((unsigned*)GW)[i] = cvt_pk(v.x, v.y); }
    unsigned* padz = (unsigned*)((bf16*)(ws + WS_WIN0) + (size_t)1440 * 1024);
    for (int i = gt; i < 96 * 1024 / 2; i += NGT) padz[i] = 0u;
}

DI void phase_mod_rows(const Ctx& c, const float* xl, const float* xc, const float* mod  , int sh_off, int sc_off, bf16* H) {
    for (int row = c.gw; row < NR; row += c.NGW) {
        const bool lat = row < NL; const int b = lat ? (row >> 13) : 8;
        const float* xs = lat ? xl + (size_t)row * 1024 : xc + (size_t)(row - NL) * 1024;
#pragma unroll
        for (int j = 0; j < 4; ++j) { const int col = 4 * c.lane + 256 * j;
            const f32x4 x = *(const f32x4*)(xs + col), sc = *(const f32x4*)(mod + b * 6144 + sc_off + col), sh = *(const f32x4*)(mod + b * 6144 + sh_off + col);
            const f32x4 h = x * (sc + 1.f) + sh;
            u32x2 w; w.x = cvt_pk(h[0], h[1]); w.y = cvt_pk(h[2], h[3]);
            *(u32x2*)(H + (size_t)row * 1024 + col) = w; }
    }
}

DI void phase_gmlp(const Params& p, const Ctx& c, bf16* UVd) {
    unsigned char* ws = p.ws;
    bf16* UV = (bf16*)(ws + WS_UV); const bf16* CQ = (const bf16*)(ws + WS_CQ); const bf16* CKV = (const bf16*)(ws + WS_CKV);
    float* RQ = (float*)(ws + WS_RQ); float* RKV = (float*)(ws + WS_RKV); const bf16* GW = (const bf16*)(ws + WS_GWS);
    const float* lng = p.in[I_GLNG]; const float* lnb = p.in[I_GLNB]; const float* bs = p.in[I_GBS];
    constexpr int PITCH = 136;
    bf16* WsL = (bf16*)c.lds;
    bf16* VT = WsL + 128 * PITCH;
    f32x2* st = (f32x2*)(VT + 128 * PITCH);
    const int tk = c.tid >> 2, part = c.tid & 3;
    for (int unit = c.bid; unit < (NR / 128) * 4; unit += c.G) {
        const int ch = unit >> 2, g = unit & 3, row0 = ch * 128;
        {
            const bf16* vrow = UV + (size_t)(row0 + tk) * 1024 + 512 + part * 128; float s = 0.f, s2 = 0.f;
#pragma unroll
            for (int i = 0; i < 16; ++i) { const u32x4 w = *(const u32x4*)(vrow + 8 * i);
#pragma unroll
                for (int k = 0; k < 4; ++k) { const float a = bf_lo(w[k]), b = bf_hi(w[k]); s += a + b; s2 += a * a + b * b; } }
            s += __shfl_xor(s, 1); s += __shfl_xor(s, 2); s2 += __shfl_xor(s2, 1); s2 += __shfl_xor(s2, 2);
            const float mean = s * (1.f / 512.f), var = fmaxf(s2 * (1.f / 512.f) - mean * mean, 0.f);
            if (part == 0) st[tk] = (f32x2){mean, 1.f / sqrtf(var + 1e-5f)};
            if (g == 0) {
                const bf16* q = CQ + (size_t)(row0 + tk) * 256 + part * 64; float ss = 0.f;
#pragma unroll
                for (int i = 0; i < 8; ++i) { const u32x4 w = *(const u32x4*)(q + 8 * i);
#pragma unroll
                    for (int k = 0; k < 4; ++k) { const float a = bf_lo(w[k]), b = bf_hi(w[k]); ss += a * a + b * b; } }
                ss += __shfl_xor(ss, 1); ss += __shfl_xor(ss, 2);
                const bf16* kv = CKV + (size_t)(row0 + tk) * 128 + part * 32; float sk = 0.f;
#pragma unroll
                for (int i = 0; i < 4; ++i) { const u32x4 w = *(const u32x4*)(kv + 8 * i);
#pragma unroll
                    for (int k = 0; k < 4; ++k) { const float a = bf_lo(w[k]), b = bf_hi(w[k]); sk += a * a + b * b; } }
                sk += __shfl_xor(sk, 1); sk += __shfl_xor(sk, 2);
                if (part == 0) { RQ[row0 + tk] = 1.f / sqrtf(ss * (1.f / 256.f) + 1e-6f); RKV[row0 + tk] = 1.f / sqrtf(sk * (1.f / 128.f) + 1e-6f); }
            }
        }
        for (int i = c.tid; i < 2048; i += NTHR) { const int pr = i >> 4, qc = (i & 15) * 8; *(u32x4*)(WsL + pr * PITCH + qc) = *(const u32x4*)(GW + (size_t)g * 16384 + pr * 128 + qc); }
        __syncthreads();
        {
            const f32x2 ms = st[tk]; const bf16* vrow = UV + (size_t)(row0 + tk) * 1024 + 512 + g * 128 + part * 32;
#pragma unroll
            for (int i = 0; i < 4; ++i) { const u32x4 w = *(const u32x4*)(vrow + 8 * i);
#pragma unroll
                for (int k = 0; k < 4; ++k) { const int cc = part * 32 + 8 * i + 2 * k; const int cg = g * 128 + cc;
                    const float a = (bf_lo(w[k]) - ms.x) * ms.y * lng[cg] + lnb[cg], b = (bf_hi(w[k]) - ms.x) * ms.y * lng[cg + 1] + lnb[cg + 1];
                    const unsigned pk = cvt_pk(a, b);
                    VT[cc * PITCH + tk] = (bf16)(pk & 0xffffu); VT[(cc + 1) * PITCH + tk] = (bf16)(pk >> 16); } }
        }
        __syncthreads();
        f32x4 acc[8];
#pragma unroll
        for (int pt = 0; pt < 8; ++pt) acc[pt] = (f32x4){0.f, 0.f, 0.f, 0.f};
        const int fr = c.lane & 15, fq = c.lane >> 4;
#pragma unroll
        for (int ks = 0; ks < 4; ++ks) {
            const bf16x8 a = *(const bf16x8*)(VT + (16 * c.wave + fr) * PITCH + 32 * ks + 8 * fq);
#pragma unroll
            for (int pt = 0; pt < 8; ++pt) { const bf16x8 b = *(const bf16x8*)(WsL + (16 * pt + fr) * PITCH + 32 * ks + 8 * fq);
                acc[pt] = __builtin_amdgcn_mfma_f32_16x16x32_bf16(a, b, acc[pt], 0, 0, 0); }
        }
#pragma unroll
        for (int pt = 0; pt < 8; ++pt) { const int pp = 16 * pt + fr; const float bias = bs[g * 128 + pp];
            bf16* up = UV + (size_t)(row0 + pp) * 1024 + g * 128 + 16 * c.wave + 4 * fq;
            const u32x2 uu = *(const u32x2*)up;
            u32x2 w; w.x = cvt_pk(bf_lo(uu.x) * (acc[pt][0] + bias), bf_hi(uu.x) * (acc[pt][1] + bias)); w.y = cvt_pk(bf_lo(uu.y) * (acc[pt][2] + bias), bf_hi(uu.y) * (acc[pt][3] + bias));
            *(u32x2*)(UVd + (up - UV)) = w; }
        __syncthreads();
    }
}

DI f32x4 ld4(const float* p) { return *(const f32x4*)p; }
DI void router_reduce(float (&lg)[16], const int lane) {
    const bool b5 = (lane & 32) != 0, b4 = (lane & 16) != 0, b3 = (lane & 8) != 0, b2 = (lane & 4) != 0;
#pragma unroll
    for (int e = 0; e < 8; ++e) { const float send = b5 ? lg[e] : lg[e + 8], keep = b5 ? lg[e + 8] : lg[e]; lg[e] = keep + __shfl_xor(send, 32); }
#pragma unroll
    for (int e = 0; e < 4; ++e) { const float send = b4 ? lg[e] : lg[e + 4], keep = b4 ? lg[e + 4] : lg[e]; lg[e] = keep + __shfl_xor(send, 16); }
#pragma unroll
    for (int e = 0; e < 2; ++e) { const float send = b3 ? lg[e] : lg[e + 2], keep = b3 ? lg[e + 2] : lg[e]; lg[e] = keep + __shfl_xor(send, 8); }
    { const float send = b2 ? lg[0] : lg[1], keep = b2 ? lg[1] : lg[0]; lg[0] = keep + __shfl_xor(send, 4); }
    lg[0] += __shfl_xor(lg[0], 2); lg[0] += __shfl_xor(lg[0], 1);
}
DI f32x4 ldbf4(const bf16* p) { const u32x2 w = *(const u32x2*)p; return (f32x4){bf_lo(w.x), bf_hi(w.x), bf_lo(w.y), bf_hi(w.y)}; }
DI void stbf4(bf16* p, f32x4 v) { u32x2 w; w.x = cvt_pk(v[0], v[1]); w.y = cvt_pk(v[2], v[3]); *(u32x2*)p = w; }
DI void phase_ln_router(const Ctx& c, const bf16* T16, bf16* X1, const float* lng, const float* lnb, const float* mod  , const float* router  ,
                        unsigned char* H8, float* SX, float* AFF, float* AFFC, int nrows) {
    float* rt = (float*)c.lds;
    for (int i = c.tid; i < 16384; i += NTHR) { const int k = i >> 4, e = i & 15; rt[e * 1024 + k] = router[i]; }
    __syncthreads();
    const int eidx = ((c.lane >> 2) & 1) | (((c.lane >> 3) & 1) << 1) | (((c.lane >> 4) & 1) << 2) | (((c.lane >> 5) & 1) << 3);
    for (int row = 2 * c.gw; row < nrows; row += 2 * c.NGW) {
        const bool lat = row < NL; const int b = lat ? (row >> 13) : 8;
        const bf16* ta = T16 + (size_t)row * 1024; const bf16* tb = ta + 1024;
        bf16* da = X1 + (size_t)row * 1024; bf16* db = da + 1024;
        const float* mrow = mod + b * 6144;
        f32x4 xa[4], xb[4]; float sa = 0.f, sa2 = 0.f, sb = 0.f, sb2 = 0.f;
#pragma unroll
        for (int j = 0; j < 4; ++j) { xa[j] = ldbf4(ta + 4 * c.lane + 256 * j); xb[j] = ldbf4(tb + 4 * c.lane + 256 * j); }
#pragma unroll
        for (int j = 0; j < 4; ++j) { sa += (xa[j][0] + xa[j][1]) + (xa[j][2] + xa[j][3]); sb += (xb[j][0] + xb[j][1]) + (xb[j][2] + xb[j][3]); }
        const float ma = wave_sum(sa) * (1.f / 1024.f), mb = wave_sum(sb) * (1.f / 1024.f);
#pragma unroll
        for (int j = 0; j < 4; ++j) { xa[j] = xa[j] - ma; xb[j] = xb[j] - mb;
            sa2 += (xa[j][0] * xa[j][0] + xa[j][1] * xa[j][1]) + (xa[j][2] * xa[j][2] + xa[j][3] * xa[j][3]);
            sb2 += (xb[j][0] * xb[j][0] + xb[j][1] * xb[j][1]) + (xb[j][2] * xb[j][2] + xb[j][3] * xb[j][3]); }
        const float ra = 1.f / sqrtf(wave_sum(sa2) * (1.f / 1024.f) + 1e-5f), rb = 1.f / sqrtf(wave_sum(sb2) * (1.f / 1024.f) + 1e-5f);
        float ivA, ivB;
        { float amA = 0.f, amB = 0.f;
#pragma unroll
          for (int j = 0; j < 4; ++j) { const int col = 4 * c.lane + 256 * j;
              const f32x4 g = ld4(lng + col), bt = ld4(lnb + col), sc = ld4(mrow + 4 * 1024 + col) + 1.f, sh = ld4(mrow + 3 * 1024 + col);
              const f32x4 ha = (xa[j] * ra * g + bt) * sc + sh, hb = (xb[j] * rb * g + bt) * sc + sh;
              amA = fmaxf(amA, fmaxf(fmaxf(fabsf(ha[0]), fabsf(ha[1])), fmaxf(fabsf(ha[2]), fabsf(ha[3])))); amB = fmaxf(amB, fmaxf(fmaxf(fabsf(hb[0]), fabsf(hb[1])), fmaxf(fabsf(hb[2]), fabsf(hb[3])))); }
          amA = wave_max(amA); amB = wave_max(amB);
          const float scA = amA > 0.f ? amA * (1.f / 448.f) : 1.f, scB = amB > 0.f ? amB * (1.f / 448.f) : 1.f; ivA = 1.f / scA; ivB = 1.f / scB;
          if (c.lane == 0) { SX[row] = scA; SX[row + 1] = scB; }
          __builtin_amdgcn_sched_barrier(0); }
        float la[16], lb[16];
#pragma unroll
        for (int e = 0; e < 16; ++e) { la[e] = 0.f; lb[e] = 0.f; }
#pragma unroll
        for (int j = 0; j < 4; ++j) { const int col = 4 * c.lane + 256 * j;
            const f32x4 g = ld4(lng + col), bt = ld4(lnb + col), sc = ld4(mrow + 4 * 1024 + col) + 1.f, sh = ld4(mrow + 3 * 1024 + col);
            const f32x4 x1a = xa[j] * ra * g + bt, x1b = xb[j] * rb * g + bt;
            stbf4(da + col, x1a); stbf4(db + col, x1b);
            const f32x4 ha = x1a * sc + sh, hb = x1b * sc + sh;
            *(unsigned*)(H8 + (size_t)row * 1024 + col) = pk4_fp8(ha[0] * ivA, ha[1] * ivA, ha[2] * ivA, ha[3] * ivA);
            *(unsigned*)(H8 + (size_t)(row + 1) * 1024 + col) = pk4_fp8(hb[0] * ivB, hb[1] * ivB, hb[2] * ivB, hb[3] * ivB);
#pragma unroll
            for (int e = 0; e < 16; ++e) { const f32x4 w = *(const f32x4*)(rt + e * 1024 + col);
                la[e] += (ha[0] * w[0] + ha[1] * w[1]) + (ha[2] * w[2] + ha[3] * w[3]); lb[e] += (hb[0] * w[0] + hb[1] * w[1]) + (hb[2] * w[2] + hb[3] * w[3]); } }
        router_reduce(la, c.lane); router_reduce(lb, c.lane);
        const float mxa = wave_max(la[0]), mxb = wave_max(lb[0]); const float ea = expf(la[0] - mxa), eb = expf(lb[0] - mxb);
        const float sea = wave_sum(ea) * 0.25f, seb = wave_sum(eb) * 0.25f;
        float* dst = lat ? AFF + (size_t)(b * 16) * SEQ + (row & (SEQ - 1)) : AFFC + (size_t)(((row - NL) >> 8) * 16) * CTX + ((row - NL) & (CTX - 1));
        const int estride = lat ? SEQ : CTX;
        if ((c.lane & 3) == 0) { dst[(size_t)eidx * estride] = ea / sea; dst[(size_t)eidx * estride + 1] = eb / seb; }
    }
    __syncthreads();
}

template <int PER>
DI void topk_unit(const Ctx& c, const float* aff, int n, int k, int* rowidx_out, float* gate_out, int* slotrow, int e, int tokrow0, int yrow0) {
    unsigned* cnts = (unsigned*)c.lds;
    unsigned* wtot = cnts + 16;
    const int i0 = c.tid * PER; const bool active = i0 < n;
    unsigned v[PER];
    if constexpr (PER == 16) {
#pragma unroll
        for (int q = 0; q < 4; ++q) { const u32x4 w = active ? *(const u32x4*)((const unsigned*)aff + i0 + 4 * q) : (u32x4){0u, 0u, 0u, 0u}; v[4 * q] = w.x; v[4 * q + 1] = w.y; v[4 * q + 2] = w.z; v[4 * q + 3] = w.w; }
    } else { v[0] = active ? __float_as_uint(aff[i0]) : 0u; }
    unsigned T = 0u;
    for (int b = 30; b >= 0; --b) {
        const unsigned cand = T | (1u << b); unsigned cw = 0u;
#pragma unroll
        for (int j = 0; j < PER; ++j) cw += (unsigned)__popcll(__ballot(v[j] >= cand));
        unsigned* cb = cnts + (b & 1) * 8;
        if (c.lane == 0) cb[c.wave] = cw;
        __syncthreads();
        unsigned tot = 0u;
#pragma unroll
        for (int w = 0; w < 8; ++w) tot += cb[w];
        if (tot >= (unsigned)k) T = cand;
    }
    unsigned cg = 0, ce = 0;
#pragma unroll
    for (int j = 0; j < PER; ++j) { cg += (v[j] > T) ? 1u : 0u; ce += (v[j] == T && active) ? 1u : 0u; }
    const unsigned packed = cg | (ce << 16); unsigned incl = packed;
#pragma unroll
    for (int o = 1; o < 64; o <<= 1) { const unsigned t = __shfl_up(incl, o); if (c.lane >= o) incl += t; }
    if (c.lane == 63) wtot[c.wave] = incl;
    __syncthreads();
    unsigned off = 0u, tot_gt = 0u;
    for (int w = 0; w < 8; ++w) { const unsigned t = wtot[w]; if (w < c.wave) off += t; tot_gt += t & 0xffffu; }
    const unsigned need_eq = (unsigned)k - tot_gt, cnt_gt = tot_gt;
    const unsigned excl = incl - packed + off; unsigned g_off = excl & 0xffffu, e_off = excl >> 16;
    if (active) { int sl[PER];
#pragma unroll
        for (int j = 0; j < PER; ++j) { const int i = i0 + j; const unsigned x = v[j]; int slot = -1;
            if (x > T) slot = (int)(g_off++);
            else if (x == T) { if (e_off < need_eq) slot = (int)(cnt_gt + e_off); ++e_off; }
            if (slot >= 0) { rowidx_out[slot] = tokrow0 + i; gate_out[slot] = __uint_as_float(x); sl[j] = yrow0 + slot; } else sl[j] = -1; }
        if constexpr (PER == 16) {
#pragma unroll
            for (int q = 0; q < 4; ++q) *(u32x4*)(slotrow + i0 + 4 * q) = (u32x4){(unsigned)sl[4 * q], (unsigned)sl[4 * q + 1], (unsigned)sl[4 * q + 2], (unsigned)sl[4 * q + 3]};
        } else slotrow[i0] = sl[0];
    }
    __syncthreads();
}
DI void phase_topk(const Params& p, const Ctx& c, bool with_ctx) {
    unsigned char* ws = p.ws;
    const float* AFF = (const float*)(ws + WS_AFF); const float* AFFC = (const float*)(ws + WS_AFFC);
    int* ROWIDX = (int*)(ws + WS_ROWIDX); float* ROWGATE = (float*)(ws + WS_ROWGATE); int* SLOTROW = (int*)(ws + WS_SLOTROW);
    const int nunits = with_ctx ? 256 : 128;
    for (int unit = c.bid; unit < nunits; unit += c.G) {
        if (unit < 128) { const int b = unit >> 4, e = unit & 15;
            topk_unit<16>(c, AFF + (size_t)(b * 16 + e) * SEQ, SEQ, CAPL, ROWIDX + e * ROWS_E + b * CAPL, ROWGATE + e * ROWS_E + b * CAPL, SLOTROW + (size_t)(b * 16 + e) * SEQ, e, b * SEQ, e * ROWS_E + b * CAPL); }
        else { const int uu = unit - 128, b = uu >> 4, e = uu & 15;
            topk_unit<1>(c, AFFC + (size_t)(b * 16 + e) * CTX, CTX, CAPC, ROWIDX + e * ROWS_E + NB * CAPL + b * CAPC, ROWGATE + e * ROWS_E + NB * CAPL + b * CAPC, SLOTROW + (size_t)NL * 16 + (size_t)(b * 16 + e) * CTX, e, NL + b * CTX, e * ROWS_E + NB * CAPL + b * CAPC); }
    }
}

DI void quant_row_fp8(const bf16* src, unsigned char* dst, float* scale_out, int lane) {
    const u32x4* s = (const u32x4*)src + 2 * lane; const u32x4 a = s[0], b = s[1];
    float v[16];
#pragma unroll
    for (int k = 0; k < 4; ++k) { v[2 * k] = bf_lo(a[k]); v[2 * k + 1] = bf_hi(a[k]); v[8 + 2 * k] = bf_lo(b[k]); v[8 + 2 * k + 1] = bf_hi(b[k]); }
    float mx = 0.f;
#pragma unroll
    for (int k = 0; k < 16; ++k) mx = fmaxf(mx, fabsf(v[k]));
    mx = wave_max(mx);
    const float sc = mx > 0.f ? mx * (1.f / 448.f) : 1.f, inv = 1.f / sc;
    u32x4 o;
    o.x = pk4_fp8(v[0] * inv, v[1] * inv, v[2] * inv, v[3] * inv); o.y = pk4_fp8(v[4] * inv, v[5] * inv, v[6] * inv, v[7] * inv);
    o.z = pk4_fp8(v[8] * inv, v[9] * inv, v[10] * inv, v[11] * inv); o.w = pk4_fp8(v[12] * inv, v[13] * inv, v[14] * inv, v[15] * inv);
    *((u32x4*)dst + lane) = o;
    if (lane == 0) *scale_out = sc;
}
DI void phase_quant_rows(const Params& p, const Ctx& c, int nrows, int first_block) {
    unsigned char* ws = p.ws; const bf16* H = (const bf16*)(ws + WS_H); unsigned char* H8 = ws + WS_XS; float* SX = (float*)(ws + WS_SX);
    if (c.bid < first_block) return;
    const int ngw = (c.G - first_block) * NWAVES;
    for (int r = (c.bid - first_block) * NWAVES + c.wave; r < nrows; r += ngw) quant_row_fp8(H + (size_t)r * 1024, H8 + (size_t)r * 1024, SX + r, c.lane);
}
DI void phase_kr(const Params& p, const Ctx& c) {
    unsigned char* ws = p.ws; const bf16* KR = (const bf16*)(ws + WS_KR); bf16* K0 = (bf16*)(ws + WS_K0); const f32x2* R16 = (const f32x2*)(ws + WS_ROPE16);
    unsigned* kchr = (unsigned*)(ws + WS_CTL) + CW_KCHR;
    const int gt = c.bid * NTHR + c.tid, NGT = c.G * NTHR;
    for (int i = gt; i < NR * 4; i += NGT) { const int row = i >> 2, ch = i & 3;
        const u32x4 w = *(const u32x4*)(KR + (size_t)row * 32 + ch * 8);
        f32x4 v0 = {bf_lo(w.x), bf_hi(w.x), bf_lo(w.y), bf_hi(w.y)}, v1 = {bf_lo(w.z), bf_hi(w.z), bf_lo(w.w), bf_hi(w.w)};
        int b, tpos, tr; row_info(row, b, tpos, tr);
        if (tr >= 0) rope8(v0, v1, R16 + tr * 16 + ch * 4);
        const u32x2 o = pack8_fp8(v0 * 0.25f, v1 * 0.25f); const u32x2 z = {0u, 0u};
#pragma unroll
        for (int h = 0; h < 8; ++h) { unsigned char* kr_ = (unsigned char*)K0 + ((size_t)(b * 8 + h) * TKV + tpos) * 128; *(u32x2*)(kr_ + 64 + ch * 8) = o; *(u32x2*)(kr_ + 96 + ch * 8) = z; }
        const float n2 = (v0[0] * v0[0] + v0[1] * v0[1]) + (v0[2] * v0[2] + v0[3] * v0[3]) + (v1[0] * v1[0] + v1[1] * v1[1]) + (v1[2] * v1[2] + v1[3] * v1[3]);
        float mx = n2; mx = fmaxf(mx, __shfl_xor(mx, 4)); mx = fmaxf(mx, __shfl_xor(mx, 8)); mx = fmaxf(mx, __shfl_xor(mx, 16)); mx = fmaxf(mx, __shfl_xor(mx, 32));
        if ((c.lane >> 2) == 0) atomicMax(kchr + b * 4 + ch, __float_as_uint(mx)); }
}
DI void quant_wgu(const Ctx& c, const bf16* W, unsigned char* W8, float* SW, int nrows, int first_block = 0) {
    if (c.bid < first_block) return;
    const int ngw = (c.G - first_block) * NWAVES;
    for (int n = (c.bid - first_block) * NWAVES + c.wave; n < nrows; n += ngw) quant_row_fp8(W + (size_t)n * 1024, W8 + (size_t)n * 1024, SW + n, c.lane);
}

DI void acc_y(f32x4 (&f)[4], const u32x2 (&y)[4]) {
#pragma unroll
    for (int j = 0; j < 4; ++j) { f[j][0] += bf_lo(y[j].x); f[j][1] += bf_hi(y[j].x); f[j][2] += bf_lo(y[j].y); f[j][3] += bf_hi(y[j].y); }
}
DI void ld_y(u32x2 (&y)[4], const bf16* Y, int s, int lane) {
    const bf16* yr = Y + (size_t)s * 1024 + 4 * lane;
#pragma unroll
    for (int j = 0; j < 4; ++j) y[j] = *(const u32x2*)(yr + 256 * j);
}
DI void phase_combine_ln(const Ctx& c, const bf16* X1, float* OUTL, float* OUTC, const bf16* Y, const int* SLOTROW, const float* lng, const float* lnb,
                         const float* mod  , const float* modn  , bf16* H, int nrows) {
    for (int row = 2 * c.gw; row < nrows; row += 2 * c.NGW) {
        const bool lat = row < NL; const int b = lat ? (row >> 13) : 8;
        const bf16* xs = X1 + (size_t)row * 1024; float* os = lat ? OUTL + (size_t)row * 1024 : OUTC + (size_t)(row - NL) * 1024;
        int sl = -1;
        if (c.lane < 32) { const int ee = c.lane & 15, dt = c.lane >> 4;
            sl = lat ? SLOTROW[(size_t)((row >> 13) * 16 + ee) * SEQ + (row & (SEQ - 1)) + dt] : SLOTROW[(size_t)NL * 16 + (size_t)(((row - NL) >> 8) * 16 + ee) * CTX + ((row - NL) & (CTX - 1)) + dt]; }
        f32x4 xa[4], xb[4];
#pragma unroll
        for (int j = 0; j < 4; ++j) { xa[j] = ldbf4(xs + 4 * c.lane + 256 * j); xb[j] = ldbf4(xs + 1024 + 4 * c.lane + 256 * j); }
        const unsigned long long bal = __ballot(sl >= 0);
        unsigned mA = (unsigned)(bal & 0xffffull), mB = (unsigned)((bal >> 16) & 0xffffull);
        f32x4 fa[4], fb[4];
#pragma unroll
        for (int j = 0; j < 4; ++j) { fa[j] = (f32x4){0.f, 0.f, 0.f, 0.f}; fb[j] = (f32x4){0.f, 0.f, 0.f, 0.f}; }
        while (mA | mB) {
            u32x2 ya0[4], ya1[4], yb0[4], yb1[4];
            const bool va0 = mA != 0; if (va0) { const int e0 = __builtin_ctz(mA); mA &= mA - 1; ld_y(ya0, Y, __builtin_amdgcn_readlane(sl, e0), c.lane); }
            const bool va1 = mA != 0; if (va1) { const int e1 = __builtin_ctz(mA); mA &= mA - 1; ld_y(ya1, Y, __builtin_amdgcn_readlane(sl, e1), c.lane); }
            const bool vb0 = mB != 0; if (vb0) { const int e0 = __builtin_ctz(mB); mB &= mB - 1; ld_y(yb0, Y, __builtin_amdgcn_readlane(sl, 16 + e0), c.lane); }
            const bool vb1 = mB != 0; if (vb1) { const int e1 = __builtin_ctz(mB); mB &= mB - 1; ld_y(yb1, Y, __builtin_amdgcn_readlane(sl, 16 + e1), c.lane); }
            if (va0) acc_y(fa, ya0); if (va1) acc_y(fa, ya1); if (vb0) acc_y(fb, yb0); if (vb1) acc_y(fb, yb1);
        }
        float sa = 0.f, sb = 0.f;
#pragma unroll
        for (int j = 0; j < 4; ++j) { const int col = 4 * c.lane + 256 * j; const f32x4 g = ld4(mod + b * 6144 + 5 * 1024 + col) + 1.f;
            xa[j] = xa[j] * DN_ALPHA + g * fa[j]; xb[j] = xb[j] * DN_ALPHA + g * fb[j];
            sa += (xa[j][0] + xa[j][1]) + (xa[j][2] + xa[j][3]); sb += (xb[j][0] + xb[j][1]) + (xb[j][2] + xb[j][3]); }
        const float ma = wave_sum(sa) * (1.f / 1024.f), mb = wave_sum(sb) * (1.f / 1024.f); float sa2 = 0.f, sb2 = 0.f;
#pragma unroll
        for (int j = 0; j < 4; ++j) { xa[j] = xa[j] - ma; xb[j] = xb[j] - mb;
            sa2 += (xa[j][0] * xa[j][0] + xa[j][1] * xa[j][1]) + (xa[j][2] * xa[j][2] + xa[j][3] * xa[j][3]);
            sb2 += (xb[j][0] * xb[j][0] + xb[j][1] * xb[j][1]) + (xb[j][2] * xb[j][2] + xb[j][3] * xb[j][3]); }
        const float ra = 1.f / sqrtf(wave_sum(sa2) * (1.f / 1024.f) + 1e-5f), rb = 1.f / sqrtf(wave_sum(sb2) * (1.f / 1024.f) + 1e-5f);
#pragma unroll
        for (int j = 0; j < 4; ++j) { const int col = 4 * c.lane + 256 * j; const f32x4 g = ld4(lng + col), bb = ld4(lnb + col);
            const f32x4 ya = xa[j] * ra * g + bb, yb = xb[j] * rb * g + bb; *(f32x4*)(os + col) = ya; *(f32x4*)(os + 1024 + col) = yb;
            if (modn) { const f32x4 sc = ld4(modn + b * 6144 + 1024 + col) + 1.f, sh = ld4(modn + b * 6144 + col); const f32x4 ha = ya * sc + sh, hb = yb * sc + sh;
                u32x2 wa, wb; wa.x = cvt_pk(ha[0], ha[1]); wa.y = cvt_pk(ha[2], ha[3]); wb.x = cvt_pk(hb[0], hb[1]); wb.y = cvt_pk(hb[2], hb[3]);
                *(u32x2*)(H + (size_t)row * 1024 + col) = wa; *(u32x2*)(H + (size_t)(row + 1) * 1024 + col) = wb; } }
    }
}
DI void vote_init(const Ctx& c, const int off) { volatile unsigned* w = (volatile unsigned*)(c.lds + off); if (c.tid == 0) { w[0] = 0u; w[1] = 0u; } __syncthreads(); }
DI bool vote_any(const Ctx& c, const int off, const bool need, int& par) {
    volatile unsigned* w = (volatile unsigned*)(c.lds + off);
    if (need && c.lane == 0) w[par] = 1u;
    __syncthreads();
    const bool r = __builtin_amdgcn_readfirstlane(w[par]) != 0u;
    par ^= 1;
    if (c.tid == 0) w[par] = 0u;
    return r;
}
DI void phase_attn_mla(const Params& p, const Ctx& c) {
    unsigned char* ws = p.ws;
    const bf16* QL = (const bf16*)(ws + WS_QL); const bf16* QC = (const bf16*)(ws + WS_QC); const bf16* K0 = (const bf16*)(ws + WS_K0); const unsigned char* V0T = ws + WS_V0;
    bf16* CAT = (bf16*)(ws + WS_UV);
    int par = 0; vote_init(c, att::Cfg2<96, 64>::WS_OFF);
    for (int i = 0;; ++i) {
        const int L = i * c.G + c.bid;
        if (L >= 2048 + 64) break;
        const bf16 *Qb, *Kh, *Vt; int seq, orow0, h;
        if (L < 2048) { const int bh = (L >> 8) * 8 + (L & 7), qb = (L & 255) >> 3; const int b = bh >> 3; h = bh & 7;
            Qb = (const bf16*)((const char*)QL + ((size_t)bh * SEQ + qb * 256) * 128); Kh = (const bf16*)((const char*)K0 + (size_t)bh * TKV * 128);     Vt = (const bf16*)(V0T + (size_t)bh * 64 * TKV); seq = TKV; orow0 = b * SEQ + qb * 256; }
        else { const int bh = L - 2048; const int b = bh >> 3; h = bh & 7;
            Qb = (const bf16*)((const char*)QC + (size_t)bh * CTX * 128); Kh = (const bf16*)((const char*)K0 + ((size_t)bh * TKV + SEQ) * 128); Vt = (const bf16*)(V0T + (size_t)bh * 64 * TKV + SEQ); seq = CTX; orow0 = NL + b * CTX; }
        float kmax2 = 0.f;
        { const float* kc = (const float*)(ws + WS_CTL) + CW_KCH0 + ((L < 2048 ? ((L >> 8) * 8 + (L & 7)) : (L - 2048))) * 8; const float* kr4 = (const float*)(ws + WS_CTL) + CW_KCHR + ((L < 2048 ? ((L >> 8) * 8 + (L & 7)) : (L - 2048)) >> 3) * 4;
#pragma unroll
          for (int i2 = 0; i2 < 8; ++i2) kmax2 += kc[i2];
#pragma unroll
          for (int i2 = 0; i2 < 4; ++i2) kmax2 += kr4[i2]; }
        att::f32x16 o[2]; float l_reg;
        { const bool need = att::attn_core2<96, 64, false>((const char*)Qb, (const char*)Kh, (const char*)Vt, TKV, seq, (char*)c.lds, o, l_reg, c.wave, kmax2);
          if (vote_any(c, att::Cfg2<96, 64>::WS_OFF, need, par)) att::attn_core2<96, 64, true>((const char*)Qb, (const char*)Kh, (const char*)Vt, TKV, seq, (char*)c.lds, o, l_reg, c.wave, kmax2); }
        int ln = c.lane; asm volatile("" : "+v"(ln));
        const int r32 = ln & 31, hi = ln >> 5; const float inv = 1.f / (l_reg * att::VSC8);
        const unsigned obase = ((unsigned)(orow0 + c.wave * 32 + r32) * 1024u + (unsigned)(512 + h * 64 + 8 * hi)) * 2u;
#pragma unroll
        for (int d0 = 0; d0 < 2; ++d0)
#pragma unroll
            for (int q4 = 0; q4 < 4; q4 += 2) { u32x2 wa, wb;
                wa.x = cvt_pk(o[d0][4 * q4] * inv, o[d0][4 * q4 + 1] * inv); wa.y = cvt_pk(o[d0][4 * q4 + 2] * inv, o[d0][4 * q4 + 3] * inv);
                wb.x = cvt_pk(o[d0][4 * q4 + 4] * inv, o[d0][4 * q4 + 5] * inv); wb.y = cvt_pk(o[d0][4 * q4 + 6] * inv, o[d0][4 * q4 + 7] * inv);
                { auto r0 = __builtin_amdgcn_permlane32_swap(wa.x, wb.x, false, false); wa.x = r0[0]; wb.x = r0[1]; auto r1 = __builtin_amdgcn_permlane32_swap(wa.y, wb.y, false, false); wa.y = r1[0]; wb.y = r1[1]; }
                const u32x4 w = {wa.x, wa.y, wb.x, wb.y};
                *(u32x4*)((char*)CAT + (obase + (unsigned)(d0 * 64 + q4 * 16))) = w; }
    }
    __syncthreads();
}
#ifdef ATT_PROF
#define PROF_ARG , prof
#else
#define PROF_ARG
#endif
DI void phase_attn_diff(const Params& p, const Ctx& c) {
    unsigned char* ws = p.ws;
    const bf16* Q1 = (const bf16*)(ws + WS_Q1); const bf16* K1 = (const bf16*)(ws + WS_K1); const unsigned char* V1T = ws + WS_V1;   bf16* O1 = (bf16*)(ws + WS_O1);
    using CF = att::Cfg2<64, 128>;
    float lam;
    { const float a = p.in[I_LQ1][c.lane] * p.in[I_LK1][c.lane], b = p.in[I_LQ2][c.lane] * p.in[I_LK2][c.lane];
      lam = expf(wave_sum(a)) - expf(wave_sum(b)) + LAM_INIT; }
    const float* sg = p.in[I_SUBLN];
#ifdef ATT_PROF
    unsigned long long prof[5] = {0, 0, 0, 0, 0};
#endif
    int par = 0; vote_init(c, CF::WS_OFF);
    for (int i = 0;; ++i) {
        const int L = i * c.G + c.bid;
        if (L >= 2048) break;
        const int bh = (L >> 8) * 8 + (L & 7), qb = (L & 255) >> 3, b = bh >> 3, h = bh & 7;
        const bf16* Vt = (const bf16*)(V1T + (size_t)bh * 128 * TKV);
        att::f32x16 o[4]; float l_reg;
        {
            const int hh = 2 * h; const bf16* Qb = (const bf16*)((const char*)Q1 + ((size_t)(b * 16 + hh) * SEQ + qb * 256) * 64); const bf16* Kh = (const bf16*)((const char*)K1 + (size_t)(b * 16 + hh) * TKV * 64);
            float kmax2 = 0.f; { const float* kc = (const float*)(ws + WS_CTL) + CW_KCH1 + (b * 16 + hh) * 8;
#pragma unroll
              for (int i2 = 0; i2 < 8; ++i2) kmax2 += kc[i2]; }
            { const bool need = att::attn_core2<64, 128, false>((const char*)Qb, (const char*)Kh, (const char*)Vt, TKV, TKV, (char*)c.lds, o, l_reg, c.wave, kmax2);
              if (vote_any(c, CF::WS_OFF, need, par)) att::attn_core2<64, 128, true>((const char*)Qb, (const char*)Kh, (const char*)Vt, TKV, TKV, (char*)c.lds, o, l_reg, c.wave, kmax2); }
            int ln = c.lane; asm volatile("" : "+v"(ln));
            unsigned* st = (unsigned*)(c.lds + CF::STASH_OFF) + c.wave * 2048 + ln; const float inv = 1.f / (l_reg * att::VSC8);
#pragma unroll
            for (int d0 = 0; d0 < 4; ++d0)
#pragma unroll
                for (int r = 0; r < 16; r += 2) st[(d0 * 8 + (r >> 1)) * 64] = cvt_pk(o[d0][r] * inv, o[d0][r + 1] * inv);
        }
        {
            const int hh = 2 * h + 1; const bf16* Qb = (const bf16*)((const char*)Q1 + ((size_t)(b * 16 + hh) * SEQ + qb * 256) * 64); const bf16* Kh = (const bf16*)((const char*)K1 + (size_t)(b * 16 + hh) * TKV * 64);
            float kmax2 = 0.f; { const float* kc = (const float*)(ws + WS_CTL) + CW_KCH1 + (b * 16 + hh) * 8;
#pragma unroll
              for (int i2 = 0; i2 < 8; ++i2) kmax2 += kc[i2]; }
            { const bool need = att::attn_core2<64, 128, false>((const char*)Qb, (const char*)Kh, (const char*)Vt, TKV, TKV, (char*)c.lds, o, l_reg, c.wave, kmax2);
              if (vote_any(c, CF::WS_OFF, need, par)) att::attn_core2<64, 128, true>((const char*)Qb, (const char*)Kh, (const char*)Vt, TKV, TKV, (char*)c.lds, o, l_reg, c.wave, kmax2); }
        }
        int ln = c.lane; asm volatile("" : "+v"(ln));
        const int r32 = ln & 31, hi = ln >> 5;
        const unsigned* st = (const unsigned*)(c.lds + CF::STASH_OFF) + c.wave * 2048 + ln;
        const float nl = -lam / (l_reg * att::VSC8); float ss = 0.f;
#pragma unroll
        for (int d0 = 0; d0 < 4; ++d0)
#pragma unroll
            for (int r = 0; r < 16; r += 2) { const unsigned w = st[(d0 * 8 + (r >> 1)) * 64];
                const float f0 = bf_lo(w) + nl * o[d0][r], f1 = bf_hi(w) + nl * o[d0][r + 1];
                o[d0][r] = f0; o[d0][r + 1] = f1; ss += f0 * f0 + f1 * f1; }
        { auto rr = __builtin_amdgcn_permlane32_swap(__float_as_uint(ss), __float_as_uint(ss), false, false); ss = __uint_as_float(rr[0]) + __uint_as_float(rr[1]); }
        const float sc = (1.f - LAM_INIT) / sqrtf(ss * (1.f / 128.f) + 1e-6f);
        const unsigned obase = ((unsigned)(b * SEQ + qb * 256 + c.wave * 32 + r32) * 1024u + (unsigned)(h * 128 + 8 * hi)) * 2u;
#pragma unroll
        for (int d0 = 0; d0 < 4; ++d0)
#pragma unroll
            for (int q4 = 0; q4 < 4; q4 += 2) { const f32x4 g = *(const f32x4*)(sg + d0 * 32 + q4 * 8 + 4 * hi), g2 = *(const f32x4*)(sg + d0 * 32 + q4 * 8 + 8 + 4 * hi);
                u32x2 wa, wb; wa.x = cvt_pk(o[d0][4 * q4] * sc * g[0], o[d0][4 * q4 + 1] * sc * g[1]); wa.y = cvt_pk(o[d0][4 * q4 + 2] * sc * g[2], o[d0][4 * q4 + 3] * sc * g[3]);
                wb.x = cvt_pk(o[d0][4 * q4 + 4] * sc * g2[0], o[d0][4 * q4 + 5] * sc * g2[1]); wb.y = cvt_pk(o[d0][4 * q4 + 6] * sc * g2[2], o[d0][4 * q4 + 7] * sc * g2[3]);
                { auto r0 = __builtin_amdgcn_permlane32_swap(wa.x, wb.x, false, false); wa.x = r0[0]; wb.x = r0[1]; auto r1 = __builtin_amdgcn_permlane32_swap(wa.y, wb.y, false, false); wa.y = r1[0]; wb.y = r1[1]; }
                const u32x4 w = {wa.x, wa.y, wb.x, wb.y};
                *(u32x4*)((char*)O1 + (obase + (unsigned)(d0 * 64 + q4 * 16))) = w; }
    }
#ifdef ATT_PROF
    if (c.bid == 0 && c.lane == 0 && (c.wave == 0 || c.wave == 4)) { unsigned long long* dbg = (unsigned long long*)(ws + WS_CTL + 512 * 1024) + (c.wave >> 2) * 8;
        for (int i = 0; i < 5; ++i) dbg[i] = prof[i]; }
#endif
    __syncthreads();
}

constexpr int NPHASE = 22;
#ifndef PROBE_REPEAT_MASK
#define PROBE_REPEAT_MASK 0u
#endif
#ifndef PROBE_DRY_MASK
#define PROBE_DRY_MASK 0u
#endif
#define REP(k) _Pragma("unroll") for (int rep_ = 0; rep_ < (int)((PROBE_REPEAT_MASK >> (k)) & 1u) + 1; ++rep_)
__global__ void __launch_bounds__(NTHR, 2) trunk_fwd(Params p) {
    extern __shared__ __attribute__((aligned(16))) unsigned char lds[];
    const int BID = blockIdx.x, GRD = gridDim.x, WID = __builtin_amdgcn_readfirstlane((int)threadIdx.x >> 6);
    unsigned char* ws = p.ws;
    LAS unsigned char* ldsl = (LAS unsigned char*)lds;
    for (int u = WID * 64 + (int)__builtin_amdgcn_mbcnt_hi(~0u, __builtin_amdgcn_mbcnt_lo(~0u, 0u)); u < (LDS_BYTES - LDSCTL_OFF) / 4; u += NTHR) ((LAS unsigned*)(ldsl + LDSCTL_OFF))[u] = 0u;
    __syncthreads();
    unsigned* ctl = (unsigned*)(ws + WS_CTL);
    const bool multi = (p.ph_hi - p.ph_lo) > 1;
    XcdBarrier bar; bar.bar = ctl + CW_BAR; bar.x = 0; bar.st = nullptr;
    if (multi) bar = xcd_barrier_post(ctl + CW_BAR, (volatile LAS unsigned*)(ldsl + MISC_OFF) + 8, WID);
    const int lo = __builtin_amdgcn_readfirstlane(p.ph_lo), hi = __builtin_amdgcn_readfirstlane(p.ph_hi);
#ifdef ONLY_PHASE
#define IN(k) ((k) == ONLY_PHASE && lo <= (k))
#else
#define IN(k) (lo <= (k) && (k) < hi)
#endif
#ifdef PH_PROF
    unsigned long long ph_t = __builtin_amdgcn_s_memrealtime(), ph_bar = 0, ph_sel = 0;
#define SEAM(k) do { if (IN(k) && IN((k) + 1)) { const unsigned long long a_ = __builtin_amdgcn_s_memrealtime(); if ((PH_PROF_MASK >> (k)) & 1u) ph_sel += a_ - ph_t; \
        xcd_barrier(bar, WID); const unsigned long long b_ = __builtin_amdgcn_s_memrealtime(); ph_bar += b_ - a_; ph_t = b_; } } while (0)
#else
#define SEAM(k) do { if (IN(k) && IN((k) + 1)) xcd_barrier(bar, WID); } while (0)
#endif
#define SEAM2(k) do { if (IN(k) && IN((k) + 2)) xcd_barrier(bar, WID); } while (0)
    float* MOD = (float*)(ws + WS_MOD);
    bf16* H = (bf16*)(ws + WS_H);
    float* XC = (float*)(ws + WS_XC);
    const f32x2* R16 = (const f32x2*)(ws + WS_ROPE16); const f32x2* R32 = (const f32x2*)(ws + WS_ROPE32);

    if (IN(0)) REP(0) { const Ctx c = make_ctx(lds, WID); phase_prologue(p, c); } SEAM(0);
#ifdef PROBE_EXTRA_BARRIERS
    for (int xb_i = 0; xb_i < PROBE_EXTRA_BARRIERS; ++xb_i) xcd_barrier(bar, WID);
#endif
    if (IN(1)) REP(1) { const Ctx c = make_ctx(lds, WID); phase_mod_rows(c, p.in[I_X], p.in[I_CTX], MOD, 0, 1024, H); } SEAM(1);
    if (IN(2)) REP(2) {
        pg8::Gemm g{H, (const bf16*)(ws + WS_WIN0), NR, 1536, 1024}; pg8::StaticOrder S; S.init(NR, 1536, GRD, BID);
        EpiA0 E{ws};
        pg8::gemm_phase<EpiA0, pg8::StaticOrder, true, true>(ldsl, g, S, E, WID);
    } SEAM(2);
    if (IN(3)) { const Ctx c = make_ctx(lds, WID);
        if (PROBE_DRY_MASK & (1u << 3)) phase_gmlp(p, c, (bf16*)p.out);
        phase_gmlp(p, c, (bf16*)(ws + WS_UV));
        phase_kr(p, c);
        } SEAM(3);
    if (IN(4)) REP(4) {
#ifndef P4_SKIP_Q
        { pg8::Gemm g{(const bf16*)(ws + WS_CQ), (const bf16*)(ws + WS_WUQ), NR, 768, 256}; pg8::StaticOrder S; S.init(NR, 768, GRD, BID);
          EpiQ E{ws, (const float*)(ws + WS_RQ), R16};
          pg8::gemm_phase<EpiQ, pg8::StaticOrder, true, true>(ldsl, g, S, E, WID); }
#endif
        __syncthreads();
#ifndef P4_SKIP_KV
        { pg8::Gemm g{(const bf16*)(ws + WS_CKV), (const bf16*)(ws + WS_WUKV), NR, 1024, 128}; pg8::StaticOrder S; S.init(NR, 1024, GRD, GRD - 1 - BID);
          EpiKV E{ws, (const float*)(ws + WS_RKV), ctl + CW_KCH0};
          pg8::gemm_phase<EpiKV, pg8::StaticOrder, true, true>(ldsl, g, S, E, WID); }
#endif
    } SEAM(4);
    if (IN(5)) REP(5) { const Ctx c = make_ctx(lds, WID); phase_attn_mla(p, c); } SEAM(5);
    if (IN(6)) REP(6) {
        pg8::Gemm g{(const bf16*)(ws + WS_UV), (const bf16*)(ws + WS_WOUT0), NR, 1024, 1024}; pg8::StaticOrder S; S.init(NR, 1024, GRD, BID);
        EpiOut E{p.in[I_X], p.in[I_CTX], (bf16*)(ws + WS_T16_0), MOD + 2 * 1024};
        pg8::gemm_phase<EpiOut, pg8::StaticOrder, true, true>(ldsl, g, S, E, WID);
    } SEAM(6);
    if (IN(7)) { const Ctx c = make_ctx(lds, WID); phase_ln_router(c, (const bf16*)(ws + WS_T16_0), (bf16*)(ws + WS_X1), p.in[I_LNMG0], p.in[I_LNMB0], MOD, p.in[I_ROUTER0], ws + WS_H, (float*)(ws + WS_SX), (float*)(ws + WS_AFF), (float*)(ws + WS_AFFC), NR); } SEAM(7);
    if (IN(8)) REP(8) { const Ctx c = make_ctx(lds, WID); phase_topk(p, c, true); } SEAM2(8);
    if (IN(10)) REP(10) {
        pg8::Gemm g{(const bf16*)(ws + WS_H), (const bf16*)(ws + WS_WGU8_0), NE * ROWS_E, NE * 2048, 512}; GroupedOrder S{MT_E, 8, BID, GRD};
        EpiMoe1F8 E{ws + WS_HID, (const float*)(ws + WS_SX), (const int*)(ws + WS_ROWIDX), (const float*)(ws + WS_SW), 8};
        pg8::gemm_phase<EpiMoe1F8, GroupedOrder, true, true, true, true>(ldsl, g, S, E, WID, (const int*)(ws + WS_ROWIDX), GTBL_OFF);
    } SEAM(10);
    if (IN(11)) REP(11) {
        pg8::Gemm g{(const bf16*)(ws + WS_HID), (const bf16*)(ws + WS_WDN8_0), NE * ROWS_E, NE * 1024, 512}; GroupedOrder S{MT_E, 4, BID, GRD};
        EpiMoe2F8 E{(bf16*)(ws + WS_Y), (const float*)(ws + WS_ROWGATE), (const float*)(ws + WS_SW) + 2 * NE * 2048, 4};
        pg8::gemm_phase<EpiMoe2F8, GroupedOrder, true, true, true>(ldsl, g, S, E, WID);
    } SEAM(11);
    if (IN(12)) { const Ctx c = make_ctx(lds, WID);
        phase_combine_ln(c, (const bf16*)(ws + WS_X1), p.out, XC, (const bf16*)(ws + WS_Y), (const int*)(ws + WS_SLOTROW), p.in[I_LNFG0], p.in[I_LNFB0], MOD, MOD + 9 * 6144, H, NR); } SEAM(12);
    if (IN(13)) REP(13) {
        { pg8::Gemm g{H, (const bf16*)(ws + WS_WIN1), NL, 2048, 1024}; pg8::StaticOrder S; S.init(NL, 2048, GRD, BID);
          EpiA1 E{ws, R32, 0, 0, ctl + CW_KCH1};
          pg8::gemm_phase<EpiA1, pg8::StaticOrder, true, true>(ldsl, g, S, E, WID); }
        __syncthreads();
        { pg8::Gemm g{H, (const bf16*)(ws + WS_WIN1) + (size_t)2048 * 1024, NL, 1024, 1024}; pg8::StaticOrder S; S.init(NL, 1024, GRD, BID);
          EpiV1T E{ws, 0};
          pg8::gemm_phase<EpiV1T, pg8::StaticOrder, true, true>(ldsl, g, S, E, WID); }
        __syncthreads();
        { pg8::Gemm g{H + (size_t)NL * 1024, (const bf16*)(ws + WS_WIN1) + (size_t)1024 * 1024, NC, 1024, 1024}; pg8::StaticOrder S; S.init(NC, 1024, GRD, BID);
          EpiA1 E{ws, R32, NL, 1024, ctl + CW_KCH1};
          pg8::gemm_phase<EpiA1, pg8::StaticOrder, true, true>(ldsl, g, S, E, WID); }
        __syncthreads();
        { pg8::Gemm g{H + (size_t)NL * 1024, (const bf16*)(ws + WS_WIN1) + (size_t)2048 * 1024, NC, 1024, 1024}; pg8::StaticOrder S; S.init(NC, 1024, GRD, GRD - 1 - BID);
          EpiV1T E{ws, NL};
          pg8::gemm_phase<EpiV1T, pg8::StaticOrder, true, true>(ldsl, g, S, E, WID); }
    } SEAM(13);
    if (IN(14)) REP(14) { const Ctx c = make_ctx(lds, WID); phase_attn_diff(p, c); } SEAM(14);
    if (IN(15)) REP(15) {
        pg8::Gemm g{(const bf16*)(ws + WS_O1), (const bf16*)(ws + WS_WOUT1), NL, 1024, 1024}; pg8::StaticOrder S; S.init(NL, 1024, GRD, BID);
        EpiOut E{p.out, XC, (bf16*)(ws + WS_T16_1), MOD + 9 * 6144 + 2 * 1024};
        pg8::gemm_phase<EpiOut, pg8::StaticOrder, true, true>(ldsl, g, S, E, WID);
    } SEAM(15);
    if (IN(16)) { const Ctx c = make_ctx(lds, WID); phase_ln_router(c, (const bf16*)(ws + WS_T16_1), (bf16*)(ws + WS_X1), p.in[I_LNMG1], p.in[I_LNMB1], MOD + 9 * 6144, p.in[I_ROUTER1], ws + WS_H, (float*)(ws + WS_SX), (float*)(ws + WS_AFF), (float*)(ws + WS_AFFC), NL); } SEAM(16);
    if (IN(17)) REP(17) { const Ctx c = make_ctx(lds, WID); phase_topk(p, c, false); } SEAM2(17);
    if (IN(19)) REP(19) {
        pg8::Gemm g{(const bf16*)(ws + WS_H), (const bf16*)(ws + WS_WGU8_1), NE * ROWS_E, NE * 2048, 512}; GroupedOrder S{32, 8, BID, GRD};
        EpiMoe1F8 E{ws + WS_HID, (const float*)(ws + WS_SX), (const int*)(ws + WS_ROWIDX), (const float*)(ws + WS_SW) + NE * 2048, 8};
        pg8::gemm_phase<EpiMoe1F8, GroupedOrder, true, true, true, true>(ldsl, g, S, E, WID, (const int*)(ws + WS_ROWIDX), GTBL_OFF);
    } SEAM(19);
    if (IN(20)) REP(20) {
        pg8::Gemm g{(const bf16*)(ws + WS_HID), (const bf16*)(ws + WS_WDN8_1), NE * ROWS_E, NE * 1024, 512}; GroupedOrder S{32, 4, BID, GRD};
        EpiMoe2F8 E{(bf16*)(ws + WS_Y), (const float*)(ws + WS_ROWGATE), (const float*)(ws + WS_SW) + 2 * NE * 2048 + NE * 1024, 4};
        pg8::gemm_phase<EpiMoe2F8, GroupedOrder, true, true, true>(ldsl, g, S, E, WID);
    } SEAM(20);
    if (IN(21)) { const Ctx c = make_ctx(lds, WID);
        phase_combine_ln(c, (const bf16*)(ws + WS_X1), p.out, XC, (const bf16*)(ws + WS_Y), (const int*)(ws + WS_SLOTROW), p.in[I_LNFG1], p.in[I_LNFB1], MOD + 9 * 6144, nullptr, H, NL); }
#ifdef PH_PROF
    { const unsigned long long a_ = __builtin_amdgcn_s_memrealtime(); if ((PH_PROF_MASK >> 21) & 1u) ph_sel += a_ - ph_t;
      xcd_barrier(bar, WID);
      if (BID == PH_PROF_BLOCK) { float v1 = (float)ph_bar, v2 = (float)ph_sel;
        v1 = exp2f((rintf(log2f(fmaxf(v1, 1.f)) * 2.f + PH_PROF_SHIFT) - PH_PROF_SHIFT) * 0.5f); v2 = exp2f((rintf(log2f(fmaxf(v2, 1.f)) * 2.f + PH_PROF_SHIFT) - PH_PROF_SHIFT) * 0.5f);
        const int t = WID * 64 + (int)__builtin_amdgcn_mbcnt_hi(~0u, __builtin_amdgcn_mbcnt_lo(~0u, 0u));
        for (int i = 1 + t; i <= 10000; i += NTHR) p.out[i] = v2;
        if (t == 0) p.out[0] = 16.f * v1; } }
#endif
#ifdef ATT_PROF
    xcd_barrier(bar, WID);
    if (BID == 0) { const unsigned long long* dbg = (const unsigned long long*)(ws + WS_CTL + 512 * 1024);
        const int i1 = ATT_PROF_SEL1, i2 = ATT_PROF_SEL2;
        float v1 = (float)dbg[i1 & 15] / (float)dbg[(i1 & 8) + 4], v2 = (float)dbg[i2 & 15] / (float)dbg[(i2 & 8) + 4];
        if (i1 & 16) v1 = (float)(dbg[(i1 & 8)] + dbg[(i1 & 8) + 1] + dbg[(i1 & 8) + 2] + dbg[(i1 & 8) + 3]) / (float)dbg[(i1 & 8) + 4];
        if (i2 & 16) v2 = (float)(dbg[(i2 & 8)] + dbg[(i2 & 8) + 1] + dbg[(i2 & 8) + 2] + dbg[(i2 & 8) + 3]) / (float)dbg[(i2 & 8) + 4];
        v1 = exp2f((rintf(log2f(fmaxf(v1, 1.f)) * 4.f + ATT_PROF_SHIFT) - ATT_PROF_SHIFT) * 0.25f); v2 = exp2f((rintf(log2f(fmaxf(v2, 1.f)) * 4.f + ATT_PROF_SHIFT) - ATT_PROF_SHIFT) * 0.25f);
        const int t = WID * 64 + (int)__builtin_amdgcn_mbcnt_hi(~0u, __builtin_amdgcn_mbcnt_lo(~0u, 0u));
        for (int i = 1 + t; i <= 10000; i += NTHR) p.out[i] = v2;
        if (t == 0) p.out[0] = 16.f * v1; }
#endif
#undef IN
#undef SEAM
}

#ifndef N_LAUNCH_MODE
#define N_LAUNCH_MODE 0
#endif
extern "C" void kernel_launch(void* const* d_in, const int* in_sizes, int n_in, void* d_out, int out_size, void* d_ws, size_t ws_size, hipStream_t stream) {
    static int ok = 0;
    if (ok == 0) {
        if (n_in != 41 || in_sizes[0] != NL * DM || out_size != NL * DM || ws_size < WS_END) { fprintf(stderr, "kernel_launch: unexpected shapes: n_in %d in0 %d out %d ws %zu (need %zu)\n", n_in, n_in > 0 ? in_sizes[0] : -1, out_size, ws_size, (size_t)WS_END); ok = -1; return; }
        if (hipFuncSetAttribute((const void*)trunk_fwd, hipFuncAttributeMaxDynamicSharedMemorySize, LDS_BYTES) != hipSuccess) { fprintf(stderr, "kernel_launch: hipFuncSetAttribute failed\n"); ok = -1; return; }
        int per_cu = 0;
        if (hipOccupancyMaxActiveBlocksPerMultiprocessor(&per_cu, (const void*)trunk_fwd, NTHR, LDS_BYTES) != hipSuccess || per_cu < 1) fprintf(stderr, "kernel_launch: note: occupancy query reports %d\n", per_cu);
        (void)hipGetLastError();
        ok = 1;
    }
    if (ok < 0) return;
    (void)hipMemsetAsync((char*)d_ws + WS_CTL, 0, CTL_ZERO_BYTES, stream);
    Params p{};
    for (int i = 0; i < 41; ++i) p.in[i] = (const float*)d_in[i];
    p.out = (float*)d_out; p.ws = (unsigned char*)d_ws;
    const int grid = 256;
#if N_LAUNCH_MODE == 0
    p.ph_lo = 0; p.ph_hi = NPHASE;
    hipLaunchKernelGGL(trunk_fwd, dim3(grid), dim3(NTHR), LDS_BYTES, stream, p);
#else
    for (int k = 0; k < NPHASE; ++k) { p.ph_lo = k; p.ph_hi = k + 1; hipLaunchKernelGGL(trunk_fwd, dim3(grid), dim3(NTHR), LDS_BYTES, stream, p); }
#endif
    const hipError_t le = hipPeekAtLastError();
    if (le != hipSuccess) fprintf(stderr, "kernel_launch: launch failed: %s\n", hipGetErrorName(le));
}
```
